# Optimizing an MI355X kernel written in HIP

```python
import math
import jax, jax.numpy as jnp
from jax import lax
import numpy as np

D_MODEL = 1024
BATCH = 8
SEQ = 4096
DEPTH = 2

HEAD_DIM = 128
RET_HEADS = 4
MOBA_HEADS = 4
FOX_HEADS = 8
RET_WIDTH = RET_HEADS * HEAD_DIM
MOBA_WIDTH = MOBA_HEADS * HEAD_DIM
FOX_WIDTH = FOX_HEADS * HEAD_DIM
RET_CHUNK = 128
MOBA_BLOCK = 256
MOBA_TOPK = 3
MOBA_Q_CHUNK = 32
FOX_Q_BLOCK = 128
N_REL_BUCKETS = 32
REL_MAX_DISTANCE = 128
ROPE_BASE = 10000.0
RMS_EPS = 1e-6
GN_EPS = 1e-5
NEG = -1e30
FFN_HIDDEN = ((8 * D_MODEL + 3 * 256 - 1) // (3 * 256)) * 256
N_EVEN = (DEPTH + 1) // 2
N_ODD = DEPTH // 2
EVEN_IN = 4 * RET_WIDTH + 3 * MOBA_WIDTH
ODD_IN = 3 * FOX_WIDTH + FOX_HEADS

kernel_name = "hybrid_retention_moba_fox_block"


def rms_norm(x, g):
    xf = x.astype(jnp.float32)
    y = xf * lax.rsqrt(jnp.mean(xf * xf, axis=-1, keepdims=True) + RMS_EPS)
    return (y * g.astype(jnp.float32)).astype(x.dtype)


def split_heads(t, n_heads):
    b, s, _ = t.shape
    return t.reshape(b, s, n_heads, HEAD_DIM).transpose(0, 2, 1, 3).astype(jnp.float32)


def merge_heads(t):
    b, h, s, d = t.shape
    return t.transpose(0, 2, 1, 3).reshape(b, s, h * d)


def rotary(t, pos):
    d = t.shape[-1]
    inv_freq = jnp.power(ROPE_BASE, -jnp.arange(0, d, 2, dtype=jnp.float32) / d)
    ang = pos.astype(jnp.float32)[:, None] * inv_freq[None, :]
    cos, sin = jnp.cos(ang), jnp.sin(ang)
    t1, t2 = t[..., : d // 2], t[..., d // 2:]
    return jnp.concatenate([t1 * cos - t2 * sin, t1 * sin + t2 * cos], axis=-1)


def t5_bucket(rel):
    n = jnp.maximum(rel, 0)
    max_exact = N_REL_BUCKETS // 2
    nf = jnp.maximum(n, 1).astype(jnp.float32)
    large = max_exact + (jnp.log(nf / max_exact) / math.log(REL_MAX_DISTANCE / max_exact)
                         * (N_REL_BUCKETS - max_exact)).astype(jnp.int32)
    large = jnp.minimum(large, N_REL_BUCKETS - 1)
    return jnp.where(n < max_exact, n, large)


def retention(q, k, v, pos):
    b, h, s, d = q.shape
    c = RET_CHUNK
    n = s // c
    log_g = jnp.log1p(-jnp.power(2.0, -5.0 - jnp.arange(h, dtype=jnp.float32)))
    q = rotary(q, pos) * (d ** -0.5)
    k = rotary(k, pos)
    idx = jnp.arange(c, dtype=jnp.float32)
    diff = idx[:, None] - idx[None, :]
    inner = jnp.where(diff >= 0, jnp.exp(log_g[:, None, None] * jnp.maximum(diff, 0.0)), 0.0)
    q_dec = jnp.exp(log_g[:, None] * (idx + 1.0))[:, :, None]
    k_dec = jnp.exp(log_g[:, None] * (c - 1.0 - idx))[:, :, None]
    chunk_dec = jnp.exp(log_g * c)[:, None, None]

    def to_chunks(t):
        return t.reshape(b, h, n, c, t.shape[-1]).transpose(2, 0, 1, 3, 4)

    def step(state, inp):
        qi, ki, vi = inp
        sc = jnp.einsum('bhqd,bhkd->bhqk', qi, ki) * inner
        o = (jnp.einsum('bhqk,bhkv->bhqv', sc, vi)
             + jnp.einsum('bhqd,bhdv->bhqv', qi, state) * q_dec)
        state = state * chunk_dec + jnp.einsum('bhkd,bhkv->bhdv', ki * k_dec, vi)
        return state, o

    state0 = jnp.zeros((b, h, d, v.shape[-1]), jnp.float32)
    _, o = lax.scan(step, state0, (to_chunks(q), to_chunks(k), to_chunks(v)))
    return o.transpose(1, 2, 0, 3, 4).reshape(b, h, s, v.shape[-1])


def head_group_norm(o, g):
    mu = jnp.mean(o, axis=-1, keepdims=True)
    var = jnp.mean(jnp.square(o - mu), axis=-1, keepdims=True)
    y = (o - mu) * lax.rsqrt(var + GN_EPS)
    return merge_heads(y) * g.astype(jnp.float32)


def moba_attention(q, k, v, rel_bias, pos):
    b, h, s, d = q.shape
    L = MOBA_BLOCK
    nb = -(-s // L)
    pad = nb * L - s
    kb = jnp.pad(k, ((0, 0), (0, 0), (0, pad), (0, 0))).reshape(b, h, nb, L, d)
    vb = jnp.pad(v, ((0, 0), (0, 0), (0, pad), (0, 0))).reshape(b, h, nb, L, d)
    kmean = jnp.mean(kb, axis=3)
    topk = min(MOBA_TOPK, nb)
    scale = d ** -0.5
    bias_t = rel_bias.astype(jnp.float32).T
    qc_len = MOBA_Q_CHUNK
    n_qc = s // qc_len
    qc = q.reshape(b, h, n_qc, qc_len, d).transpose(2, 0, 1, 3, 4)
    bi = jnp.arange(b)[:, None, None, None]
    hi = jnp.arange(h)[None, :, None, None]
    blk_ids = jnp.arange(nb)
    offs = jnp.arange(L)

    def one_chunk(args):
        qi, ci = args
        q_pos = pos[0] + ci * qc_len + jnp.arange(qc_len)
        own = (ci * qc_len) // L
        gate = jnp.einsum('bhqd,bhnd->bhqn', qi, kmean)
        gate = jnp.where(blk_ids < own, gate, -jnp.inf)
        _, sel = lax.top_k(gate, topk)
        valid = sel < own
        ks = kb[bi, hi, sel]
        vs = vb[bi, hi, sel]
        s_sel = jnp.einsum('bhqd,bhqnld->bhqnl', qi, ks) * scale
        k_pos_sel = pos[0] + sel[..., None] * L + offs
        rel_sel = q_pos[None, None, :, None, None] - k_pos_sel
        s_sel = s_sel + bias_t[hi[..., None], t5_bucket(rel_sel)]
        s_sel = jnp.where(valid[..., None], s_sel, NEG).reshape(b, h, qc_len, topk * L)
        k_own = lax.dynamic_slice_in_dim(kb, own, 1, axis=2)[:, :, 0]
        v_own = lax.dynamic_slice_in_dim(vb, own, 1, axis=2)[:, :, 0]
        rel_own = q_pos[:, None] - (pos[0] + own * L + offs)[None, :]
        s_own = jnp.einsum('bhqd,bhld->bhql', qi, k_own) * scale + bias_t[:, t5_bucket(rel_own)]
        s_own = jnp.where(rel_own >= 0, s_own, NEG)
        p = jax.nn.softmax(jnp.concatenate([s_sel, s_own], axis=-1), axis=-1)
        p_sel = p[..., : topk * L].reshape(b, h, qc_len, topk, L)
        p_own = p[..., topk * L:]
        return (jnp.einsum('bhqnl,bhqnld->bhqd', p_sel, vs)
                + jnp.einsum('bhql,bhld->bhqd', p_own, v_own))

    o = lax.map(one_chunk, (qc, jnp.arange(n_qc)))
    return o.transpose(1, 2, 0, 3, 4).reshape(b, h, s, d)


def forgetting_attention(q, k, v, log_f):
    b, h, s, d = q.shape
    qb_len = FOX_Q_BLOCK
    n_qb = s // qb_len
    scale = d ** -0.5
    F = jnp.cumsum(log_f, axis=-1)
    qb = q.reshape(b, h, n_qb, qb_len, d).transpose(2, 0, 1, 3, 4)
    Fb = F.reshape(b, h, n_qb, qb_len).transpose(2, 0, 1, 3)
    k_pos = jnp.arange(s)

    def one_block(args):
        qi, Fi, blk = args
        q_pos = blk * qb_len + jnp.arange(qb_len)
        sc = (jnp.einsum('bhqd,bhkd->bhqk', qi, k) * scale
              + Fi[..., :, None] - F[:, :, None, :])
        sc = jnp.where(k_pos[None, :] <= q_pos[:, None], sc, NEG)
        p = jax.nn.softmax(sc, axis=-1)
        return jnp.einsum('bhqk,bhkd->bhqd', p, v)

    o = lax.map(one_block, (qb, Fb, jnp.arange(n_qb)))
    return o.transpose(1, 2, 0, 3, 4).reshape(b, h, s, d)


def even_mixer(h, w_in, gn_w, w_out, rel_bias, pos):
    proj = h @ w_in
    cuts = [RET_WIDTH * i for i in range(1, 5)] + [4 * RET_WIDTH + MOBA_WIDTH * i for i in range(1, 3)]
    rq, rk, rv, rg, mq, mk, mv = jnp.split(proj, cuts, axis=-1)
    ret = retention(split_heads(rq, RET_HEADS), split_heads(rk, RET_HEADS),
                    split_heads(rv, RET_HEADS), pos)
    ret = head_group_norm(ret, gn_w) * jax.nn.silu(rg.astype(jnp.float32))
    mob = merge_heads(moba_attention(split_heads(mq, MOBA_HEADS), split_heads(mk, MOBA_HEADS),
                                     split_heads(mv, MOBA_HEADS), rel_bias, pos))
    cat = jnp.concatenate([ret, mob], axis=-1).astype(h.dtype)
    return cat @ w_out


def odd_mixer(h, w_in, b_forget, w_out):
    proj = h @ w_in
    fq, fk, fv, fl = jnp.split(proj, [FOX_WIDTH, 2 * FOX_WIDTH, 3 * FOX_WIDTH], axis=-1)
    log_f = jax.nn.log_sigmoid(fl.astype(jnp.float32) + b_forget.astype(jnp.float32))
    o = forgetting_attention(split_heads(fq, FOX_HEADS), split_heads(fk, FOX_HEADS),
                             split_heads(fv, FOX_HEADS), log_f.transpose(0, 2, 1))
    return merge_heads(o).astype(h.dtype) @ w_out


def swiglu(h, w_in, w_out):
    gu = h @ w_in
    g, u = jnp.split(gu, [FFN_HIDDEN], axis=-1)
    return (jax.nn.silu(g) * u) @ w_out


def setup_inputs(seed: int = 0) -> dict:
    key = jax.random.key(seed)
    ks = jax.random.split(key, 15)
    f32 = jnp.float32

    def w(k, shape, fan_in):
        return jax.random.normal(k, shape, f32) * (fan_in ** -0.5)

    def gain(k, shape):
        return 1.0 + 0.05 * jax.random.normal(k, shape, f32)

    return {
        "x": jax.random.normal(ks[0], (BATCH, SEQ, D_MODEL), f32),
        "rel_bias": 0.5 * jax.random.normal(ks[1], (N_REL_BUCKETS, MOBA_HEADS), f32),
        "norm_mix_pre": gain(ks[2], (DEPTH, D_MODEL)),
        "norm_mix_post": gain(ks[3], (DEPTH, D_MODEL)),
        "norm_ffn_pre": gain(ks[4], (DEPTH, D_MODEL)),
        "norm_ffn_post": gain(ks[5], (DEPTH, D_MODEL)),
        "even_w_in": w(ks[6], (N_EVEN, D_MODEL, EVEN_IN), D_MODEL),
        "even_gn": gain(ks[7], (N_EVEN, RET_WIDTH)),
        "even_w_out": w(ks[8], (N_EVEN, RET_WIDTH + MOBA_WIDTH, D_MODEL), RET_WIDTH + MOBA_WIDTH),
        "odd_w_in": w(ks[9], (N_ODD, D_MODEL, ODD_IN), D_MODEL),
        "odd_b_forget": 2.0 + 0.5 * jax.random.normal(ks[10], (N_ODD, FOX_HEADS), f32),
        "odd_w_out": w(ks[11], (N_ODD, FOX_WIDTH, D_MODEL), FOX_WIDTH),
        "ffn_w_in": w(ks[12], (DEPTH, D_MODEL, 2 * FFN_HIDDEN), D_MODEL),
        "ffn_w_out": w(ks[13], (DEPTH, FFN_HIDDEN, D_MODEL), FFN_HIDDEN),
    }


def reference(x, rel_bias, norm_mix_pre, norm_mix_post, norm_ffn_pre, norm_ffn_post,
              even_w_in, even_gn, even_w_out, odd_w_in, odd_b_forget, odd_w_out,
              ffn_w_in, ffn_w_out):
    pos = jnp.arange(x.shape[1], dtype=jnp.int32)
    for layer in range(DEPTH):
        i = layer // 2
        hn = rms_norm(x, norm_mix_pre[layer])
        if layer % 2 == 0:
            m = even_mixer(hn, even_w_in[i], even_gn[i], even_w_out[i], rel_bias, pos)
        else:
            m = odd_mixer(hn, odd_w_in[i], odd_b_forget[i], odd_w_out[i])
        x = x + rms_norm(m, norm_mix_post[layer])
        hn = rms_norm(x, norm_ffn_pre[layer])
        x = x + rms_norm(swiglu(hn, ffn_w_in[layer], ffn_w_out[layer]), norm_ffn_post[layer])
    return x
```

```cpp
#include <hip/hip_runtime.h>
#include <cstdio>
#include <cstdint>
namespace nv {
constexpr int S = 4096, DM = 1024, HD = 128, FFH = 2816;
__device__ __forceinline__ float silu_f(float v) { return v / (1.f + expf(-v)); }
__device__ __forceinline__ int t5_bucket(int rel) {
    int n = rel > 0 ? rel : 0; if (n < 16) return n;
    int large = 16 + (int)(logf((float)n / 16.f) / 2.0794415416798357f * 16.f);
    return large < 31 ? large : 31;
}
__global__ void k_rmsnorm(const float* __restrict__ x, const float* __restrict__ g, const float* res, float* y, int rows) {
    __shared__ float red[256];
    for (int r = blockIdx.x; r < rows; r += gridDim.x) {
        const float* xr = x + (size_t)r * DM; float s = 0.f;
        for (int c = threadIdx.x; c < DM; c += 256) s += xr[c] * xr[c];
        red[threadIdx.x] = s; __syncthreads();
        for (int o = 128; o > 0; o >>= 1) { if (threadIdx.x < o) red[threadIdx.x] += red[threadIdx.x + o]; __syncthreads(); }
        const float rs = rsqrtf(red[0] / DM + 1e-6f); __syncthreads();
        for (int c = threadIdx.x; c < DM; c += 256) { float v = xr[c] * rs * g[c]; if (res) v += res[(size_t)r * DM + c]; y[(size_t)r * DM + c] = v; }
    }
}
__global__ void k_gemm(const float* __restrict__ A, const float* __restrict__ B, float* __restrict__ C, int M, int N, int K, int ldb) {
    __shared__ float As[16][65], Bs[16][65];
    const int tx = threadIdx.x & 15, ty = threadIdx.x >> 4, ntn = (N + 63) / 64, ntm = M / 64;
    for (int t = blockIdx.x; t < ntn * ntm; t += gridDim.x) {
        const int m0 = (t / ntn) * 64, n0 = (t % ntn) * 64; float acc[4][4] = {};
        for (int k0 = 0; k0 < K; k0 += 16) {
            for (int i = threadIdx.x; i < 1024; i += 256) { const int mm = i >> 4, kk = i & 15; As[kk][mm] = A[(size_t)(m0 + mm) * K + k0 + kk]; }
            for (int i = threadIdx.x; i < 1024; i += 256) { const int kk = i >> 6, nn = i & 63; Bs[kk][nn] = (n0 + nn < N) ? B[(size_t)(k0 + kk) * ldb + n0 + nn] : 0.f; }
            __syncthreads();
#pragma unroll
            for (int kk = 0; kk < 16; ++kk) { float a[4], b[4];
#pragma unroll
                for (int i = 0; i < 4; ++i) { a[i] = As[kk][ty * 4 + i]; b[i] = Bs[kk][tx * 4 + i]; }
#pragma unroll
                for (int i = 0; i < 4; ++i)
#pragma unroll
                    for (int j = 0; j < 4; ++j) acc[i][j] += a[i] * b[j]; }
            __syncthreads();
        }
        for (int i = 0; i < 4; ++i) for (int j = 0; j < 4; ++j) if (n0 + tx * 4 + j < N) C[(size_t)(m0 + ty * 4 + i) * N + n0 + tx * 4 + j] = acc[i][j];
    }
}
__global__ void k_rotary(float* p, int ld, int col0, int nheads, float scale) {
    const int total = S * nheads * 64;
    for (int i = blockIdx.x * blockDim.x + threadIdx.x; i < total; i += gridDim.x * blockDim.x) {
        const int j = i & 63, h = (i >> 6) % nheads, t = i / (64 * nheads);
        const float inv = powf(10000.f, -(float)(2 * j) / 128.f), ang = (float)t * inv, c = cosf(ang), s = sinf(ang);
        float* q = p + (size_t)t * ld + col0 + h * HD; const float t1 = q[j], t2 = q[j + 64];
        q[j] = (t1 * c - t2 * s) * scale; q[j + 64] = (t1 * s + t2 * c) * scale;
    }
}
__global__ void k_kmean(const float* p, int ld, int kcol0, float* kmean) {
    for (int i = blockIdx.x * blockDim.x + threadIdx.x; i < 4 * 16 * HD; i += gridDim.x * blockDim.x) {
        const int d = i & 127, blk = (i >> 7) & 15, h = i >> 11; float s = 0.f;
        for (int t = 0; t < 256; ++t) s += p[(size_t)(blk * 256 + t) * ld + kcol0 + h * HD + d];
        kmean[i] = s * (1.f / 256.f);
    }
}
__global__ void k_select(const float* p, int ld, int qcol0, const float* kmean, unsigned* sel) {
    for (int i = blockIdx.x * blockDim.x + threadIdx.x; i < S * 4; i += gridDim.x * blockDim.x) {
        const int h = i & 3, t = i >> 2, own = t >> 8; const float* q = p + (size_t)t * ld + qcol0 + h * HD;
        float g[16];
        for (int n = 0; n < 16; ++n) { float s = 0.f; if (n < own) { const float* km = kmean + (h * 16 + n) * HD; for (int d = 0; d < HD; ++d) s += q[d] * km[d]; } g[n] = s; }
        unsigned m = 0;
        for (int k = 0; k < 3; ++k) { int best = -1; float bv = 0.f;
            for (int n = 0; n < own; ++n) if (!((m >> n) & 1u) && (best < 0 || g[n] > bv)) { best = n; bv = g[n]; }
            if (best >= 0) m |= 1u << best; }
        sel[i] = m;
    }
}
__global__ void k_fcum(const float* proj, int ld, const float* bf, float* F) {
    const int h = blockIdx.x * blockDim.x + threadIdx.x; if (h >= 8) return;
    double acc = 0.0;
    for (int t = 0; t < S; ++t) { const float z = proj[(size_t)t * ld + 3072 + h] + bf[h];
        const float ls = fminf(z, 0.f) - log1pf(expf(-fabsf(z))); acc += (double)ls; F[h * S + t] = (float)acc; }
}
template <int MODE>
__global__ void k_attn(const float* __restrict__ Q, const float* __restrict__ K, const float* __restrict__ V, int ld, float* O, int ldo, int nheads,
                       const unsigned* sel, const float* relb, const float* F) {
    __shared__ float Qs[32][HD + 1], Ks[32][HD + 1], Vs[32][HD], Ss[32][33];
    const int tid = threadIdx.x, qi = tid >> 3, sub = tid & 7;
    const int ntile = S / 32;
    for (int u = blockIdx.x; u < ntile * nheads; u += gridDim.x) {
        const int h = u % nheads, qt = u / nheads, q0 = qt * 32, iq = q0 + qi;
        for (int i = tid; i < 32 * HD; i += 256) Qs[i >> 7][i & 127] = Q[(size_t)(q0 + (i >> 7)) * ld + h * HD + (i & 127)];
        float lg = 0.f; if (MODE == 0) lg = log1pf(-exp2f(-5.f - (float)h));
        unsigned sm = 0; if (MODE == 1) sm = sel[iq * 4 + h];
        float Fi = 0.f; if (MODE == 2) Fi = F[h * S + iq];
        float mrow = -INFINITY, lrow = 0.f, o[16];
        for (int i = 0; i < 16; ++i) o[i] = 0.f;
        const int npass = (MODE == 0) ? 1 : 3;
        for (int pass = 0; pass < npass; ++pass) {
            for (int kt = 0; kt <= qt; ++kt) {
                const int k0 = kt * 32;
                __syncthreads();
                for (int i = tid; i < 32 * HD; i += 256) { Ks[i >> 7][i & 127] = K[(size_t)(k0 + (i >> 7)) * ld + h * HD + (i & 127)]; Vs[i >> 7][i & 127] = V[(size_t)(k0 + (i >> 7)) * ld + h * HD + (i & 127)]; }
                __syncthreads();
                for (int jj = 0; jj < 4; ++jj) { const int kj = sub * 4 + jj, jk = k0 + kj; float d = 0.f;
                    for (int c = 0; c < HD; ++c) d += Qs[qi][c] * Ks[kj][c];
                    float s; bool valid = jk <= iq;
                    if (MODE == 0) { s = valid ? d * expf(lg * (float)(iq - jk)) : 0.f; }
                    else if (MODE == 1) { const int bq = iq >> 8, bk = jk >> 8; valid = valid && (bq == bk || ((sm >> bk) & 1u));
                        s = valid ? d * 0.08838834764831845f + relb[t5_bucket(iq - jk) * 4 + h] : -INFINITY; }
                    else { s = valid ? d * 0.08838834764831845f + (Fi - F[h * S + jk]) : -INFINITY; }
                    Ss[qi][kj] = s; }
                __syncthreads();
                if (MODE != 0 && pass == 0) { for (int j = 0; j < 32; ++j) mrow = fmaxf(mrow, Ss[qi][j]); }
                else if (MODE != 0 && pass == 1) { for (int j = 0; j < 32; ++j) lrow += expf(Ss[qi][j] - mrow); }
                else { for (int j = 0; j < 32; ++j) { const float w = (MODE == 0) ? Ss[qi][j] : expf(Ss[qi][j] - mrow) / lrow;
                        for (int i = 0; i < 16; ++i) o[i] += w * Vs[j][sub * 16 + i]; } }
            }
        }
        for (int i = 0; i < 16; ++i) O[(size_t)iq * ldo + h * HD + sub * 16 + i] = o[i];
        __syncthreads();
    }
}
__global__ void k_gn_gate(float* cat, int ldc, const float* proj, int ld, int gcol0, const float* gn) {
    __shared__ float red[128];
    for (int u = blockIdx.x; u < S * 4; u += gridDim.x) {
        const int h = u & 3, t = u >> 2, d = threadIdx.x; float* c = cat + (size_t)t * ldc + h * HD;
        const float v = c[d]; red[d] = v; __syncthreads();
        for (int o = 64; o > 0; o >>= 1) { if (d < o) red[d] += red[d + o]; __syncthreads(); }
        const float mu = red[0] / HD; __syncthreads();
        red[d] = (v - mu) * (v - mu); __syncthreads();
        for (int o = 64; o > 0; o >>= 1) { if (d < o) red[d] += red[d + o]; __syncthreads(); }
        const float var = red[0] / HD; __syncthreads();
        c[d] = (v - mu) * rsqrtf(var + 1e-5f) * gn[h * HD + d] * silu_f(proj[(size_t)t * ld + gcol0 + h * HD + d]);
    }
}
__global__ void k_swiglu(const float* gu, float* hbuf) {
    const size_t total = (size_t)S * FFH;
    for (size_t i = (size_t)blockIdx.x * blockDim.x + threadIdx.x; i < total; i += (size_t)gridDim.x * blockDim.x) {
        const size_t t = i / FFH, c = i % FFH; hbuf[i] = silu_f(gu[t * 2 * FFH + c]) * gu[t * 2 * FFH + FFH + c]; }
}
struct Bufs { float *hn, *proj, *cat, *m, *h, *kmean, *F; unsigned* sel; };
static void run_batch(const float* xb, float* ob, void* const* d_in, const Bufs& B, hipStream_t st) {
    const float* relb = (const float*)d_in[1]; const float* nmpre = (const float*)d_in[2]; const float* nmpost = (const float*)d_in[3];
    const float* nfpre = (const float*)d_in[4]; const float* nfpost = (const float*)d_in[5]; const float* ewin = (const float*)d_in[6]; const float* egn = (const float*)d_in[7];
    const float* ewout = (const float*)d_in[8]; const float* owin = (const float*)d_in[9]; const float* obf = (const float*)d_in[10]; const float* owout = (const float*)d_in[11];
    const float* fwin = (const float*)d_in[12]; const float* fwout = (const float*)d_in[13];
    const int G = 2048;
    k_rmsnorm<<<G, 256, 0, st>>>(xb, nmpre, nullptr, B.hn, S);
    k_gemm<<<G, 256, 0, st>>>(B.hn, ewin, B.proj, S, 3584, DM, 3584);
    k_rotary<<<G, 256, 0, st>>>(B.proj, 3584, 0, 4, 0.08838834764831845f);
    k_rotary<<<G, 256, 0, st>>>(B.proj, 3584, 512, 4, 1.f);
    k_attn<0><<<G, 256, 0, st>>>(B.proj, B.proj + 512, B.proj + 1024, 3584, B.cat, DM, 4, nullptr, nullptr, nullptr);
    k_gn_gate<<<G, 128, 0, st>>>(B.cat, DM, B.proj, 3584, 1536, egn);
    k_kmean<<<64, 128, 0, st>>>(B.proj, 3584, 2560, B.kmean);
    k_select<<<64, 256, 0, st>>>(B.proj, 3584, 2048, B.kmean, B.sel);
    k_attn<1><<<G, 256, 0, st>>>(B.proj + 2048, B.proj + 2560, B.proj + 3072, 3584, B.cat + 512, DM, 4, B.sel, relb, nullptr);
    k_gemm<<<G, 256, 0, st>>>(B.cat, ewout, B.m, S, DM, DM, DM);
    k_rmsnorm<<<G, 256, 0, st>>>(B.m, nmpost, xb, ob, S);
    k_rmsnorm<<<G, 256, 0, st>>>(ob, nfpre, nullptr, B.hn, S);
    k_gemm<<<G, 256, 0, st>>>(B.hn, fwin, B.proj, S, 2 * FFH, DM, 2 * FFH);
    k_swiglu<<<G, 256, 0, st>>>(B.proj, B.h);
    k_gemm<<<G, 256, 0, st>>>(B.h, fwout, B.m, S, DM, FFH, DM);
    k_rmsnorm<<<G, 256, 0, st>>>(B.m, nfpost, ob, ob, S);
    k_rmsnorm<<<G, 256, 0, st>>>(ob, nmpre + DM, nullptr, B.hn, S);
    k_gemm<<<G, 256, 0, st>>>(B.hn, owin, B.proj, S, 3080, DM, 3080);
    k_fcum<<<1, 64, 0, st>>>(B.proj, 3080, obf, B.F);
    k_attn<2><<<G, 256, 0, st>>>(B.proj, B.proj + 1024, B.proj + 2048, 3080, B.cat, DM, 8, nullptr, nullptr, B.F);
    k_gemm<<<G, 256, 0, st>>>(B.cat, owout, B.m, S, DM, DM, DM);
    k_rmsnorm<<<G, 256, 0, st>>>(B.m, nmpost + DM, ob, ob, S);
    k_rmsnorm<<<G, 256, 0, st>>>(ob, nfpre + DM, nullptr, B.hn, S);
    k_gemm<<<G, 256, 0, st>>>(B.hn, fwin + (size_t)DM * 2 * FFH, B.proj, S, 2 * FFH, DM, 2 * FFH);
    k_swiglu<<<G, 256, 0, st>>>(B.proj, B.h);
    k_gemm<<<G, 256, 0, st>>>(B.h, fwout + (size_t)FFH * DM, B.m, S, DM, FFH, DM);
    k_rmsnorm<<<G, 256, 0, st>>>(B.m, nfpost + DM, ob, ob, S);
}
static Bufs make_bufs(unsigned char* ws, size_t off) {
    Bufs B; float* f = (float*)(ws + off);
    B.hn = f; f += (size_t)S * DM; B.proj = f; f += (size_t)S * 5632; B.cat = f; f += (size_t)S * DM; B.m = f; f += (size_t)S * DM; B.h = f; f += (size_t)S * FFH;
    B.kmean = f; f += 4 * 16 * HD; B.F = f; f += 8 * S; B.sel = (unsigned*)f; return B;
}
}
extern "C" void kernel_launch(void* const* d_in, const int* in_sizes, int n_in, void* d_out, int out_size, void* d_ws, size_t ws_size, hipStream_t stream) {
    (void)in_sizes; (void)n_in; (void)out_size; (void)ws_size;
    nv::Bufs B = nv::make_bufs((unsigned char*)d_ws, 0);
    for (int b = 0; b < 8; ++b) nv::run_batch((const float*)d_in[0] + (size_t)b * 4096 * 1024, (float*)d_out + (size_t)b * 4096 * 1024, d_in, B, stream);
}
```

```cpp
#define N_LAUNCH_SPLIT 1
#include <hip/hip_runtime.h>
#include <hip/hip_bf16.h>
#include <hip/hip_cooperative_groups.h>
#include <cstdio>
#include <cstdint>
namespace cg = cooperative_groups;
#define LAS __attribute__((address_space(3)))
#define GAS __attribute__((address_space(1)))
#define XB_TMO      128
#define XB_XCNT(j)  (256  + 64 * (j))
#define XB_XSUB(j)  (1280 + 64 * (j))
#define XB_XGEN(j)  (2304 + 64 * (j))
#define XB_TOP      3328
#define XB_TOPGEN   3392
#define XCD_BAR_WORDS 3456
#define XB_SPIN_CAP (1u << 18)
__device__ __forceinline__ unsigned xb_ld(unsigned* p)              { return __hip_atomic_load(p, __ATOMIC_RELAXED, __HIP_MEMORY_SCOPE_AGENT); }
__device__ __forceinline__ unsigned xb_add(unsigned* p, unsigned v) { return __hip_atomic_fetch_add(p, v, __ATOMIC_RELAXED, __HIP_MEMORY_SCOPE_AGENT); }
__device__ __forceinline__ unsigned xb_xcc_id() { return (unsigned)__builtin_amdgcn_s_getreg((3 << 11) | 20) & 0xFu; }
#define XB_SPIN(cond, bar) do { unsigned _sp = 0; while (cond) { __builtin_amdgcn_s_sleep(1); \
    if ((++_sp & 255u) == 0u) { if (xb_ld(&(bar)[XB_TMO])) break; if (_sp > XB_SPIN_CAP) { atomicAdd(&(bar)[XB_TMO], 1u); break; } } } } while (0)
struct XcdBarrier { unsigned* bar; unsigned x; volatile LAS unsigned* st; };
__device__ __forceinline__ XcdBarrier xcd_barrier_post(unsigned* bar, volatile LAS unsigned* st) {
    XcdBarrier b; b.bar = bar; b.x = xb_xcc_id(); b.st = st;
    if (threadIdx.x == 0) (void)xb_add(&bar[XB_XCNT(b.x)], 1u);
    return b;
}
__device__ __forceinline__ void xcd_barrier_complete(unsigned* bar, unsigned x, unsigned& nloc, unsigned& nx) {
    const unsigned G = gridDim.x * gridDim.y * gridDim.z;
    unsigned sum, cnt, mine, sp = 0u;
    for (;;) {
        sum = 0u; cnt = 0u; mine = 0u;
#pragma unroll
        for (unsigned j = 0; j < 16; ++j) { const unsigned c = xb_ld(&bar[XB_XCNT(j)]); sum += c; cnt += (c > 0u) ? 1u : 0u; mine = (j == x) ? c : mine; }
        if (sum == G) break;
        __builtin_amdgcn_s_sleep(1);
        if ((++sp & 255u) == 0u) { if (xb_ld(&bar[XB_TMO])) break; if (sp > XB_SPIN_CAP) { atomicAdd(&bar[XB_TMO], 1u); break; } }
    }
    nloc = mine > 0u ? mine : 1u; nx = cnt > 0u ? cnt : 1u;
}
__device__ __forceinline__ void xcd_barrier(const XcdBarrier& b) {
    asm volatile("s_waitcnt vmcnt(0)" ::: "memory");
    __syncthreads();
    if (threadIdx.x == 0) {
        unsigned* bar = b.bar;
        __builtin_amdgcn_s_waitcnt(0);
        unsigned nloc = b.st[0], nx = b.st[1];
        if (nloc == 0u) { xcd_barrier_complete(bar, b.x, nloc, nx); b.st[0] = nloc; b.st[1] = nx; }
        const unsigned old = xb_add(&bar[XB_XSUB(b.x)], 1u);
        const unsigned gen = old / nloc;
        if (old + 1u == (gen + 1u) * nloc) {
            __builtin_amdgcn_fence(__ATOMIC_RELEASE, "agent");
            asm volatile("s_waitcnt vmcnt(0)" ::: "memory");
            const unsigned og = xb_add(&bar[XB_TOP], 1u);
            const unsigned tg = og / nx;
            if (og + 1u == (tg + 1u) * nx) xb_add(&bar[XB_TOPGEN], 1u);
            else XB_SPIN(xb_ld(&bar[XB_TOPGEN]) == tg, bar);
            __builtin_amdgcn_fence(__ATOMIC_ACQUIRE, "agent");
            xb_add(&bar[XB_XGEN(b.x)], 1u);
            asm volatile("s_waitcnt vmcnt(0)" ::: "memory");
        } else {
            XB_SPIN(xb_ld(&bar[XB_XGEN(b.x)]) == gen, bar);
            __builtin_amdgcn_fence(__ATOMIC_ACQUIRE, "agent");
            asm volatile("s_waitcnt vmcnt(0)" ::: "memory");
        }
    }
    __syncthreads();
}
namespace pg8 {
#define PG8_LAS __attribute__((address_space(3)))
typedef unsigned short bf16_t;
typedef short bf16x8 __attribute__((ext_vector_type(8)));
typedef float f32x4 __attribute__((ext_vector_type(4)));
typedef unsigned u32x4 __attribute__((ext_vector_type(4)));
constexpr int BM = 256, BK = 64, HALF = 128, HTB = HALF * BK * 2  , STAGE_BYTES = 8 * HTB, NXCD = 8, WGM = 8;

__host__ __device__ __forceinline__ int lds_byte(int r, int c) { const int st = (r >> 4) * 2 + (c >> 5), rr = r & 15, cc = c & 31, ob = rr * 64 + cc * 2; return st * 1024 + (ob ^ (((ob >> 9) & 1) << 5)); }
__host__ __device__ __forceinline__ void stage_rc(int b, int& R, int& C) { const int st = b / 1024, sb = b % 1024, swz = sb ^ (((sb >> 9) & 1) << 5); R = (st >> 1) * 16 + swz / 64; C = (st & 1) * 32 + (swz % 64) / 2; }
__host__ __device__ __forceinline__ int perm32(int rho) { const int n = rho >> 4, i = rho & 15; return 8 * (i >> 2) + 4 * n + (i & 3); }

struct Unit { int pm, pn; };
struct Gemm { const bf16_t* A; const bf16_t* Bt; int M, N, K; };

struct StaticOrder {
    int nM, nN, nwg, G, c;
    __host__ __device__ void init(int M, int N, int G_, int c_) { nM = M / BM; nN = N / BM; nwg = nM * nN; G = G_; c = c_; }
    __host__ __device__ bool next(int i, Unit& u) const {
        const long L = (long)i * G + c; if (L >= nwg) return false;
        int wgid = (int)L; { const int q = nwg / NXCD, r = nwg % NXCD, xcd = wgid % NXCD, off = wgid / NXCD; wgid = (xcd < r ? xcd * (q + 1) : r * (q + 1) + (xcd - r) * q) + off; }
        const int nig = WGM * nN, gid = wgid / nig, fm = gid * WGM, gsz = (nM - fm) < WGM ? (nM - fm) : WGM;
        u.pm = fm + ((wgid % nig) % gsz); u.pn = (wgid % nig) / gsz; return true;
    }
    __device__ __forceinline__ void a_ready(const Unit&) const {}
    __device__ __forceinline__ void done(const Unit&) const {}
};

__device__ __forceinline__ unsigned cvt_pk_bf16(float lo, float hi) { unsigned r; asm volatile("v_cvt_pk_bf16_f32 %0, %1, %2" : "=v"(r) : "v"(lo), "v"(hi)); return r; }
typedef float f32x2 __attribute__((ext_vector_type(2)));
struct EpiPlain {
    static constexpr bool PERM = true, AFTER_DRAIN = false;
    bf16_t* O; int ldc;
    __device__ __forceinline__ void operator()(const f32x4 (&acc)[2][2][4][2], const Unit& u, int wr, int wc, int fr, int fq) const {
        const int row0 = u.pm * BM + wr * 64 + fr, col0 = u.pn * BM + wc * 32 + 8 * fq;
#pragma unroll
        for (int ai = 0; ai < 2; ++ai)
#pragma unroll
            for (int m = 0; m < 4; ++m) { bf16_t* rowp = O + (size_t)(row0 + ai * HALF + m * 16) * ldc + col0;
#pragma unroll
                for (int bj = 0; bj < 2; ++bj) { const f32x4 v0 = acc[ai][bj][m][0], v1 = acc[ai][bj][m][1];
                    u32x4 w; w.x = cvt_pk_bf16(v0[0], v0[1]); w.y = cvt_pk_bf16(v0[2], v0[3]); w.z = cvt_pk_bf16(v1[0], v1[1]); w.w = cvt_pk_bf16(v1[2], v1[3]);
                    *(u32x4*)(rowp + bj * HALF) = w; } }
    }
};
struct EpiSwiglu {
    static constexpr bool PERM = true, AFTER_DRAIN = false;
    bf16_t* H; int ldh;
    __device__ __forceinline__ void operator()(const f32x4 (&acc)[2][2][4][2], const Unit& u, int wr, int wc, int fr, int fq) const {
        const int row0 = u.pm * BM + wr * 64 + fr, col0 = u.pn * HALF + wc * 32 + 8 * fq;
#pragma unroll
        for (int ai = 0; ai < 2; ++ai)
#pragma unroll
            for (int m = 0; m < 4; ++m) { bf16_t* rowp = H + (size_t)(row0 + ai * HALF + m * 16) * ldh + col0; float o[8];
#pragma unroll
                for (int n = 0; n < 2; ++n)
#pragma unroll
                    for (int i = 0; i < 4; ++i) { const float g = acc[ai][0][m][n][i], uu = acc[ai][1][m][n][i];
                        o[n * 4 + i] = g * __builtin_amdgcn_rcpf(1.f + __builtin_amdgcn_exp2f(-1.4426950408889634f * g)) * uu; }
                u32x4 w; w.x = cvt_pk_bf16(o[0], o[1]); w.y = cvt_pk_bf16(o[2], o[3]); w.z = cvt_pk_bf16(o[4], o[5]); w.w = cvt_pk_bf16(o[6], o[7]);
                *(u32x4*)rowp = w; }
    }
};
template <int NH, bool ROT, int TOKA> struct EpiHeads {
    static constexpr bool PERM = true, AFTER_DRAIN = false;
    static constexpr int TPA = NH / 2;
    bf16_t* base; size_t astride; const float* cs; const float* sn; float qscale;
    __device__ __forceinline__ void operator()(const f32x4 (&acc)[2][2][4][2], const Unit& u, int wr, int wc, int fr, int fq) const {
        const int a = u.pn / TPA, hp = u.pn % TPA, b = u.pm >> 4, s0 = (u.pm & 15) * BM + wr * 64 + fr, d0 = wc * 32 + 8 * fq;
        bf16_t* ab = base + (size_t)a * astride;
        const bool rot = ROT && a < 2; const float sc = (ROT && a == 0) ? qscale : 1.f;
#pragma unroll
        for (int ai = 0; ai < 2; ++ai)
#pragma unroll
            for (int m = 0; m < 4; ++m) { const int s = s0 + ai * HALF + m * 16;
                f32x4 c4 = {1.f, 1.f, 1.f, 1.f}, s4 = {0.f, 0.f, 0.f, 0.f};
                if (rot) { c4 = *(const f32x4*)(cs + (size_t)s * 64 + 4 * (4 * wc + fq)); s4 = *(const f32x4*)(sn + (size_t)s * 64 + 4 * (4 * wc + fq)); }
#pragma unroll
                for (int bj = 0; bj < 2; ++bj) { f32x4 v0 = acc[ai][bj][m][0], v1 = acc[ai][bj][m][1];
                    if (rot) { const f32x4 o1 = (v0 * c4 - v1 * s4) * sc, o2 = (v0 * s4 + v1 * c4) * sc; v0 = o1; v1 = o2; }
                    u32x4 w; w.x = cvt_pk_bf16(v0[0], v0[1]); w.y = cvt_pk_bf16(v0[2], v0[3]); w.z = cvt_pk_bf16(v1[0], v1[1]); w.w = cvt_pk_bf16(v1[2], v1[3]);
                    const int head = 2 * hp + bj;
                    bf16_t* dst = (a == TOKA) ? ab + (size_t)(b * 4096 + s) * (NH * 128) + head * 128 + d0
                                              : ab + ((size_t)(b * NH + head) * 4096 + s) * 128 + d0;
                    *(u32x4*)dst = w; } }
    }
};
template <class Epi, class Sched, bool ALIGN_EPI = false, bool SP2 = false>
__device__ __forceinline__ void gemm_phase(PG8_LAS unsigned char* lds, const Gemm g, const Sched& S, const Epi& E) {
    const int tid = threadIdx.x, wid = __builtin_amdgcn_readfirstlane(tid >> 6), lane = tid & 63, wr = wid >> 2, wc = wid & 3, fr = lane & 15, fq = lane >> 4;
    const int K = g.K, nt = K / BK;
    unsigned voffA[2], voffB[2];
#pragma unroll
    for (int i = 0; i < 2; ++i) { int R, C; stage_rc(tid * 16 + i * 8192, R, C); const int Rb = Epi::PERM ? ((R & ~31) + perm32(R & 31)) : R;
        voffA[i] = (unsigned)(R * K + C) * 2u; voffB[i] = (unsigned)(Rb * K + C) * 2u; }
    const size_t kstep = (size_t)(BK * 2);
    const size_t hstep = (size_t)HALF * K * 2;
    const size_t tstep = 2 * hstep;
    const unsigned ldsw = (unsigned)wid * 1024u;
    const int aoff = lds_byte(wr * 64 + fr, fq * 8), boff = lds_byte(wc * 32 + fr, fq * 8);
#define PG8_SA(b, h) (((b) * 2 + (h)) * HTB)
#define PG8_SB(b, h) ((4 + (b) * 2 + (h)) * HTB)
#define PG8_STAGE(bufoff, gbase, voff) do { _Pragma("unroll") for (int _i = 0; _i < 2; ++_i) \
        __builtin_amdgcn_global_load_lds((const unsigned*)((const char*)(gbase) + (voff)[_i]), (PG8_LAS unsigned*)(lds + (bufoff) + ldsw + _i * 8192), 16, 0, 0); } while (0)
#define PG8_LDA(dst, b, h) do { _Pragma("unroll") for (int m = 0; m < 4; ++m) _Pragma("unroll") for (int k = 0; k < 2; ++k) dst[m][k] = *(const PG8_LAS bf16x8*)(lds + PG8_SA(b, h) + aoff + m * 2048 + k * 1024); } while (0)
#define PG8_LDB(dst, b, h) do { _Pragma("unroll") for (int n = 0; n < 2; ++n) _Pragma("unroll") for (int k = 0; k < 2; ++k) dst[n][k] = *(const PG8_LAS bf16x8*)(lds + PG8_SB(b, h) + boff + n * 2048 + k * 1024); } while (0)
#define PG8_MMA(ai, bj, At, Bt) do { __builtin_amdgcn_s_setprio(1); _Pragma("unroll") for (int m = 0; m < 4; ++m) _Pragma("unroll") for (int n = 0; n < 2; ++n) _Pragma("unroll") for (int k = 0; k < 2; ++k) \
        acc[ai][bj][m][n] = __builtin_amdgcn_mfma_f32_16x16x32_bf16(Bt[n][k], At[m][k], acc[ai][bj][m][n], 0, 0, 0); __builtin_amdgcn_s_setprio(0); } while (0)
#define PG8_WAIT_V(n) asm volatile("s_waitcnt vmcnt(" #n ")" ::: "memory")
#define PG8_WAIT_L(n) asm volatile("s_waitcnt lgkmcnt(" #n ")" ::: "memory")
#define PG8_BAR __builtin_amdgcn_s_barrier()
#define PG8_SCHED __builtin_amdgcn_sched_barrier(0)
    Unit cur, nxt; int ui = 0;
    if (!S.next(0, cur)) return;
    f32x4 acc[2][2][4][2];
#pragma unroll
    for (int a = 0; a < 2; ++a)
#pragma unroll
        for (int b = 0; b < 2; ++b)
#pragma unroll
            for (int m = 0; m < 4; ++m)
#pragma unroll
                for (int n = 0; n < 2; ++n) acc[a][b][m][n] = (f32x4){0.f, 0.f, 0.f, 0.f};
    bf16x8 At[4][2], B0[2][2], B1[2][2];
    const char* cA = (const char*)g.A + (size_t)cur.pm * tstep; const char* cB = (const char*)g.Bt + (size_t)cur.pn * tstep;
    S.a_ready(cur);
    if constexpr (SP2) {
        PG8_STAGE(PG8_SB(0, 0), cB, voffB); PG8_STAGE(PG8_SB(0, 1), cB + hstep, voffB); PG8_STAGE(PG8_SA(0, 0), cA, voffA); PG8_STAGE(PG8_SA(0, 1), cA + hstep, voffA);
        if (wr == 1) PG8_BAR;
        PG8_WAIT_V(2); PG8_BAR;
        PG8_STAGE(PG8_SB(1, 0), cB + kstep, voffB); PG8_STAGE(PG8_SA(1, 0), cA + kstep, voffA); PG8_STAGE(PG8_SB(1, 1), cB + hstep + kstep, voffB);
        PG8_WAIT_V(6); PG8_BAR;
    } else {
        PG8_STAGE(PG8_SB(0, 0), cB, voffB); PG8_STAGE(PG8_SA(0, 0), cA, voffA); PG8_STAGE(PG8_SB(0, 1), cB + hstep, voffB); PG8_STAGE(PG8_SA(0, 1), cA + hstep, voffA);
        if (wr == 1) PG8_BAR;
        PG8_WAIT_V(4); PG8_BAR;
        PG8_STAGE(PG8_SB(1, 0), cB + kstep, voffB); PG8_STAGE(PG8_SA(1, 0), cA + kstep, voffA); PG8_STAGE(PG8_SB(1, 1), cB + hstep + kstep, voffB);
        PG8_WAIT_V(6); PG8_BAR;
    }
    for (;;) {
        const bool has_next = S.next(ui + 1, nxt);
        const char* nA = has_next ? (const char*)g.A + (size_t)nxt.pm * tstep : cA; const char* nB = has_next ? (const char*)g.Bt + (size_t)nxt.pn * tstep : cB;
        for (int t = 0; t < nt; t += 2) {
            const bool last = (t == nt - 2);
            const char* a1 = cA + (size_t)(t + 1) * kstep;
            const char* a2 = last ? nA : cA + (size_t)(t + 2) * kstep; const char* b2 = last ? nB : cB + (size_t)(t + 2) * kstep;
            const char* a3 = a2 + kstep; const char* b3 = b2 + kstep;
            if (last && has_next) S.a_ready(nxt);
            if constexpr (SP2) {
            PG8_LDB(B0, 0, 0); PG8_LDB(B1, 0, 1); PG8_SCHED; PG8_LDA(At, 0, 0); PG8_STAGE(PG8_SA(1, 1), a1 + hstep, voffA);
            PG8_WAIT_V(8); PG8_WAIT_L(0); PG8_BAR; PG8_MMA(0, 0, At, B0); PG8_MMA(0, 1, At, B1); PG8_BAR; PG8_SCHED;
            PG8_LDA(At, 0, 1); PG8_STAGE(PG8_SB(0, 0), b2, voffB); PG8_STAGE(PG8_SB(0, 1), b2 + hstep, voffB); PG8_STAGE(PG8_SA(0, 0), a2, voffA);
            PG8_WAIT_V(8); PG8_WAIT_L(0); PG8_BAR; PG8_MMA(1, 0, At, B0); PG8_MMA(1, 1, At, B1); PG8_BAR; PG8_SCHED;
            PG8_LDB(B0, 1, 0); PG8_LDB(B1, 1, 1); PG8_SCHED; PG8_LDA(At, 1, 0); PG8_STAGE(PG8_SA(0, 1), a2 + hstep, voffA);
            PG8_WAIT_V(8); PG8_WAIT_L(0); PG8_BAR; PG8_MMA(0, 0, At, B0); PG8_MMA(0, 1, At, B1); PG8_BAR; PG8_SCHED;
            PG8_LDA(At, 1, 1); PG8_STAGE(PG8_SB(1, 0), b3, voffB); PG8_STAGE(PG8_SB(1, 1), b3 + hstep, voffB); PG8_STAGE(PG8_SA(1, 0), a3, voffA);
            PG8_WAIT_V(8); PG8_WAIT_L(0); PG8_BAR; PG8_MMA(1, 0, At, B0); PG8_MMA(1, 1, At, B1); PG8_BAR; PG8_SCHED;
            } else {
            PG8_LDB(B0, 0, 0); PG8_SCHED; PG8_LDA(At, 0, 0); PG8_STAGE(PG8_SA(1, 1), a1 + hstep, voffA);
            PG8_WAIT_L(8); PG8_BAR; PG8_WAIT_L(0); PG8_MMA(0, 0, At, B0); PG8_BAR; PG8_SCHED;
            PG8_LDB(B1, 0, 1); PG8_STAGE(PG8_SB(0, 0), b2, voffB);
            PG8_BAR; PG8_WAIT_L(0); PG8_MMA(0, 1, At, B1); PG8_BAR;
            PG8_LDA(At, 0, 1); PG8_STAGE(PG8_SA(0, 0), a2, voffA);
            PG8_BAR; PG8_WAIT_L(0); PG8_MMA(1, 0, At, B0); PG8_BAR; PG8_SCHED;
            PG8_STAGE(PG8_SB(0, 1), b2 + hstep, voffB);
            PG8_WAIT_V(6); PG8_BAR; PG8_MMA(1, 1, At, B1); PG8_BAR;
            PG8_LDB(B0, 1, 0); PG8_SCHED; PG8_LDA(At, 1, 0); PG8_STAGE(PG8_SA(0, 1), a2 + hstep, voffA);
            PG8_WAIT_L(8); PG8_BAR; PG8_WAIT_L(0); PG8_MMA(0, 0, At, B0); PG8_BAR; PG8_SCHED;
            PG8_LDB(B1, 1, 1); PG8_STAGE(PG8_SB(1, 0), b3, voffB);
            PG8_BAR; PG8_WAIT_L(0); PG8_MMA(0, 1, At, B1); PG8_BAR;
            PG8_LDA(At, 1, 1); PG8_STAGE(PG8_SA(1, 0), a3, voffA);
            PG8_BAR; PG8_WAIT_L(0); PG8_MMA(1, 0, At, B0); PG8_BAR; PG8_SCHED;
            PG8_STAGE(PG8_SB(1, 1), b3 + hstep, voffB);
            PG8_WAIT_V(6); PG8_BAR; PG8_MMA(1, 1, At, B1); PG8_BAR;
            }
        }
        if constexpr (ALIGN_EPI) { if (wr == 0) PG8_BAR; }
        if constexpr (!Epi::AFTER_DRAIN) { E(acc, cur, wr, wc, fr, fq); S.done(cur); }
        if (!has_next) break;
#pragma unroll
        for (int a = 0; a < 2; ++a)
#pragma unroll
            for (int b = 0; b < 2; ++b)
#pragma unroll
                for (int m = 0; m < 4; ++m)
#pragma unroll
                    for (int n = 0; n < 2; ++n) acc[a][b][m][n] = (f32x4){0.f, 0.f, 0.f, 0.f};
        cur = nxt; cA = nA; cB = nB; ++ui;
        if constexpr (ALIGN_EPI) { if (wr == 1) PG8_BAR; }
    }
    PG8_WAIT_V(0);
    if constexpr (!ALIGN_EPI) { if (wr == 0) PG8_BAR; }
    PG8_BAR;
    if constexpr (Epi::AFTER_DRAIN) { E.fused(acc, cur, wr, wc, fr, fq, lds, wid, lane); S.done(cur); }
#undef PG8_SA
#undef PG8_SB
#undef PG8_STAGE
#undef PG8_LDA
#undef PG8_LDB
#undef PG8_MMA
#undef PG8_WAIT_V
#undef PG8_WAIT_L
#undef PG8_BAR
#undef PG8_SCHED
}
}
namespace att {
#define QKT_SPLIT 1
#ifndef CINIT_TEST
#define CINIT_TEST 0
#endif
using bf16 = __hip_bfloat16;
typedef short bf16x8 __attribute__((ext_vector_type(8)));
typedef short s16x4 __attribute__((ext_vector_type(4)));
typedef float f32x16 __attribute__((ext_vector_type(16)));
typedef float f32x4 __attribute__((ext_vector_type(4)));
typedef unsigned u32x4 __attribute__((ext_vector_type(4)));
constexpr int D = 128, NW = 8, QBLK = 32, KVBLK = 64, QB = NW * QBLK, SEQ = 4096;
constexpr int SHM_V = KVBLK * D * 2, SHM_K = KVBLK * D * 2;
constexpr int OFF_WS = 2 * SHM_V + 2 * SHM_K;
constexpr int OFF_LUT = OFF_WS + NW * 64 * 4;
constexpr int LUT_FLOATS = 4 * 512 + 64;
constexpr int OFF_G = OFF_LUT + LUT_FLOATS * 4;
constexpr int LDS_BYTES = OFF_G + 2 * 64 * 4;
constexpr float SCALE = 0.08838834764831845f, INV_SCALE = 11.313708498984761f, THR = 8.f;
constexpr int OSTR = 1024;

#define KSWZ(row, colB) ((row) * 256 + ((colB) ^ (((row) & 7) << 4)))
#define SBAR() __builtin_amdgcn_sched_barrier(0)
__device__ __forceinline__ int v_st(int k, int c) { const int kk = (k & ~0xC) | ((k & 4) << 1) | ((k & 8) >> 1); return ((kk >> 3) * 4 + (c >> 5)) * 512 + ((kk & 7) * 32 + (c & 31)) * 2; }
__device__ __forceinline__ int v_rd_base(int lane) { return ((lane & 3) << 3) | (((lane >> 2) & 3) << 6) | (((lane >> 4) & 1) << 5) | (((lane >> 5) & 1) << 8); }
constexpr int v_rd_off(int d0, int ks, int half) { return d0 * 512 + ks * 4096 + half * 2048; }
__device__ __forceinline__ int crow(int r, int hi) { return (r & 3) + 8 * (r >> 2) + 4 * hi; }
__device__ __forceinline__ unsigned cvtpk(float lo, float hi) { unsigned r; asm volatile("v_cvt_pk_bf16_f32 %0, %1, %2" : "=v"(r) : "v"(lo), "v"(hi)); return r; }
__device__ __forceinline__ bf16x8 load8(const bf16* p) { return *reinterpret_cast<const bf16x8*>(p); }
__device__ __forceinline__ void mask_tile(f32x16& p0, f32x16& p1, int dq) {
    const float NEG = -__builtin_inff();
#pragma unroll
    for (int r = 0; r < 16; ++r) { const int c = (r & 3) + 8 * (r >> 2);
        if (dq - c < 0) p0[r] = NEG;
        if (dq - c - 32 < 0) p1[r] = NEG; }
}
__device__ __forceinline__ void partialSM(f32x16& p0, f32x16& p1, float& m_reg, float& mn, float& alpha) {
    float pmax = p0[0]; for (int r = 1; r < 16; ++r) pmax = fmaxf(pmax, p0[r]); for (int r = 0; r < 16; ++r) pmax = fmaxf(pmax, p1[r]);
    { auto rr = __builtin_amdgcn_permlane32_swap(__float_as_uint(pmax), __float_as_uint(pmax), false, false);
      pmax = fmaxf(__uint_as_float(rr[0]), __uint_as_float(rr[1])); }
    constexpr float C2 = 1.4426950408889634f * SCALE;
    if (__builtin_expect(__all((pmax - m_reg) * SCALE <= THR), 1)) { mn = m_reg; alpha = 1.f; }
    else { mn = fmaxf(m_reg, pmax); alpha = __builtin_amdgcn_exp2f((m_reg - mn) * C2); m_reg = mn; }
    const float mnL = -mn * C2;
    for (int r = 0; r < 16; ++r) p0[r] = fmaf(p0[r], C2, mnL); for (int r = 0; r < 16; ++r) p1[r] = fmaf(p1[r], C2, mnL);
    for (int r = 0; r < 16; ++r) p0[r] = __builtin_amdgcn_exp2f(p0[r]);
}
#define ATT_PK4(P, B_, OUT) do { unsigned a0 = cvtpk(P[B_+0], P[B_+1]), a1 = cvtpk(P[B_+2], P[B_+3]);                          \
        unsigned b0 = cvtpk(P[B_+4], P[B_+5]), b1 = cvtpk(P[B_+6], P[B_+7]);                                             \
        auto r0 = __builtin_amdgcn_permlane32_swap(a0, b0, false, false); auto r1 = __builtin_amdgcn_permlane32_swap(a1, b1, false, false); \
        u32x4 w = {r0[0], r1[0], r0[1], r1[1]}; OUT = *reinterpret_cast<bf16x8*>(&w); } while (0)
__device__ __forceinline__ void finishSM(f32x16& p0, f32x16& p1, float alpha, float& l_reg, bf16x8& pa0, bf16x8& pa1, bf16x8& pa2, bf16x8& pa3) {
    for (int r = 0; r < 16; ++r) p1[r] = __builtin_amdgcn_exp2f(p1[r]);
    float ps = 0; for (int r = 0; r < 16; ++r) ps += p0[r]; for (int r = 0; r < 16; ++r) ps += p1[r];
    { auto rr = __builtin_amdgcn_permlane32_swap(__float_as_uint(ps), __float_as_uint(ps), false, false);
      ps = __uint_as_float(rr[0]) + __uint_as_float(rr[1]); }
    l_reg = l_reg * alpha + ps;
    ATT_PK4(p0, 0, pa0); ATT_PK4(p0, 8, pa1); ATT_PK4(p1, 0, pa2); ATT_PK4(p1, 8, pa3);
}
__device__ __forceinline__ void qkt(f32x16& p0, f32x16& p1, const char* K_tile, int r32, int hi, const bf16x8* qr) {
    const char* kb[4];
#pragma unroll
    for (int dd = 0; dd < 4; ++dd) kb[dd] = K_tile + KSWZ(r32, (dd * 16 + hi * 8) * 2);
#pragma unroll
    for (int d0 = 0; d0 < 8; ++d0) { const char* a = kb[d0 & 3] + (d0 >> 2) * 128;
        bf16x8 b0 = *reinterpret_cast<const bf16x8*>(a);
        bf16x8 b1 = *reinterpret_cast<const bf16x8*>(a + 32 * 256);
        p0 = __builtin_amdgcn_mfma_f32_32x32x16_bf16(b0, qr[d0], p0, 0, 0, 0);
        p1 = __builtin_amdgcn_mfma_f32_32x32x16_bf16(b1, qr[d0], p1, 0, 0, 0);
#ifdef QKT_SPLIT
        if (d0 == 3) SBAR();
#endif
    }
}
template <int VOFF>
__device__ __forceinline__ void pv_tile(f32x16* o, int vb0, bf16x8 pa0, bf16x8 pa1, bf16x8 pa2, bf16x8 pa3) {
#define TRRD(dst, off) asm volatile("ds_read_b64_tr_b16 %0, %1 offset:%2" : "=&v"(dst) : "v"(vb0), "i"(off) : "memory")
#define PV_D0(d0) do { s16x4 l0, l1, l2, l3, h0, h1, h2, h3; constexpr int b_ = VOFF + v_rd_off(d0, 0, 0); \
        TRRD(l0, b_); TRRD(h0, b_ + 2048); TRRD(l1, b_ + 4096); TRRD(h1, b_ + 6144); TRRD(l2, b_ + 8192); TRRD(h2, b_ + 10240); TRRD(l3, b_ + 12288); TRRD(h3, b_ + 14336); \
        asm volatile("s_waitcnt lgkmcnt(0)" ::: "memory"); SBAR();   \
        o[d0] = __builtin_amdgcn_mfma_f32_32x32x16_bf16(pa0, (bf16x8){l0[0], l0[1], l0[2], l0[3], h0[0], h0[1], h0[2], h0[3]}, o[d0], 0, 0, 0);   \
        o[d0] = __builtin_amdgcn_mfma_f32_32x32x16_bf16(pa1, (bf16x8){l1[0], l1[1], l1[2], l1[3], h1[0], h1[1], h1[2], h1[3]}, o[d0], 0, 0, 0);   \
        o[d0] = __builtin_amdgcn_mfma_f32_32x32x16_bf16(pa2, (bf16x8){l2[0], l2[1], l2[2], l2[3], h2[0], h2[1], h2[2], h2[3]}, o[d0], 0, 0, 0);   \
        o[d0] = __builtin_amdgcn_mfma_f32_32x32x16_bf16(pa3, (bf16x8){l3[0], l3[1], l3[2], l3[3], h3[0], h3[1], h3[2], h3[3]}, o[d0], 0, 0, 0); } while (0)
    PV_D0(0); PV_D0(1); PV_D0(2); PV_D0(3);
#undef PV_D0
#undef TRRD
}

struct ABase { const bf16* Q; const bf16* K; const bf16* V; bf16* O; const float* F; const unsigned* sel; int nh, ocol0; };
struct ADesc { __amdgpu_buffer_rsrc_t q, k, v, f; };
struct AItem { int bh, qb; };
#define A_HB(it)  ((size_t)(it).bh * SEQ * D)
#define A_Q(it)   (B.Q + A_HB(it) + (size_t)(it).qb * QB * D)
#define A_K(it)   (B.K + A_HB(it))
#define A_V(it)   (B.V + A_HB(it))
#define A_F(it)   (B.F + (size_t)(it).bh * SEQ)
#define A_O(it)   (B.O + ((size_t)((it).bh / B.nh) * SEQ + (size_t)(it).qb * QB) * OSTR + B.ocol0 + ((it).bh % B.nh) * D)
#define A_SEL(it) (B.sel + (size_t)(it).bh * SEQ + (size_t)(it).qb * QB)
#define A_P0(it)  ((it).qb * QB)
struct Seam { bf16x8 qr[8]; bf16x8 st_v0, st_v1, st_k0, st_k1; float st_g; };
template <int MODE> __device__ __forceinline__ int first_kb(int P0) { return MODE == 0 ? P0 + QB - KVBLK : 0; }
#define VMW() asm volatile("s_waitcnt vmcnt(0)" ::: "memory")
#define VMWN(n) asm volatile("s_waitcnt vmcnt(%0)" :: "i"(n) : "memory")
#define BL16(rs, vo, so) __builtin_bit_cast(bf16x8, __builtin_amdgcn_raw_buffer_load_b128((rs), (int)(vo), (int)(so), 0))
#define SLOAD_H(it, k0) do { const unsigned so_ = (unsigned)(((it).bh * SEQ + (k0)) * D * 2);                                                  \
                         S.st_v0 = BL16(DS.v, loff, so_); S.st_v1 = BL16(DS.v, loff, so_ + 32 * D * 2);                                     \
                         S.st_k0 = BL16(DS.k, loff, so_); S.st_k1 = BL16(DS.k, loff, so_ + 32 * D * 2);                                     \
                         if (MODE == 0) S.st_g = __builtin_bit_cast(float, __builtin_amdgcn_raw_buffer_load_b32(DS.f, (int)((tid & 63u) * 4u), (int)(((it).bh * SEQ + (k0)) * 4), 0)); } while (0)
#define QLOAD(it) do { const unsigned so_ = (unsigned)((((it).bh * SEQ) + (it).qb * QB) * D * 2);                                              \
                         _Pragma("unroll") for (int d0 = 0; d0 < 8; ++d0) S.qr[d0] = BL16(DS.q, qoff + d0 * 32, so_); } while (0)
#define SWRITE_HK(bf) do { *(bf16x8*)(K_lds + (bf) * SHM_K + kws) = S.st_k0; *(bf16x8*)(K_lds + (bf) * SHM_K + kws + 32 * 256) = S.st_k1; \
                           if (MODE == 0 && tid < 64) ((float*)(lds + OFF_G))[(bf) * 64 + tid] = S.st_g; } while (0)
#define SWRITE_HV(bf) do { *(bf16x8*)(V_lds + (bf) * SHM_V + vst0) = S.st_v0; *(bf16x8*)(V_lds + (bf) * SHM_V + vst1) = S.st_v1; } while (0)
#define SWRITE_H(bf) do { SWRITE_HV(bf); SWRITE_HK(bf); } while (0)
template <int MODE>
__device__ __forceinline__ void attn_prime(const ABase& B, const ADesc& DS, const AItem& cur, char* lds, Seam& S) {
    const int tid = threadIdx.x, wid = __builtin_amdgcn_readfirstlane(tid >> 6), lane = tid & 63, r32 = lane & 31, hi = lane >> 5;
    const int sr = tid >> 4, sc = (tid & 15) * 8, kws = KSWZ(sr, sc * 2); char* K_lds = lds + 2 * SHM_V; const unsigned loff = (unsigned)(sr * D + sc) * 2u, qoff = (unsigned)((wid * QBLK + r32) * D + hi * 8) * 2u;
    const int kb0 = first_kb<MODE>(A_P0(cur));
    QLOAD(cur);
    SLOAD_H(cur, kb0); VMW(); SWRITE_HK(0);
    __syncthreads();
}
template <int MODE>
__device__ __forceinline__ void attn_block(const ABase& B, const ADesc& DS, const AItem& cur, const AItem& nxt, char* lds, Seam& S) {
    const int tid = threadIdx.x, wid = __builtin_amdgcn_readfirstlane(tid >> 6), lane = tid & 63, r32 = lane & 31, hi = lane >> 5;
    const int P0 = A_P0(cur), NT = (P0 + QB) / KVBLK;
    const int kbn = first_kb<MODE>(A_P0(nxt));
    const int qlo = P0 + wid * QBLK, qm = qlo + r32 - 4 * hi;
    char* V_lds = lds; char* K_lds = lds + 2 * SHM_V;
    float* ws = (float*)(lds + OFF_WS) + wid * 64; float* li_l = ws, * al_l = ws + 32;
    float m_reg = -1e30f, l_reg = 0; f32x16 o[4] = {};
    const int sr = tid >> 4, sc = (tid & 15) * 8, vst0 = v_st(sr, sc), vst1 = v_st(32 + sr, sc), kws = KSWZ(sr, sc * 2);
    const unsigned loff = (unsigned)(sr * D + sc) * 2u, qoff = (unsigned)((wid * QBLK + r32) * D + hi * 8) * 2u;
    const int vb0 = (int)(uintptr_t)V_lds + v_rd_base(lane);
    const float* Fh = A_F(cur);
    const float* lut = (const float*)(lds + OFF_LUT) + (cur.bh % B.nh) * 512 + 256;
    unsigned selrow = 0; const int own = P0 >> 8;
    if (MODE == 1) { selrow = A_SEL(cur)[wid * QBLK + r32] | (1u << own); }
#define RESC(a) do { if (__any((a) < 1.f)) { if (hi == 0) al_l[r32] = (a); asm volatile("s_waitcnt lgkmcnt(0)" ::: "memory");              \
                     for (int d_ = 0; d_ < 4; ++d_) for (int r = 0; r < 16; ++r) o[d_][r] *= al_l[crow(r, hi)]; } } while (0)
#define KBASE(t) (MODE == 0 ? (NT - 1 - (t)) * KVBLK : (t) * KVBLK)
#define MASKT(P0_, P1_, t) do { const int kb_ = KBASE(t); if (kb_ + KVBLK - 1 > qlo) mask_tile(P0_, P1_, qm - kb_); } while (0)
#define CINIT(P0_, P1_, t, KB) do { const int kb_ = KBASE(t);                                                                               \
        if (MODE == 0) { const float* fp_ = (const float*)(lds + OFF_G) + (KB) * 64 + 4 * hi;                                               \
            _Pragma("unroll") for (int g_ = 0; g_ < 4; ++g_) { const f32x4 a_ = *(const f32x4*)(fp_ + 8 * g_), b_ = *(const f32x4*)(fp_ + 32 + 8 * g_);   \
                _Pragma("unroll") for (int i_ = 0; i_ < 4; ++i_) { P0_[4 * g_ + i_] = a_[i_]; P1_[4 * g_ + i_] = b_[i_]; } } }   \
        else { const bool keep_ = (selrow >> (kb_ >> 8)) & 1u; const float NEG_ = -__builtin_inff();                                         \
            if (CINIT_TEST == 1 || (CINIT_TEST == 0 && qlo - kb_ - (KVBLK - 1) >= 113)) { const float v_ = keep_ ? lut[127] : NEG_;                                                  \
                _Pragma("unroll") for (int r_ = 0; r_ < 16; ++r_) { P0_[r_] = v_; P1_[r_] = v_; } }                                          \
            else { const float* lp_ = keep_ ? lut + (qlo + r32 - kb_ - 4 * hi - 59) : (const float*)(lds + OFF_LUT) + 2048;                  \
                _Pragma("unroll") for (int r_ = 0; r_ < 16; ++r_) { const int c_ = (r_ & 3) + 8 * (r_ >> 2);                                 \
                    P0_[r_] = lp_[59 - c_]; P1_[r_] = lp_[27 - c_]; } } } } while (0)
    constexpr int NQL = 8;
#define SEAM_K0() do { VMWN(NQL); SWRITE_HK(0); SBAR(); } while (0)
    f32x16 pA0, pA1, pB0, pB1; float mnA, mnB, alA, alB; bf16x8 pa0, pa1, pa2, pa3;
    SWRITE_HV(0); SBAR();
    CINIT(pA0, pA1, 0, 0);
    SLOAD_H(cur, KBASE(1));
    SBAR(); qkt(pA0, pA1, K_lds, r32, hi, S.qr);
    MASKT(pA0, pA1, 0); partialSM(pA0, pA1, m_reg, mnA, alA);
    VMW(); SWRITE_H(1);
    __syncthreads();
#define HALF_STEP(PX0, PX1, mnX, alX, PY0, PY1, alY, t, KB, VB, SB) do {                                                      \
        SBAR(); CINIT(PX0, PX1, (t), (KB)); qkt(PX0, PX1, K_lds + (KB) * SHM_K, r32, hi, S.qr);                                   \
        finishSM(PY0, PY1, alY, l_reg, pa0, pa1, pa2, pa3); SBAR();                                                           \
        if ((t) + 1 < NT) { SLOAD_H(cur, KBASE((t) + 1)); SBAR(); }                                       \
        pv_tile<(VB) * SHM_V>(o, vb0, pa0, pa1, pa2, pa3); MASKT(PX0, PX1, (t)); partialSM(PX0, PX1, m_reg, mnX, alX);         \
        __syncthreads();                                                                                                      \
        if ((t) + 1 < NT) { VMW(); SWRITE_H(SB); }                                                                            \
        RESC(alX); __syncthreads(); } while (0)
    for (int t = 1; t + 1 < NT; t += 2) {
        HALF_STEP(pB0, pB1, mnB, alB, pA0, pA1, alA, t, 1, 0, 0);
        HALF_STEP(pA0, pA1, mnA, alA, pB0, pB1, alB, t + 1, 0, 1, 1);
    }
    SBAR(); CINIT(pB0, pB1, NT - 1, 1); qkt(pB0, pB1, K_lds + SHM_K, r32, hi, S.qr); SBAR();
    SLOAD_H(nxt, kbn); SBAR();
    QLOAD(nxt);
    SBAR();
    finishSM(pA0, pA1, alA, l_reg, pa0, pa1, pa2, pa3); SBAR();
    pv_tile<0>(o, vb0, pa0, pa1, pa2, pa3);
    MASKT(pB0, pB1, NT - 1); partialSM(pB0, pB1, m_reg, mnB, alB); __syncthreads(); RESC(alB);
    finishSM(pB0, pB1, alB, l_reg, pa0, pa1, pa2, pa3); SBAR(); pv_tile<SHM_V>(o, vb0, pa0, pa1, pa2, pa3);
    SBAR(); SEAM_K0();
    if (hi == 0) li_l[r32] = l_reg; asm volatile("s_waitcnt lgkmcnt(0)" ::: "memory");
    float rli[16];
#pragma unroll
    for (int r = 0; r < 16; ++r) rli[r] = __builtin_amdgcn_rcpf(li_l[crow(r, hi)]);
    bf16* Ow = A_O(cur) + (size_t)(wid * QBLK) * OSTR; const unsigned ooff = (unsigned)(4 * hi * OSTR + r32);
#pragma unroll
    for (int r = 0; r < 16; ++r) { const int orow = crow(r, hi);
#pragma unroll
        for (int d0 = 0; d0 < 4; ++d0) { const float v = o[d0][r] * rli[r];
            const float vn = __shfl_xor(v, 1);
            if ((r32 & 1) == 0) *(unsigned*)(Ow + ((r & 3) + 8 * (r >> 2)) * OSTR + d0 * 32 + ooff) = cvtpk(v, vn); } }
    __syncthreads();
#undef RESC
#undef KBASE
#undef MASKT
#undef CINIT
#undef SEAM_K0
#undef HALF_STEP
}
#undef ROW
#undef VMW
#undef VMWN
#undef SLOAD_H
#undef QLOAD
#undef BL16
#undef SWRITE_HK
#undef SWRITE_HV
#undef SWRITE_H
template <int MODE, class Sched>
__device__ __forceinline__ void attn_phase(char* lds, const ABase& B, const Sched& sch) {
    AItem cur, nxt; if (!sch.get(0, cur)) return;
    ADesc DS; const int tb_ = 8 * SEQ * B.nh * D * 2;
    DS.q = __builtin_amdgcn_make_buffer_rsrc((void*)B.Q, (short)0, tb_, 0x00020000); DS.k = __builtin_amdgcn_make_buffer_rsrc((void*)B.K, (short)0, tb_, 0x00020000);
    DS.v = __builtin_amdgcn_make_buffer_rsrc((void*)B.V, (short)0, tb_, 0x00020000); DS.f = __builtin_amdgcn_make_buffer_rsrc((void*)B.F, (short)0, MODE == 0 ? 8 * SEQ * B.nh * 4 : 0, 0x00020000);
    Seam S; attn_prime<MODE>(B, DS, cur, lds, S);
    for (int i = 0;; ++i) {
        const bool more = sch.get(i + 1, nxt); if (!more) nxt = cur;
        attn_block<MODE>(B, DS, cur, nxt, lds, S);
        if (!more) break;
        cur = nxt;
    }
}
#undef SBAR
}
namespace ret {
using att::bf16; using att::bf16x8; using att::s16x4; using att::f32x16; using att::f32x4; using att::u32x4;
using att::crow; using att::cvtpk; using att::load8; using att::v_st; using att::v_rd_base; using att::qkt; using att::pv_tile;
__device__ __forceinline__ float bf_lo(unsigned w) { return __uint_as_float(w << 16); }
__device__ __forceinline__ float bf_hi(unsigned w) { return __uint_as_float(w & 0xffff0000u); }
__device__ __forceinline__ float l2g_of(int h) { return __builtin_log2f(1.f - __builtin_amdgcn_exp2f(-5.f - (float)h)); }
#define SBAR() __builtin_amdgcn_sched_barrier(0)
__device__ __forceinline__ void kv_task(char* lds, const bf16* K, const bf16* V, float* KVt, int h) {
    const int tid = threadIdx.x, wid = __builtin_amdgcn_readfirstlane(tid >> 6), lane = tid & 63, r32 = lane & 31, hi = lane >> 5;
    const float l2g = l2g_of(h);
#pragma unroll
    for (int i = 0; i < 4; ++i) { const int idx = tid + 512 * i, row = idx >> 4, pc = idx & 15;
        const u32x4 kw = *(const u32x4*)(K + (size_t)row * 128 + pc * 8); const bf16x8 vv = load8(V + (size_t)row * 128 + pc * 8);
        const float dec = __builtin_amdgcn_exp2f(l2g * (float)(127 - row));
        u32x4 ks; ks.x = cvtpk(bf_lo(kw.x) * dec, bf_hi(kw.x) * dec); ks.y = cvtpk(bf_lo(kw.y) * dec, bf_hi(kw.y) * dec);
        ks.z = cvtpk(bf_lo(kw.z) * dec, bf_hi(kw.z) * dec); ks.w = cvtpk(bf_lo(kw.w) * dec, bf_hi(kw.w) * dec);
        const int off = (row >> 6) * 16384 + v_st(row & 63, pc * 8);
        *(u32x4*)(lds + off) = ks; *(bf16x8*)(lds + 32768 + off) = vv; }
    __syncthreads();
    const int dkb = wid >> 1, dvb0 = 2 * (wid & 1);
    const int kb = (int)(uintptr_t)lds + v_rd_base(lane) + dkb * 512, vb = (int)(uintptr_t)lds + 32768 + v_rd_base(lane) + dvb0 * 512;
    f32x16 acc0 = {}, acc1 = {};
#define TRRD(dst, base, off) asm volatile("ds_read_b64_tr_b16 %0, %1 offset:%2" : "=&v"(dst) : "v"(base), "i"(off) : "memory")
#define KV_STEP(tt, ks) do { s16x4 al, ah, b0l, b0h, b1l, b1h; constexpr int o_ = (tt) * 16384 + (ks) * 4096;                        \
        TRRD(al, kb, o_); TRRD(ah, kb, o_ + 2048); TRRD(b0l, vb, o_); TRRD(b0h, vb, o_ + 2048); TRRD(b1l, vb, o_ + 512); TRRD(b1h, vb, o_ + 2560);   \
        asm volatile("s_waitcnt lgkmcnt(0)" ::: "memory"); SBAR();                                                                     \
        const bf16x8 A_ = (bf16x8){al[0], al[1], al[2], al[3], ah[0], ah[1], ah[2], ah[3]};                                              \
        acc0 = __builtin_amdgcn_mfma_f32_32x32x16_bf16(A_, (bf16x8){b0l[0], b0l[1], b0l[2], b0l[3], b0h[0], b0h[1], b0h[2], b0h[3]}, acc0, 0, 0, 0);   \
        acc1 = __builtin_amdgcn_mfma_f32_32x32x16_bf16(A_, (bf16x8){b1l[0], b1l[1], b1l[2], b1l[3], b1h[0], b1h[1], b1h[2], b1h[3]}, acc1, 0, 0, 0); } while (0)
    KV_STEP(0, 0); KV_STEP(0, 1); KV_STEP(0, 2); KV_STEP(0, 3); KV_STEP(1, 0); KV_STEP(1, 1); KV_STEP(1, 2); KV_STEP(1, 3);
#undef KV_STEP
#pragma unroll
    for (int g = 0; g < 4; ++g) { const int dk = 32 * dkb + 8 * g + 4 * hi;
        *(f32x4*)(KVt + (size_t)(32 * dvb0 + r32) * 128 + dk) = (f32x4){acc0[4 * g], acc0[4 * g + 1], acc0[4 * g + 2], acc0[4 * g + 3]};
        *(f32x4*)(KVt + (size_t)(32 * (dvb0 + 1) + r32) * 128 + dk) = (f32x4){acc1[4 * g], acc1[4 * g + 1], acc1[4 * g + 2], acc1[4 * g + 3]}; }
    __syncthreads();
}
__device__ __forceinline__ void out_task(char* lds, const bf16* Q, const bf16* K, const bf16* V, const bf16* ST, const bf16* RG, const float* gn, bf16* CAT, int h) {
    const int tid = threadIdx.x, wid = __builtin_amdgcn_readfirstlane(tid >> 6), lane = tid & 63, r32 = lane & 31, hi = lane >> 5;
    const int ch = wid >> 2, wq = wid & 3, ltid = tid & 255;
    const float l2g = l2g_of(h);
    char* Vreg = lds + ch * 32768; char* Kreg = lds + 65536 + ch * 32768;
#pragma unroll
    for (int i = 0; i < 8; ++i) { const int row = (ltid >> 4) + 16 * i, pc = ltid & 15;
        const bf16x8 kv = load8(K + (size_t)(ch * 128 + row) * 128 + pc * 8), vv = load8(V + (size_t)(ch * 128 + row) * 128 + pc * 8);
        *(bf16x8*)(Kreg + (row >> 6) * 16384 + KSWZ(row & 63, pc * 16)) = kv;
        *(bf16x8*)(Vreg + (row >> 6) * 16384 + v_st(row & 63, pc * 8)) = vv; }
    bf16x8 qr[8];
#pragma unroll
    for (int d0 = 0; d0 < 8; ++d0) qr[d0] = load8(Q + (size_t)(ch * 128 + wq * 32 + r32) * 128 + d0 * 16 + hi * 8);
    f32x16 o[4] = {};
    const bf16* STc = ST + (size_t)ch * 16384;
#pragma unroll
    for (int d0 = 0; d0 < 4; ++d0) { bf16x8 sf[8];
#pragma unroll
        for (int ks = 0; ks < 8; ++ks) sf[ks] = load8(STc + (size_t)(d0 * 32 + r32) * 128 + ks * 16 + hi * 8);
#pragma unroll
        for (int ks = 0; ks < 8; ++ks) o[d0] = __builtin_amdgcn_mfma_f32_32x32x16_bf16(qr[ks], sf[ks], o[d0], 0, 0, 0); }
#pragma unroll
    for (int r = 0; r < 16; ++r) { const float qd = __builtin_amdgcn_exp2f(l2g * (float)(wq * 32 + crow(r, hi) + 1));
#pragma unroll
        for (int d0 = 0; d0 < 4; ++d0) o[d0][r] *= qd; }
    __syncthreads();
    const int vb0 = (int)(uintptr_t)Vreg + v_rd_base(lane), row = wq * 32 + r32;
    for (int kt = 0; kt < 2; ++kt) { if (kt * 64 > wq * 32 + 31) break;
        f32x16 p0 = {}, p1 = {};
        qkt(p0, p1, Kreg + kt * 16384, r32, hi, qr);
#pragma unroll
        for (int r = 0; r < 16; ++r) { const int k0 = kt * 64 + crow(r, hi), k1 = k0 + 32;
            p0[r] = (k0 <= row) ? p0[r] * __builtin_amdgcn_exp2f(l2g * (float)(row - k0)) : 0.f;
            p1[r] = (k1 <= row) ? p1[r] * __builtin_amdgcn_exp2f(l2g * (float)(row - k1)) : 0.f; }
        bf16x8 pa0, pa1, pa2, pa3;
        ATT_PK4(p0, 0, pa0); ATT_PK4(p0, 8, pa1); ATT_PK4(p1, 0, pa2); ATT_PK4(p1, 8, pa3);
        SBAR(); pv_tile<0>(o, vb0 + kt * 16384, pa0, pa1, pa2, pa3); }
    float gnv[4];
#pragma unroll
    for (int d0 = 0; d0 < 4; ++d0) gnv[d0] = gn[d0 * 32 + r32];
#pragma unroll
    for (int r = 0; r < 16; ++r) { const int trow = ch * 128 + wq * 32 + crow(r, hi);
        float s = (o[0][r] + o[1][r]) + (o[2][r] + o[3][r]);
        s += __shfl_xor(s, 1); s += __shfl_xor(s, 2); s += __shfl_xor(s, 4); s += __shfl_xor(s, 8); s += __shfl_xor(s, 16);
        const float mu = s * (1.f / 128.f); float dv[4], q = 0.f;
#pragma unroll
        for (int d0 = 0; d0 < 4; ++d0) { dv[d0] = o[d0][r] - mu; q += dv[d0] * dv[d0]; }
        q += __shfl_xor(q, 1); q += __shfl_xor(q, 2); q += __shfl_xor(q, 4); q += __shfl_xor(q, 8); q += __shfl_xor(q, 16);
        const float rstd = __builtin_amdgcn_rsqf(q * (1.f / 128.f) + 1e-5f);
#pragma unroll
        for (int d0 = 0; d0 < 4; ++d0) { const float g = __bfloat162float(RG[(size_t)trow * 512 + d0 * 32 + r32]);
            const float y = dv[d0] * rstd * gnv[d0] * g * __builtin_amdgcn_rcpf(1.f + __builtin_amdgcn_exp2f(-1.4426950408889634f * g));
            const float yn = __shfl_xor(y, 1);
            if ((r32 & 1) == 0) *(unsigned*)(CAT + (size_t)trow * 1024 + d0 * 32 + r32) = cvtpk(y, yn); } }
    __syncthreads();
}
#undef TRRD
#undef SBAR
}
constexpr int NWAVES = 8;
constexpr int BATCH = 8, SEQ = 4096, DM = 1024, T = BATCH * SEQ, FFH = 2816;
constexpr size_t MiB = 1u << 20;
constexpr size_t WS_CTL = 0, CTL_ZERO_BYTES = 1 * MiB;
constexpr size_t WS_COS = 1 * MiB, WS_SIN = 2 * MiB;
constexpr size_t WS_WFL = 3 * MiB;
constexpr size_t WS_KMEAN = 3 * MiB + 65536;
constexpr size_t WS_SEL = 4 * MiB;
constexpr size_t WS_LOGF = 5 * MiB;
constexpr size_t WS_FCUM = 6 * MiB;
constexpr size_t WS_WP0 = 8 * MiB, WS_WO0 = 15 * MiB, WS_WFI0 = 17 * MiB, WS_WFO0 = 28 * MiB, WS_WP1 = 34 * MiB, WS_WO1 = 40 * MiB, WS_WFI1 = 42 * MiB, WS_WFO1 = 53 * MiB;
constexpr size_t WS_A = 64 * MiB;
constexpr size_t WS_B = 128 * MiB;
constexpr size_t WS_C = 352 * MiB;
constexpr size_t WS_D = 416 * MiB;
constexpr size_t WS_END = 480 * MiB;
constexpr int CW_BAR = 4096;
constexpr int RING_BYTES = 131072, MISC_OFF = RING_BYTES + 320, LDS_BYTES = 147456;
constexpr int SCR_OFF = RING_BYTES + 1024;

typedef unsigned short bf16r;
typedef unsigned v4u __attribute__((ext_vector_type(4)));
typedef float f32x4 __attribute__((ext_vector_type(4)));
#define LDS_WAIT() asm volatile("s_waitcnt lgkmcnt(0)" ::: "memory")
__device__ __forceinline__ unsigned pk2(float lo, float hi) { unsigned r; asm volatile("v_cvt_pk_bf16_f32 %0, %1, %2" : "=v"(r) : "v"(lo), "v"(hi)); return r; }
__device__ __forceinline__ float wave_sum(float v) {
#pragma unroll
    for (int o = 1; o < 64; o <<= 1) v += __shfl_xor(v, o);
    return v;
}
__device__ __forceinline__ int t5_bucket(int rel) {
    int n = rel > 0 ? rel : 0; if (n < 16) return n;
    int large = 16 + (int)(logf((float)n / 16.f) / 2.0794415416798357f * 16.f);
    return large < 31 ? large : 31;
}
template <int MAP> __device__ __forceinline__ int dest_row(int n) {
    if (MAP == 1) { if (n >= 1024) return n; const int d = n & 127, j = d & 63; return (n & ~127) + 8 * (j >> 2) + (j & 3) + ((d >> 6) << 2); }
    if (MAP == 2) { if (n < FFH) return 256 * (n >> 7) + (n & 127); const int c = n - FFH; return 256 * (c >> 7) + 128 + (c & 127); }
    return n;
}
template <int MAP> __device__ __forceinline__ void transpose_item(const float* W, int K, int N, int ldw, bf16r* WT, LAS float* scr, int item, int lane) {
    const int nblk = N / 32, kb = item / nblk, nb = item % nblk, k0 = 64 * kb, n0 = 32 * nb;
#pragma unroll 8
    for (int i = 0; i < 32; ++i) { const int kk = 2 * i + (lane >> 5); scr[kk * 33 + (lane & 31)] = W[(size_t)(k0 + kk) * ldw + n0 + (lane & 31)]; }
    LDS_WAIT(); asm volatile("" ::: "memory");
    const int c = lane & 7;
#pragma unroll
    for (int j = 0; j < 4; ++j) { const int n = (lane >> 3) + 8 * j; const LAS float* s = scr + (8 * c) * 33 + n;
        v4u o; o.x = pk2(s[0 * 33], s[1 * 33]); o.y = pk2(s[2 * 33], s[3 * 33]); o.z = pk2(s[4 * 33], s[5 * 33]); o.w = pk2(s[6 * 33], s[7 * 33]);
        *(v4u*)(WT + (size_t)dest_row<MAP>(n0 + n) * K + k0 + 8 * c) = o; }
    LDS_WAIT(); asm volatile("" ::: "memory");
}
struct P {
    const float *x, *relb, *nmpre, *nmpost, *nfpre, *nfpost, *ewin, *egn, *ewout, *owin, *obf, *owout, *fwin, *fwout; float* out; unsigned char* ws;
};
template <bool HAS_M, bool HAS_HN, bool HAS_LOGF>
__device__ __forceinline__ void row_pass(int gw, int NGW, int lane, const float* xin, const bf16r* m, const float* gpost, const float* gpre, float* xout, bf16r* hn,
                                         const LAS float* wfl, const float* bfg, float* logf_out) {
    f32x4 gp[4], gq[4];
#pragma unroll
    for (int j = 0; j < 4; ++j) { if (HAS_M) gp[j] = *(const f32x4*)(gpost + 4 * lane + 256 * j); if (HAS_HN) gq[j] = *(const f32x4*)(gpre + 4 * lane + 256 * j); }
    for (int r = gw; r < T; r += NGW) {
        f32x4 v[4];
#pragma unroll
        for (int j = 0; j < 4; ++j) v[j] = *(const f32x4*)(xin + (size_t)r * DM + 4 * lane + 256 * j);
        if (HAS_M) { f32x4 mv[4]; float ss = 0.f;
#pragma unroll
            for (int j = 0; j < 4; ++j) { const uint2 w = *(const uint2*)(m + (size_t)r * DM + 4 * lane + 256 * j);
                mv[j] = (f32x4){__uint_as_float(w.x << 16), __uint_as_float(w.x & 0xffff0000u), __uint_as_float(w.y << 16), __uint_as_float(w.y & 0xffff0000u)};
                ss += (mv[j].x * mv[j].x + mv[j].y * mv[j].y) + (mv[j].z * mv[j].z + mv[j].w * mv[j].w); }
            const float r1 = 1.f / sqrtf(wave_sum(ss) * (1.f / DM) + 1e-6f);
#pragma unroll
            for (int j = 0; j < 4; ++j) { v[j] = v[j] + mv[j] * r1 * gp[j]; *(f32x4*)(xout + (size_t)r * DM + 4 * lane + 256 * j) = v[j]; } }
        if (HAS_HN) { float ss = 0.f;
#pragma unroll
            for (int j = 0; j < 4; ++j) ss += (v[j].x * v[j].x + v[j].y * v[j].y) + (v[j].z * v[j].z + v[j].w * v[j].w);
            const float r2 = 1.f / sqrtf(wave_sum(ss) * (1.f / DM) + 1e-6f);
#pragma unroll
            for (int j = 0; j < 4; ++j) { v[j] = v[j] * r2 * gq[j]; uint2 w; w.x = pk2(v[j].x, v[j].y); w.y = pk2(v[j].z, v[j].w); *(uint2*)(hn + (size_t)r * DM + 4 * lane + 256 * j) = w; }
            if (HAS_LOGF) { float myz = 0.f;
#pragma unroll
                for (int h = 0; h < 8; ++h) { float d = 0.f;
#pragma unroll
                    for (int j = 0; j < 4; ++j) { const f32x4 w = *(const LAS f32x4*)(wfl + h * DM + 4 * lane + 256 * j); d += (v[j].x * w.x + v[j].y * w.y) + (v[j].z * w.z + v[j].w * w.w); }
                    d = wave_sum(d); if (lane == h) myz = d; }
                if (lane < 8) { const float z = myz + bfg[lane]; logf_out[(size_t)r * 8 + lane] = fminf(z, 0.f) - log1pf(expf(-fabsf(z))); } } }
    }
}
struct AttSchedFox {
    int vcu;
    __device__ __forceinline__ bool get(int i, att::AItem& r) const { if (i >= 4) return false; const int p = vcu + 256 * (i >> 1), x = p & 7; r.bh = p >> 3; r.qb = (i & 1) ? x : 15 - x; return true; }
};
struct AttSchedMoba {
    int vcu;
    __device__ __forceinline__ bool get(int i, att::AItem& r) const { if (i >= 2) return false; const int x = vcu & 7; r.bh = vcu >> 3; r.qb = (i & 1) ? x : 15 - x; return true; }
};

struct Args { const float* in[14]; float* out; unsigned char* ws; int ph_lo, ph_hi; };
constexpr int NPHASE = 17;
__global__ void __launch_bounds__(NWAVES * 64, 2) mega_fwd(Args args) {
    extern __shared__ __attribute__((aligned(16))) unsigned char lds[];
    LAS unsigned char* ldsA = (LAS unsigned char*)lds;
    volatile LAS unsigned* MISC = (volatile LAS unsigned*)(ldsA + MISC_OFF);
    const int tid = threadIdx.x, lane = tid & 63, wave = __builtin_amdgcn_readfirstlane(tid >> 6);
    const int G = gridDim.x, bx = blockIdx.x, vcu = (G % 8 == 0) ? (bx % 8) * (G / 8) + bx / 8 : bx;
    const int gw = vcu * NWAVES + wave, NGW = G * NWAVES;
    typedef const __attribute__((address_space(4))) Args* CArgsP;
    const CArgsP ap0 = (CArgsP)__builtin_amdgcn_kernarg_segment_ptr();
#define ARGP() ({ unsigned lo_ = (unsigned)(uintptr_t)ap0, hi_ = (unsigned)((uintptr_t)ap0 >> 32); asm volatile("" : "+s"(lo_), "+s"(hi_)); \
    (CArgsP)(((uintptr_t)(unsigned)__builtin_amdgcn_readfirstlane(hi_) << 32) | (unsigned)__builtin_amdgcn_readfirstlane(lo_)); })
#define a_ws ((unsigned char*)(GAS unsigned char*)(ARGP()->ws))
    unsigned* ctl = (unsigned*)(a_ws + WS_CTL);
    for (int u = tid; u < (LDS_BYTES - RING_BYTES) / 4; u += NWAVES * 64) ((LAS unsigned*)(ldsA + RING_BYTES))[u] = 0u;
    __syncthreads();
    XcdBarrier bar = xcd_barrier_post(ctl + CW_BAR, MISC + 8);
    cg::grid_group grid = cg::this_grid();
    const int lo = ap0->ph_lo, hi = ap0->ph_hi;
#ifndef PHMASK
#define PHMASK 0x1ffff
#endif
#define IN(k) (((PHMASK >> (k)) & 1) && lo <= (k) && (k) < hi)
#define SEAM(k) do { if (IN(k) && IN((k) + 1)) { if ((k) == 0) grid.sync(); else xcd_barrier(bar); } } while (0)
#define a_x      ((const float*)(const GAS float*)(ARGP()->in[0]))
#define a_relb   ((const float*)(const GAS float*)(ARGP()->in[1]))
#define a_nmpre  ((const float*)(const GAS float*)(ARGP()->in[2]))
#define a_nmpost ((const float*)(const GAS float*)(ARGP()->in[3]))
#define a_nfpre  ((const float*)(const GAS float*)(ARGP()->in[4]))
#define a_nfpost ((const float*)(const GAS float*)(ARGP()->in[5]))
#define a_ewin   ((const float*)(const GAS float*)(ARGP()->in[6]))
#define a_egn    ((const float*)(const GAS float*)(ARGP()->in[7]))
#define a_ewout  ((const float*)(const GAS float*)(ARGP()->in[8]))
#define a_owin   ((const float*)(const GAS float*)(ARGP()->in[9]))
#define a_obf    ((const float*)(const GAS float*)(ARGP()->in[10]))
#define a_owout  ((const float*)(const GAS float*)(ARGP()->in[11]))
#define a_fwin   ((const float*)(const GAS float*)(ARGP()->in[12]))
#define a_fwout  ((const float*)(const GAS float*)(ARGP()->in[13]))
#define a_out    ((float*)(GAS float*)(ARGP()->out))
#define COS   ((float*)(a_ws + WS_COS))
#define SIN   ((float*)(a_ws + WS_SIN))
#define WFL   ((float*)(a_ws + WS_WFL))
#define KMEAN ((float*)(a_ws + WS_KMEAN))
#define SEL   ((unsigned*)(a_ws + WS_SEL))
#define LOGF  ((float*)(a_ws + WS_LOGF))
#define FCUM  ((float*)(a_ws + WS_FCUM))
#define WP0   ((bf16r*)(a_ws + WS_WP0))
#define WO0   ((bf16r*)(a_ws + WS_WO0))
#define WFI0  ((bf16r*)(a_ws + WS_WFI0))
#define WFO0  ((bf16r*)(a_ws + WS_WFO0))
#define WP1   ((bf16r*)(a_ws + WS_WP1))
#define WO1   ((bf16r*)(a_ws + WS_WO1))
#define WFI1  ((bf16r*)(a_ws + WS_WFI1))
#define WFO1  ((bf16r*)(a_ws + WS_WFO1))
#define HN    ((bf16r*)(a_ws + WS_A))
#define KVT   ((float*)(a_ws + WS_A))
#define PB    ((bf16r*)(a_ws + WS_B))
    constexpr size_t A32 = (size_t)T * 512;
#define RQ (PB)
#define RK (PB + A32)
#define RV (PB + 2 * A32)
#define RG (PB + 3 * A32)
#define MQ (PB + 4 * A32)
#define MK (PB + 5 * A32)
#define MV (PB + 6 * A32)
#define HB (PB)
#define FQ (PB)
#define FK (PB + 2 * A32)
#define FV (PB + 4 * A32)
#define CAT ((bf16r*)(a_ws + WS_C))
#define MB  ((bf16r*)(a_ws + WS_D))
#define STB ((bf16r*)(a_ws + WS_D))
    if (IN(0)) {
        LAS float* scr = (LAS float*)(ldsA + wave * 16384);
        constexpr int I_P0 = 16 * 112, I_O = 16 * 32, I_FI = 16 * 176, I_FO = 44 * 32, I_P1 = 16 * 96;
        constexpr int NITEMS = I_P0 + 2 * I_O + 2 * I_FI + 2 * I_FO + I_P1;
        for (int it = gw; it < NITEMS; it += NGW) { int r = it;
            if (r < I_P0) { transpose_item<1>(a_ewin, DM, 3584, 3584, WP0, scr, r, lane); continue; } r -= I_P0;
            if (r < I_O) { transpose_item<0>(a_ewout, DM, DM, DM, WO0, scr, r, lane); continue; } r -= I_O;
            if (r < I_FI) { transpose_item<2>(a_fwin, DM, 2 * FFH, 2 * FFH, WFI0, scr, r, lane); continue; } r -= I_FI;
            if (r < I_FO) { transpose_item<0>(a_fwout, FFH, DM, DM, WFO0, scr, r, lane); continue; } r -= I_FO;
            if (r < I_P1) { transpose_item<0>(a_owin, DM, 3072, 3080, WP1, scr, r, lane); continue; } r -= I_P1;
            if (r < I_O) { transpose_item<0>(a_owout, DM, DM, DM, WO1, scr, r, lane); continue; } r -= I_O;
            if (r < I_FI) { transpose_item<2>(a_fwin + (size_t)DM * 2 * FFH, DM, 2 * FFH, 2 * FFH, WFI1, scr, r, lane); continue; } r -= I_FI;
            transpose_item<0>(a_fwout + (size_t)FFH * DM, FFH, DM, DM, WFO1, scr, r, lane);
        }
        for (int i = bx * 512 + tid; i < SEQ * 64; i += G * 512) { const int j = i & 63, t = i >> 6;
            const float inv = powf(10000.f, -(float)(2 * j) / 128.f), ang = (float)t * inv;
            const double a = (double)ang, k = rint(a * 0.15915494309189535); const float rr = (float)(a - k * 6.283185307179586);
            COS[i] = cosf(rr); SIN[i] = sinf(rr); }
        for (int i = bx * 512 + tid; i < 8 * DM; i += G * 512) { const int h = i >> 10, k = i & 1023; WFL[i] = a_owin[(size_t)k * 3080 + 3072 + h]; }
        row_pass<false, true, false>(gw, NGW, lane, a_x, nullptr, nullptr, a_nmpre, nullptr, HN, nullptr, nullptr, nullptr);
    }
    SEAM(0);
    if (IN(1)) {
        pg8::Gemm g{HN, WP0, T, 3584, DM}; pg8::StaticOrder S; S.init(T, 3584, G, bx);
        pg8::EpiHeads<4, true, 3> E{PB, A32, COS, SIN, 0.08838834764831845f};
        pg8::gemm_phase<pg8::EpiHeads<4, true, 3>, pg8::StaticOrder, true, true>(ldsA, g, S, E);
    }
    SEAM(1);
    if (IN(2)) {
        for (int c = vcu; c < 1024; c += G) { const int bh = c >> 5;
            ret::kv_task((char*)lds, (const att::bf16*)(RK + (size_t)c * 128 * 128), (const att::bf16*)(RV + (size_t)c * 128 * 128), KVT + (size_t)c * 16384, bh & 3); }
        LAS float* red = (LAS float*)(ldsA + SCR_OFF);
        for (int u = vcu; u < 512; u += G) {
            const int d = tid & 127, part = tid >> 7; const bf16r* kp = MK + ((size_t)u * 256 + part * 64) * 128 + d; float s = 0.f;
            for (int i = 0; i < 64; ++i) s += __uint_as_float((unsigned)kp[(size_t)i * 128] << 16);
            red[tid] = s; __syncthreads();
            if (tid < 128) KMEAN[(size_t)u * 128 + tid] = ((red[tid] + red[tid + 128]) + (red[tid + 256] + red[tid + 384])) * (1.f / 256.f);
            __syncthreads(); }
    }
    SEAM(2);
    if (IN(3)) {
        for (int gid = bx * 512 + tid; gid < 32 * 4096; gid += G * 512) { const int bh = gid >> 12, e4 = gid & 4095;
            const float cd = __builtin_amdgcn_exp2f(ret::l2g_of(bh & 3) * 128.f); f32x4 s = {0.f, 0.f, 0.f, 0.f};
            const f32x4* kv = (const f32x4*)KVT + (size_t)bh * 32 * 4096 + e4; uint2* st = (uint2*)STB + (size_t)bh * 32 * 4096 + e4;
#pragma unroll 8
            for (int i = 0; i < 32; ++i) { const f32x4 k = kv[(size_t)i * 4096]; uint2 w; w.x = pk2(s.x, s.y); w.y = pk2(s.z, s.w); st[(size_t)i * 4096] = w; s = s * cd + k; } }
        for (int gid = bx * 512 + tid; gid < 32 * 4096; gid += G * 512) { const int bh = __builtin_amdgcn_readfirstlane(gid >> 12), s = gid & 4095, own = __builtin_amdgcn_readfirstlane(s >> 8);
            const v4u* qp = (const v4u*)(MQ + ((size_t)bh * SEQ + s) * 128); v4u q[16];
#pragma unroll
            for (int i = 0; i < 16; ++i) q[i] = qp[i];
            float v1 = 0.f, v2 = 0.f, v3 = 0.f; int i1 = -1, i2 = -1, i3 = -1;
            for (int n = 0; n < own; ++n) { const f32x4* km = (const f32x4*)(KMEAN + ((size_t)bh * 16 + n) * 128); float d = 0.f;
#pragma unroll
                for (int i = 0; i < 16; ++i) { const f32x4 a = km[2 * i], b = km[2 * i + 1];
                    d += (ret::bf_lo(q[i].x) * a.x + ret::bf_hi(q[i].x) * a.y) + (ret::bf_lo(q[i].y) * a.z + ret::bf_hi(q[i].y) * a.w)
                       + (ret::bf_lo(q[i].z) * b.x + ret::bf_hi(q[i].z) * b.y) + (ret::bf_lo(q[i].w) * b.z + ret::bf_hi(q[i].w) * b.w); }
                if (i1 < 0 || d > v1) { v3 = v2; i3 = i2; v2 = v1; i2 = i1; v1 = d; i1 = n; }
                else if (i2 < 0 || d > v2) { v3 = v2; i3 = i2; v2 = d; i2 = n; }
                else if (i3 < 0 || d > v3) { v3 = d; i3 = n; } }
            unsigned msk = 0; if (i1 >= 0) msk |= 1u << i1; if (i2 >= 0) msk |= 1u << i2; if (i3 >= 0) msk |= 1u << i3;
            SEL[gid] = msk; }
    }
    SEAM(3);
    if (IN(4)) {
        if (!(PHMASK & 0x100000)) for (int u = vcu; u < 512; u += G) { const int bh = u >> 4, cp = u & 15, b = bh >> 2, h = bh & 3; const size_t hb = ((size_t)bh * SEQ + cp * 256) * 128, tb = (size_t)b * SEQ + cp * 256;
            ret::out_task((char*)lds, (const att::bf16*)(RQ + hb), (const att::bf16*)(RK + hb), (const att::bf16*)(RV + hb), (const att::bf16*)(STB + ((size_t)bh * 32 + cp * 2) * 16384),
                          (const att::bf16*)(RG + tb * 512 + h * 128), a_egn + h * 128, (att::bf16*)(CAT + tb * DM + h * 128), h); }
        { LAS float* lut = (LAS float*)(ldsA + att::OFF_LUT); const float* rb = a_relb;
          for (int i = tid; i < att::LUT_FLOATS; i += 512) { const int h = i >> 9, rel = (i & 511) - 256; lut[i] = (i >= 2048) ? -__builtin_inff() : rb[t5_bucket(rel) * 4 + h] * att::INV_SCALE; }
          __syncthreads(); }
        if (!(PHMASK & 0x200000)) { AttSchedMoba sch{vcu}; const att::ABase AB{(const att::bf16*)MQ, (const att::bf16*)MK, (const att::bf16*)MV, (att::bf16*)CAT, nullptr, SEL, 4, 512};
        att::attn_phase<1, AttSchedMoba>((char*)lds, AB, sch); }
    }
    SEAM(4);
    if (IN(5)) { pg8::Gemm g{CAT, WO0, T, DM, DM}; pg8::StaticOrder S; S.init(T, DM, G, bx); pg8::EpiPlain E{MB, DM};
        pg8::gemm_phase<pg8::EpiPlain, pg8::StaticOrder, true, true>(ldsA, g, S, E); }
    SEAM(5);
    if (IN(6)) row_pass<true, true, false>(gw, NGW, lane, a_x, MB, a_nmpost, a_nfpre, a_out, HN, nullptr, nullptr, nullptr);
    SEAM(6);
    if (IN(7)) { pg8::Gemm g{HN, WFI0, T, 2 * FFH, DM}; pg8::StaticOrder S; S.init(T, 2 * FFH, G, bx); pg8::EpiSwiglu E{HB, FFH};
        pg8::gemm_phase<pg8::EpiSwiglu, pg8::StaticOrder, true, true>(ldsA, g, S, E); }
    SEAM(7);
    if (IN(8)) { pg8::Gemm g{HB, WFO0, T, DM, FFH}; pg8::StaticOrder S; S.init(T, DM, G, bx); pg8::EpiPlain E{MB, DM};
        pg8::gemm_phase<pg8::EpiPlain, pg8::StaticOrder, true, true>(ldsA, g, S, E); }
    SEAM(8);
    if (IN(9)) {
        LAS float* wfl = (LAS float*)ldsA;
        for (int i = tid; i < 8 * DM; i += 512) wfl[i] = WFL[i];
        __syncthreads();
        row_pass<true, true, true>(gw, NGW, lane, a_out, MB, a_nfpost, a_nmpre + DM, a_out, HN, wfl, a_obf, LOGF);
        __syncthreads();
    }
    SEAM(9);
    if (IN(10)) {
        for (int bh = vcu; bh < 64; bh += G) { LAS float* sc = (LAS float*)(ldsA + SCR_OFF); const int b = bh >> 3, h = bh & 7; float v[8], run = 0.f;
#pragma unroll
            for (int i = 0; i < 8; ++i) { run += LOGF[((size_t)b * SEQ + tid * 8 + i) * 8 + h]; v[i] = run; }
            sc[tid] = run; __syncthreads();
            for (int o = 1; o < 512; o <<= 1) { const float a = (tid >= o) ? sc[tid - o] : 0.f; __syncthreads(); sc[tid] += a; __syncthreads(); }
            const float base = (tid > 0) ? sc[tid - 1] : 0.f;
#pragma unroll
            for (int i = 0; i < 8; ++i) FCUM[(size_t)bh * SEQ + tid * 8 + i] = -(base + v[i]) * att::INV_SCALE;
            __syncthreads(); }
        pg8::Gemm g{HN, WP1, T, 3072, DM}; pg8::StaticOrder S; S.init(T, 3072, G, bx);
        pg8::EpiHeads<8, false, -1> E{PB, 2 * A32, nullptr, nullptr, 1.f};
        pg8::gemm_phase<pg8::EpiHeads<8, false, -1>, pg8::StaticOrder, true, true>(ldsA, g, S, E);
    }
    SEAM(10);
    if (IN(11)) { AttSchedFox sch{vcu}; const att::ABase AB{(const att::bf16*)FQ, (const att::bf16*)FK, (const att::bf16*)FV, (att::bf16*)CAT, FCUM, nullptr, 8, 0};
        att::attn_phase<0, AttSchedFox>((char*)lds, AB, sch); }
    SEAM(11);
    if (IN(12)) { pg8::Gemm g{CAT, WO1, T, DM, DM}; pg8::StaticOrder S; S.init(T, DM, G, bx); pg8::EpiPlain E{MB, DM};
        pg8::gemm_phase<pg8::EpiPlain, pg8::StaticOrder, true, true>(ldsA, g, S, E); }
    SEAM(12);
    if (IN(13)) row_pass<true, true, false>(gw, NGW, lane, a_out, MB, a_nmpost + DM, a_nfpre + DM, a_out, HN, nullptr, nullptr, nullptr);
    SEAM(13);
    if (IN(14)) { pg8::Gemm g{HN, WFI1, T, 2 * FFH, DM}; pg8::StaticOrder S; S.init(T, 2 * FFH, G, bx); pg8::EpiSwiglu E{HB, FFH};
        pg8::gemm_phase<pg8::EpiSwiglu, pg8::StaticOrder, true, true>(ldsA, g, S, E); }
    SEAM(14);
    if (IN(15)) { pg8::Gemm g{HB, WFO1, T, DM, FFH}; pg8::StaticOrder S; S.init(T, DM, G, bx); pg8::EpiPlain E{MB, DM};
        pg8::gemm_phase<pg8::EpiPlain, pg8::StaticOrder, true, true>(ldsA, g, S, E); }
    SEAM(15);
    if (IN(16)) row_pass<true, false, false>(gw, NGW, lane, a_out, MB, a_nfpost + DM, nullptr, a_out, nullptr, nullptr, nullptr, nullptr);
#undef IN
#undef SEAM
}

#ifndef N_LAUNCH_SPLIT
#define N_LAUNCH_SPLIT 0
#endif
extern "C" void kernel_launch(void* const* d_in, const int* in_sizes, int n_in, void* d_out, int out_size, void* d_ws, size_t ws_size, hipStream_t stream) {
    static int grid = 0;
    if (grid == 0) {
        if (n_in != 14 || in_sizes[0] != T * DM || out_size != T * DM || ws_size < WS_END) { fprintf(stderr, "kernel_launch: unexpected shapes (n_in %d in0 %d out %d ws %zu)\n", n_in, n_in > 0 ? in_sizes[0] : -1, out_size, ws_size); grid = -1; return; }
        int dev = 0, cus = 0, per_cu = 0;
        if (hipGetDevice(&dev) != hipSuccess || hipDeviceGetAttribute(&cus, hipDeviceAttributeMultiprocessorCount, dev) != hipSuccess) { grid = -1; return; }
        if (hipFuncSetAttribute((const void*)mega_fwd, hipFuncAttributeMaxDynamicSharedMemorySize, LDS_BYTES) != hipSuccess) { fprintf(stderr, "kernel_launch: hipFuncSetAttribute failed\n"); grid = -1; return; }
        if (hipOccupancyMaxActiveBlocksPerMultiprocessor(&per_cu, (const void*)mega_fwd, NWAVES * 64, LDS_BYTES) != hipSuccess || per_cu < 1) { fprintf(stderr, "kernel_launch: occupancy query says %d\n", per_cu); (void)hipGetLastError(); grid = -1; return; }
        grid = cus;
        if (grid != 256) fprintf(stderr, "kernel_launch: note: %d CUs (tuned for 256)\n", grid);
    }
    if (grid < 0) return;
    if (hipMemsetAsync((char*)d_ws + WS_CTL, 0, CTL_ZERO_BYTES, stream) != hipSuccess) return;
    Args a{};
    for (int i = 0; i < 14; ++i) a.in[i] = (const float*)d_in[i];
    a.out = (float*)d_out; a.ws = (unsigned char*)d_ws;
#if N_LAUNCH_SPLIT
    for (int p = 0; p < NPHASE; ++p) { a.ph_lo = p; a.ph_hi = p + 1; hipLaunchKernelGGL(mega_fwd, dim3(grid), dim3(NWAVES * 64), LDS_BYTES, stream, a); }
#else
    a.ph_lo = 0; a.ph_hi = NPHASE;
    void* kargs[] = {&a};
    hipError_t e = hipLaunchCooperativeKernel((const void*)mega_fwd, dim3(grid), dim3(NWAVES * 64), kargs, LDS_BYTES, stream);
    if (e != hipSuccess) fprintf(stderr, "kernel_launch: cooperative launch failed: %s (grid %d)\n", hipGetErrorString(e), grid);
#endif
}
```

```cpp
#include <hip/hip_runtime.h>
#include <hip/hip_bf16.h>
#include <hip/hip_cooperative_groups.h>
#include <cstdio>
#include <cstdint>
namespace cg = cooperative_groups;
#define LAS __attribute__((address_space(3)))
#define GAS __attribute__((address_space(1)))
#define XB_TMO      128
#define XB_XCNT(j)  (256  + 64 * (j))
#define XB_XSUB(j)  (1280 + 64 * (j))
#define XB_XGEN(j)  (2304 + 64 * (j))
#define XB_TOP      3328
#define XB_TOPGEN   3392
#define XCD_BAR_WORDS 3456
#define XB_SPIN_CAP (1u << 18)
__device__ __forceinline__ unsigned xb_ld(unsigned* p)              { return __hip_atomic_load(p, __ATOMIC_RELAXED, __HIP_MEMORY_SCOPE_AGENT); }
__device__ __forceinline__ unsigned xb_add(unsigned* p, unsigned v) { return __hip_atomic_fetch_add(p, v, __ATOMIC_RELAXED, __HIP_MEMORY_SCOPE_AGENT); }
__device__ __forceinline__ unsigned xb_xcc_id() { return (unsigned)__builtin_amdgcn_s_getreg((3 << 11) | 20) & 0xFu; }
#define XB_SPIN(cond, bar) do { unsigned _sp = 0; while (cond) { __builtin_amdgcn_s_sleep(1); \
    if ((++_sp & 255u) == 0u) { if (xb_ld(&(bar)[XB_TMO])) break; if (_sp > XB_SPIN_CAP) { atomicAdd(&(bar)[XB_TMO], 1u); break; } } } } while (0)
struct XcdBarrier { unsigned* bar; unsigned x; volatile LAS unsigned* st; };
__device__ __forceinline__ XcdBarrier xcd_barrier_post(unsigned* bar, volatile LAS unsigned* st) {
    XcdBarrier b; b.bar = bar; b.x = xb_xcc_id(); b.st = st;
    if (threadIdx.x == 0) (void)xb_add(&bar[XB_XCNT(b.x)], 1u);
    return b;
}
__device__ __forceinline__ void xcd_barrier_complete(unsigned* bar, unsigned x, unsigned& nloc, unsigned& nx) {
    const unsigned G = gridDim.x * gridDim.y * gridDim.z;
    unsigned sum, cnt, mine, sp = 0u;
    for (;;) {
        sum = 0u; cnt = 0u; mine = 0u;
#pragma unroll
        for (unsigned j = 0; j < 16; ++j) { const unsigned c = xb_ld(&bar[XB_XCNT(j)]); sum += c; cnt += (c > 0u) ? 1u : 0u; mine = (j == x) ? c : mine; }
        if (sum == G) break;
        __builtin_amdgcn_s_sleep(1);
        if ((++sp & 255u) == 0u) { if (xb_ld(&bar[XB_TMO])) break; if (sp > XB_SPIN_CAP) { atomicAdd(&bar[XB_TMO], 1u); break; } }
    }
    nloc = mine > 0u ? mine : 1u; nx = cnt > 0u ? cnt : 1u;
}
__device__ __forceinline__ void xcd_barrier(const XcdBarrier& b) {
    asm volatile("s_waitcnt vmcnt(0)" ::: "memory");
    __syncthreads();
    if (threadIdx.x == 0) {
        unsigned* bar = b.bar;
        __builtin_amdgcn_s_waitcnt(0);
        unsigned nloc = b.st[0], nx = b.st[1];
        if (nloc == 0u) { xcd_barrier_complete(bar, b.x, nloc, nx); b.st[0] = nloc; b.st[1] = nx; }
        const unsigned old = xb_add(&bar[XB_XSUB(b.x)], 1u);
        const unsigned gen = old / nloc;
        if (old + 1u == (gen + 1u) * nloc) {
            __builtin_amdgcn_fence(__ATOMIC_RELEASE, "agent");
            asm volatile("s_waitcnt vmcnt(0)" ::: "memory");
            const unsigned og = xb_add(&bar[XB_TOP], 1u);
            const unsigned tg = og / nx;
            if (og + 1u == (tg + 1u) * nx) xb_add(&bar[XB_TOPGEN], 1u);
            else XB_SPIN(xb_ld(&bar[XB_TOPGEN]) == tg, bar);
            __builtin_amdgcn_fence(__ATOMIC_ACQUIRE, "agent");
            xb_add(&bar[XB_XGEN(b.x)], 1u);
            asm volatile("s_waitcnt vmcnt(0)" ::: "memory");
        } else {
            XB_SPIN(xb_ld(&bar[XB_XGEN(b.x)]) == gen, bar);
            __builtin_amdgcn_fence(__ATOMIC_ACQUIRE, "agent");
            asm volatile("s_waitcnt vmcnt(0)" ::: "memory");
        }
    }
    __syncthreads();
}
namespace pg8 {
#define PG8_LAS __attribute__((address_space(3)))
typedef unsigned short bf16_t;
typedef short bf16x8 __attribute__((ext_vector_type(8)));
typedef float f32x4 __attribute__((ext_vector_type(4)));
typedef unsigned u32x4 __attribute__((ext_vector_type(4)));
constexpr int BM = 256, BK = 64, HALF = 128, HTB = HALF * BK * 2  , STAGE_BYTES = 8 * HTB, NXCD = 8, WGM = 8;

__host__ __device__ __forceinline__ int lds_byte(int r, int c) { const int st = (r >> 4) * 2 + (c >> 5), rr = r & 15, cc = c & 31, ob = rr * 64 + cc * 2; return st * 1024 + (ob ^ (((ob >> 9) & 1) << 5)); }
__host__ __device__ __forceinline__ void stage_rc(int b, int& R, int& C) { const int st = b / 1024, sb = b % 1024, swz = sb ^ (((sb >> 9) & 1) << 5); R = (st >> 1) * 16 + swz / 64; C = (st & 1) * 32 + (swz % 64) / 2; }
__host__ __device__ __forceinline__ int perm32(int rho) { const int n = rho >> 4, i = rho & 15; return 8 * (i >> 2) + 4 * n + (i & 3); }

struct Unit { int pm, pn; };
struct Gemm { const bf16_t* A; const bf16_t* Bt; int M, N, K; };

struct StaticOrder {
    int nM, nN, nwg, G, c;
    __host__ __device__ void init(int M, int N, int G_, int c_) { nM = M / BM; nN = N / BM; nwg = nM * nN; G = G_; c = c_; }
    __host__ __device__ bool next(int i, Unit& u) const {
        const long L = (long)i * G + c; if (L >= nwg) return false;
        int wgid = (int)L; { const int q = nwg / NXCD, r = nwg % NXCD, xcd = wgid % NXCD, off = wgid / NXCD; wgid = (xcd < r ? xcd * (q + 1) : r * (q + 1) + (xcd - r) * q) + off; }
        const int nig = WGM * nN, gid = wgid / nig, fm = gid * WGM, gsz = (nM - fm) < WGM ? (nM - fm) : WGM;
        u.pm = fm + ((wgid % nig) % gsz); u.pn = (wgid % nig) / gsz; return true;
    }
    __device__ __forceinline__ void a_ready(const Unit&) const {}
    __device__ __forceinline__ void done(const Unit&) const {}
};

__device__ __forceinline__ unsigned cvt_pk_bf16(float lo, float hi) { unsigned r; asm volatile("v_cvt_pk_bf16_f32 %0, %1, %2" : "=v"(r) : "v"(lo), "v"(hi)); return r; }
typedef float f32x2 __attribute__((ext_vector_type(2)));
struct EpiPlain {
    static constexpr bool PERM = true, AFTER_DRAIN = false;
    bf16_t* O; int ldc;
    __device__ __forceinline__ void operator()(const f32x4 (&acc)[2][2][4][2], const Unit& u, int wr, int wc, int fr, int fq) const {
        const int row0 = u.pm * BM + wr * 64 + fr, col0 = u.pn * BM + wc * 32 + 8 * fq;
#pragma unroll
        for (int ai = 0; ai < 2; ++ai)
#pragma unroll
            for (int m = 0; m < 4; ++m) { bf16_t* rowp = O + (size_t)(row0 + ai * HALF + m * 16) * ldc + col0;
#pragma unroll
                for (int bj = 0; bj < 2; ++bj) { const f32x4 v0 = acc[ai][bj][m][0], v1 = acc[ai][bj][m][1];
                    u32x4 w; w.x = cvt_pk_bf16(v0[0], v0[1]); w.y = cvt_pk_bf16(v0[2], v0[3]); w.z = cvt_pk_bf16(v1[0], v1[1]); w.w = cvt_pk_bf16(v1[2], v1[3]);
                    *(u32x4*)(rowp + bj * HALF) = w; } }
    }
};
struct EpiSwiglu {
    static constexpr bool PERM = true, AFTER_DRAIN = false;
    bf16_t* H; int ldh;
    __device__ __forceinline__ void operator()(const f32x4 (&acc)[2][2][4][2], const Unit& u, int wr, int wc, int fr, int fq) const {
        const int row0 = u.pm * BM + wr * 64 + fr, col0 = u.pn * HALF + wc * 32 + 8 * fq;
#pragma unroll
        for (int ai = 0; ai < 2; ++ai)
#pragma unroll
            for (int m = 0; m < 4; ++m) { bf16_t* rowp = H + (size_t)(row0 + ai * HALF + m * 16) * ldh + col0; float o[8];
#pragma unroll
                for (int n = 0; n < 2; ++n)
#pragma unroll
                    for (int i = 0; i < 4; ++i) { const float g = acc[ai][0][m][n][i], uu = acc[ai][1][m][n][i];
                        o[n * 4 + i] = g * __builtin_amdgcn_rcpf(1.f + __builtin_amdgcn_exp2f(-1.4426950408889634f * g)) * uu; }
                u32x4 w; w.x = cvt_pk_bf16(o[0], o[1]); w.y = cvt_pk_bf16(o[2], o[3]); w.z = cvt_pk_bf16(o[4], o[5]); w.w = cvt_pk_bf16(o[6], o[7]);
                *(u32x4*)rowp = w; }
    }
};
template <int NH, bool ROT, int TOKA> struct EpiHeads {
    static constexpr bool PERM = true, AFTER_DRAIN = false;
    static constexpr int TPA = NH / 2;
    bf16_t* base; size_t astride; const float* cs; const float* sn; float qscale;
    __device__ __forceinline__ void operator()(const f32x4 (&acc)[2][2][4][2], const Unit& u, int wr, int wc, int fr, int fq) const {
        const int a = u.pn / TPA, hp = u.pn % TPA, b = u.pm >> 4, s0 = (u.pm & 15) * BM + wr * 64 + fr, d0 = wc * 32 + 8 * fq;
        bf16_t* ab = base + (size_t)a * astride;
        const bool rot = ROT && a < 2; const float sc = (ROT && a == 0) ? qscale : 1.f;
#pragma unroll
        for (int ai = 0; ai < 2; ++ai)
#pragma unroll
            for (int m = 0; m < 4; ++m) { const int s = s0 + ai * HALF + m * 16;
                f32x4 c4 = {1.f, 1.f, 1.f, 1.f}, s4 = {0.f, 0.f, 0.f, 0.f};
                if (rot) { c4 = *(const f32x4*)(cs + (size_t)s * 64 + 4 * (4 * wc + fq)); s4 = *(const f32x4*)(sn + (size_t)s * 64 + 4 * (4 * wc + fq)); }
#pragma unroll
                for (int bj = 0; bj < 2; ++bj) { f32x4 v0 = acc[ai][bj][m][0], v1 = acc[ai][bj][m][1];
                    if (rot) { const f32x4 o1 = (v0 * c4 - v1 * s4) * sc, o2 = (v0 * s4 + v1 * c4) * sc; v0 = o1; v1 = o2; }
                    u32x4 w; w.x = cvt_pk_bf16(v0[0], v0[1]); w.y = cvt_pk_bf16(v0[2], v0[3]); w.z = cvt_pk_bf16(v1[0], v1[1]); w.w = cvt_pk_bf16(v1[2], v1[3]);
                    const int head = 2 * hp + bj;
                    bf16_t* dst = (a == TOKA) ? ab + (size_t)(b * 4096 + s) * (NH * 128) + head * 128 + d0
                                              : ab + ((size_t)(b * NH + head) * 4096 + s) * 128 + d0;
                    *(u32x4*)dst = w; } }
    }
};
template <class Epi, class Sched, bool ALIGN_EPI = false, bool SP2 = false>
__device__ __forceinline__ void gemm_phase(PG8_LAS unsigned char* lds, const Gemm g, const Sched& S, const Epi& E) {
    const int tid = threadIdx.x, wid = __builtin_amdgcn_readfirstlane(tid >> 6), lane = tid & 63, wr = wid >> 2, wc = wid & 3, fr = lane & 15, fq = lane >> 4;
    const int K = g.K, nt = K / BK;
    unsigned voffA[2], voffB[2];
#pragma unroll
    for (int i = 0; i < 2; ++i) { int R, C; stage_rc(tid * 16 + i * 8192, R, C); const int Rb = Epi::PERM ? ((R & ~31) + perm32(R & 31)) : R;
        voffA[i] = (unsigned)(R * K + C) * 2u; voffB[i] = (unsigned)(Rb * K + C) * 2u; }
    const size_t kstep = (size_t)(BK * 2);
    const size_t hstep = (size_t)HALF * K * 2;
    const size_t tstep = 2 * hstep;
    const unsigned ldsw = (unsigned)wid * 1024u;
    const int aoff = lds_byte(wr * 64 + fr, fq * 8), boff = lds_byte(wc * 32 + fr, fq * 8);
#define PG8_SA(b, h) (((b) * 2 + (h)) * HTB)
#define PG8_SB(b, h) ((4 + (b) * 2 + (h)) * HTB)
#define PG8_STAGE(bufoff, gbase, voff) do { _Pragma("unroll") for (int _i = 0; _i < 2; ++_i) \
        __builtin_amdgcn_global_load_lds((const unsigned*)((const char*)(gbase) + (voff)[_i]), (PG8_LAS unsigned*)(lds + (bufoff) + ldsw + _i * 8192), 16, 0, 0); } while (0)
#define PG8_LDA(dst, b, h) do { _Pragma("unroll") for (int m = 0; m < 4; ++m) _Pragma("unroll") for (int k = 0; k < 2; ++k) dst[m][k] = *(const PG8_LAS bf16x8*)(lds + PG8_SA(b, h) + aoff + m * 2048 + k * 1024); } while (0)
#define PG8_LDB(dst, b, h) do { _Pragma("unroll") for (int n = 0; n < 2; ++n) _Pragma("unroll") for (int k = 0; k < 2; ++k) dst[n][k] = *(const PG8_LAS bf16x8*)(lds + PG8_SB(b, h) + boff + n * 2048 + k * 1024); } while (0)
#define PG8_MMA(ai, bj, At, Bt) do { __builtin_amdgcn_s_setprio(1); _Pragma("unroll") for (int m = 0; m < 4; ++m) _Pragma("unroll") for (int n = 0; n < 2; ++n) _Pragma("unroll") for (int k = 0; k < 2; ++k) \
        acc[ai][bj][m][n] = __builtin_amdgcn_mfma_f32_16x16x32_bf16(Bt[n][k], At[m][k], acc[ai][bj][m][n], 0, 0, 0); __builtin_amdgcn_s_setprio(0); } while (0)
#define PG8_WAIT_V(n) asm volatile("s_waitcnt vmcnt(" #n ")" ::: "memory")
#define PG8_WAIT_L(n) asm volatile("s_waitcnt lgkmcnt(" #n ")" ::: "memory")
#define PG8_BAR __builtin_amdgcn_s_barrier()
#define PG8_SCHED __builtin_amdgcn_sched_barrier(0)
    Unit cur, nxt; int ui = 0;
    if (!S.next(0, cur)) return;
    f32x4 acc[2][2][4][2];
#pragma unroll
    for (int a = 0; a < 2; ++a)
#pragma unroll
        for (int b = 0; b < 2; ++b)
#pragma unroll
            for (int m = 0; m < 4; ++m)
#pragma unroll
                for (int n = 0; n < 2; ++n) acc[a][b][m][n] = (f32x4){0.f, 0.f, 0.f, 0.f};
    bf16x8 At[4][2], B0[2][2], B1[2][2];
    const char* cA = (const char*)g.A + (size_t)cur.pm * tstep; const char* cB = (const char*)g.Bt + (size_t)cur.pn * tstep;
    S.a_ready(cur);
    if constexpr (SP2) {
        PG8_STAGE(PG8_SB(0, 0), cB, voffB); PG8_STAGE(PG8_SB(0, 1), cB + hstep, voffB); PG8_STAGE(PG8_SA(0, 0), cA, voffA); PG8_STAGE(PG8_SA(0, 1), cA + hstep, voffA);
        if (wr == 1) PG8_BAR;
        PG8_WAIT_V(2); PG8_BAR;
        PG8_STAGE(PG8_SB(1, 0), cB + kstep, voffB); PG8_STAGE(PG8_SA(1, 0), cA + kstep, voffA); PG8_STAGE(PG8_SB(1, 1), cB + hstep + kstep, voffB);
        PG8_WAIT_V(6); PG8_BAR;
    } else {
        PG8_STAGE(PG8_SB(0, 0), cB, voffB); PG8_STAGE(PG8_SA(0, 0), cA, voffA); PG8_STAGE(PG8_SB(0, 1), cB + hstep, voffB); PG8_STAGE(PG8_SA(0, 1), cA + hstep, voffA);
        if (wr == 1) PG8_BAR;
        PG8_WAIT_V(4); PG8_BAR;
        PG8_STAGE(PG8_SB(1, 0), cB + kstep, voffB); PG8_STAGE(PG8_SA(1, 0), cA + kstep, voffA); PG8_STAGE(PG8_SB(1, 1), cB + hstep + kstep, voffB);
        PG8_WAIT_V(6); PG8_BAR;
    }
    for (;;) {
        const bool has_next = S.next(ui + 1, nxt);
        const char* nA = has_next ? (const char*)g.A + (size_t)nxt.pm * tstep : cA; const char* nB = has_next ? (const char*)g.Bt + (size_t)nxt.pn * tstep : cB;
        for (int t = 0; t < nt; t += 2) {
            const bool last = (t == nt - 2);
            const char* a1 = cA + (size_t)(t + 1) * kstep;
            const char* a2 = last ? nA : cA + (size_t)(t + 2) * kstep; const char* b2 = last ? nB : cB + (size_t)(t + 2) * kstep;
            const char* a3 = a2 + kstep; const char* b3 = b2 + kstep;
            if (last && has_next) S.a_ready(nxt);
            if constexpr (SP2) {
            PG8_LDB(B0, 0, 0); PG8_LDB(B1, 0, 1); PG8_SCHED; PG8_LDA(At, 0, 0); PG8_STAGE(PG8_SA(1, 1), a1 + hstep, voffA);
            PG8_WAIT_V(8); PG8_WAIT_L(0); PG8_BAR; PG8_MMA(0, 0, At, B0); PG8_MMA(0, 1, At, B1); PG8_BAR; PG8_SCHED;
            PG8_LDA(At, 0, 1); PG8_STAGE(PG8_SB(0, 0), b2, voffB); PG8_STAGE(PG8_SB(0, 1), b2 + hstep, voffB); PG8_STAGE(PG8_SA(0, 0), a2, voffA);
            PG8_WAIT_V(8); PG8_WAIT_L(0); PG8_BAR; PG8_MMA(1, 0, At, B0); PG8_MMA(1, 1, At, B1); PG8_BAR; PG8_SCHED;
            PG8_LDB(B0, 1, 0); PG8_LDB(B1, 1, 1); PG8_SCHED; PG8_LDA(At, 1, 0); PG8_STAGE(PG8_SA(0, 1), a2 + hstep, voffA);
            PG8_WAIT_V(8); PG8_WAIT_L(0); PG8_BAR; PG8_MMA(0, 0, At, B0); PG8_MMA(0, 1, At, B1); PG8_BAR; PG8_SCHED;
            PG8_LDA(At, 1, 1); PG8_STAGE(PG8_SB(1, 0), b3, voffB); PG8_STAGE(PG8_SB(1, 1), b3 + hstep, voffB); PG8_STAGE(PG8_SA(1, 0), a3, voffA);
            PG8_WAIT_V(8); PG8_WAIT_L(0); PG8_BAR; PG8_MMA(1, 0, At, B0); PG8_MMA(1, 1, At, B1); PG8_BAR; PG8_SCHED;
            } else {
            PG8_LDB(B0, 0, 0); PG8_SCHED; PG8_LDA(At, 0, 0); PG8_STAGE(PG8_SA(1, 1), a1 + hstep, voffA);
            PG8_WAIT_L(8); PG8_BAR; PG8_WAIT_L(0); PG8_MMA(0, 0, At, B0); PG8_BAR; PG8_SCHED;
            PG8_LDB(B1, 0, 1); PG8_STAGE(PG8_SB(0, 0), b2, voffB);
            PG8_BAR; PG8_WAIT_L(0); PG8_MMA(0, 1, At, B1); PG8_BAR;
            PG8_LDA(At, 0, 1); PG8_STAGE(PG8_SA(0, 0), a2, voffA);
            PG8_BAR; PG8_WAIT_L(0); PG8_MMA(1, 0, At, B0); PG8_BAR; PG8_SCHED;
            PG8_STAGE(PG8_SB(0, 1), b2 + hstep, voffB);
            PG8_WAIT_V(6); PG8_BAR; PG8_MMA(1, 1, At, B1); PG8_BAR;
            PG8_LDB(B0, 1, 0); PG8_SCHED; PG8_LDA(At, 1, 0); PG8_STAGE(PG8_SA(0, 1), a2 + hstep, voffA);
            PG8_WAIT_L(8); PG8_BAR; PG8_WAIT_L(0); PG8_MMA(0, 0, At, B0); PG8_BAR; PG8_SCHED;
            PG8_LDB(B1, 1, 1); PG8_STAGE(PG8_SB(1, 0), b3, voffB);
            PG8_BAR; PG8_WAIT_L(0); PG8_MMA(0, 1, At, B1); PG8_BAR;
            PG8_LDA(At, 1, 1); PG8_STAGE(PG8_SA(1, 0), a3, voffA);
            PG8_BAR; PG8_WAIT_L(0); PG8_MMA(1, 0, At, B0); PG8_BAR; PG8_SCHED;
            PG8_STAGE(PG8_SB(1, 1), b3 + hstep, voffB);
            PG8_WAIT_V(6); PG8_BAR; PG8_MMA(1, 1, At, B1); PG8_BAR;
            }
        }
        if constexpr (ALIGN_EPI) { if (wr == 0) PG8_BAR; }
        if constexpr (!Epi::AFTER_DRAIN) { E(acc, cur, wr, wc, fr, fq); S.done(cur); }
        if (!has_next) break;
#pragma unroll
        for (int a = 0; a < 2; ++a)
#pragma unroll
            for (int b = 0; b < 2; ++b)
#pragma unroll
                for (int m = 0; m < 4; ++m)
#pragma unroll
                    for (int n = 0; n < 2; ++n) acc[a][b][m][n] = (f32x4){0.f, 0.f, 0.f, 0.f};
        cur = nxt; cA = nA; cB = nB; ++ui;
        if constexpr (ALIGN_EPI) { if (wr == 1) PG8_BAR; }
    }
    PG8_WAIT_V(0);
    if constexpr (!ALIGN_EPI) { if (wr == 0) PG8_BAR; }
    PG8_BAR;
    if constexpr (Epi::AFTER_DRAIN) { E.fused(acc, cur, wr, wc, fr, fq, lds, wid, lane); S.done(cur); }
#undef PG8_SA
#undef PG8_SB
#undef PG8_STAGE
#undef PG8_LDA
#undef PG8_LDB
#undef PG8_MMA
#undef PG8_WAIT_V
#undef PG8_WAIT_L
#undef PG8_BAR
#undef PG8_SCHED
}
}
namespace att {
#define QKT_SPLIT 1
#ifndef CINIT_TEST
#define CINIT_TEST 0
#endif
using bf16 = __hip_bfloat16;
typedef short bf16x8 __attribute__((ext_vector_type(8)));
typedef short s16x4 __attribute__((ext_vector_type(4)));
typedef float f32x16 __attribute__((ext_vector_type(16)));
typedef float f32x4 __attribute__((ext_vector_type(4)));
typedef unsigned u32x4 __attribute__((ext_vector_type(4)));
constexpr int D = 128, NW = 8, QBLK = 32, KVBLK = 64, QB = NW * QBLK, SEQ = 4096;
constexpr int SHM_V = KVBLK * D * 2, SHM_K = KVBLK * D * 2;
constexpr int OFF_WS = 2 * SHM_V + 2 * SHM_K;
constexpr int OFF_LUT = OFF_WS + NW * 64 * 4;
constexpr int LUT_FLOATS = 4 * 512 + 64;
constexpr int OFF_G = OFF_LUT + LUT_FLOATS * 4;
constexpr int LDS_BYTES = OFF_G + 2 * 64 * 4;
constexpr float SCALE = 0.08838834764831845f, INV_SCALE = 11.313708498984761f, THR = 8.f;
constexpr int OSTR = 1024;

#define KSWZ(row, colB) ((row) * 256 + ((colB) ^ (((row) & 7) << 4)))
#define SBAR() __builtin_amdgcn_sched_barrier(0)
__device__ __forceinline__ int v_st(int k, int c) { const int kk = (k & ~0xC) | ((k & 4) << 1) | ((k & 8) >> 1); return ((kk >> 3) * 4 + (c >> 5)) * 512 + ((kk & 7) * 32 + (c & 31)) * 2; }
__device__ __forceinline__ int v_rd_base(int lane) { return ((lane & 3) << 3) | (((lane >> 2) & 3) << 6) | (((lane >> 4) & 1) << 5) | (((lane >> 5) & 1) << 8); }
constexpr int v_rd_off(int d0, int ks, int half) { return d0 * 512 + ks * 4096 + half * 2048; }
__device__ __forceinline__ int crow(int r, int hi) { return (r & 3) + 8 * (r >> 2) + 4 * hi; }
__device__ __forceinline__ unsigned cvtpk(float lo, float hi) { unsigned r; asm volatile("v_cvt_pk_bf16_f32 %0, %1, %2" : "=v"(r) : "v"(lo), "v"(hi)); return r; }
__device__ __forceinline__ bf16x8 load8(const bf16* p) { return *reinterpret_cast<const bf16x8*>(p); }
__device__ __forceinline__ void mask_tile(f32x16& p0, f32x16& p1, int dq) {
    const float NEG = -__builtin_inff();
#pragma unroll
    for (int r = 0; r < 16; ++r) { const int c = (r & 3) + 8 * (r >> 2);
        if (dq - c < 0) p0[r] = NEG;
        if (dq - c - 32 < 0) p1[r] = NEG; }
}
__device__ __forceinline__ void partialSM(f32x16& p0, f32x16& p1, float& m_reg, float& mn, float& alpha) {
    float pmax = p0[0]; for (int r = 1; r < 16; ++r) pmax = fmaxf(pmax, p0[r]); for (int r = 0; r < 16; ++r) pmax = fmaxf(pmax, p1[r]);
    { auto rr = __builtin_amdgcn_permlane32_swap(__float_as_uint(pmax), __float_as_uint(pmax), false, false);
      pmax = fmaxf(__uint_as_float(rr[0]), __uint_as_float(rr[1])); }
    constexpr float C2 = 1.4426950408889634f * SCALE;
    if (__builtin_expect(__all((pmax - m_reg) * SCALE <= THR), 1)) { mn = m_reg; alpha = 1.f; }
    else { mn = fmaxf(m_reg, pmax); alpha = __builtin_amdgcn_exp2f((m_reg - mn) * C2); m_reg = mn; }
    const float mnL = -mn * C2;
    for (int r = 0; r < 16; ++r) p0[r] = fmaf(p0[r], C2, mnL); for (int r = 0; r < 16; ++r) p1[r] = fmaf(p1[r], C2, mnL);
    for (int r = 0; r < 16; ++r) p0[r] = __builtin_amdgcn_exp2f(p0[r]);
}
#define ATT_PK4(P, B_, OUT) do { unsigned a0 = cvtpk(P[B_+0], P[B_+1]), a1 = cvtpk(P[B_+2], P[B_+3]);                          \
        unsigned b0 = cvtpk(P[B_+4], P[B_+5]), b1 = cvtpk(P[B_+6], P[B_+7]);                                             \
        auto r0 = __builtin_amdgcn_permlane32_swap(a0, b0, false, false); auto r1 = __builtin_amdgcn_permlane32_swap(a1, b1, false, false); \
        u32x4 w = {r0[0], r1[0], r0[1], r1[1]}; OUT = *reinterpret_cast<bf16x8*>(&w); } while (0)
__device__ __forceinline__ void finishSM(f32x16& p0, f32x16& p1, float alpha, float& l_reg, bf16x8& pa0, bf16x8& pa1, bf16x8& pa2, bf16x8& pa3) {
    for (int r = 0; r < 16; ++r) p1[r] = __builtin_amdgcn_exp2f(p1[r]);
    float ps = 0; for (int r = 0; r < 16; ++r) ps += p0[r]; for (int r = 0; r < 16; ++r) ps += p1[r];
    { auto rr = __builtin_amdgcn_permlane32_swap(__float_as_uint(ps), __float_as_uint(ps), false, false);
      ps = __uint_as_float(rr[0]) + __uint_as_float(rr[1]); }
    l_reg = l_reg * alpha + ps;
    ATT_PK4(p0, 0, pa0); ATT_PK4(p0, 8, pa1); ATT_PK4(p1, 0, pa2); ATT_PK4(p1, 8, pa3);
}
__device__ __forceinline__ void qkt(f32x16& p0, f32x16& p1, const char* K_tile, int r32, int hi, const bf16x8* qr) {
    const char* kb[4];
#pragma unroll
    for (int dd = 0; dd < 4; ++dd) kb[dd] = K_tile + KSWZ(r32, (dd * 16 + hi * 8) * 2);
#pragma unroll
    for (int d0 = 0; d0 < 8; ++d0) { const char* a = kb[d0 & 3] + (d0 >> 2) * 128;
        bf16x8 b0 = *reinterpret_cast<const bf16x8*>(a);
        bf16x8 b1 = *reinterpret_cast<const bf16x8*>(a + 32 * 256);
        p0 = __builtin_amdgcn_mfma_f32_32x32x16_bf16(b0, qr[d0], p0, 0, 0, 0);
        p1 = __builtin_amdgcn_mfma_f32_32x32x16_bf16(b1, qr[d0], p1, 0, 0, 0);
#ifdef QKT_SPLIT
        if (d0 == 3) SBAR();
#endif
    }
}
template <int VOFF>
__device__ __forceinline__ void pv_tile(f32x16* o, int vb0, bf16x8 pa0, bf16x8 pa1, bf16x8 pa2, bf16x8 pa3) {
#define TRRD(dst, off) asm volatile("ds_read_b64_tr_b16 %0, %1 offset:%2" : "=&v"(dst) : "v"(vb0), "i"(off) : "memory")
#define PV_D0(d0) do { s16x4 l0, l1, l2, l3, h0, h1, h2, h3; constexpr int b_ = VOFF + v_rd_off(d0, 0, 0); \
        TRRD(l0, b_); TRRD(h0, b_ + 2048); TRRD(l1, b_ + 4096); TRRD(h1, b_ + 6144); TRRD(l2, b_ + 8192); TRRD(h2, b_ + 10240); TRRD(l3, b_ + 12288); TRRD(h3, b_ + 14336); \
        asm volatile("s_waitcnt lgkmcnt(0)" ::: "memory"); SBAR();   \
        o[d0] = __builtin_amdgcn_mfma_f32_32x32x16_bf16(pa0, (bf16x8){l0[0], l0[1], l0[2], l0[3], h0[0], h0[1], h0[2], h0[3]}, o[d0], 0, 0, 0);   \
        o[d0] = __builtin_amdgcn_mfma_f32_32x32x16_bf16(pa1, (bf16x8){l1[0], l1[1], l1[2], l1[3], h1[0], h1[1], h1[2], h1[3]}, o[d0], 0, 0, 0);   \
        o[d0] = __builtin_amdgcn_mfma_f32_32x32x16_bf16(pa2, (bf16x8){l2[0], l2[1], l2[2], l2[3], h2[0], h2[1], h2[2], h2[3]}, o[d0], 0, 0, 0);   \
        o[d0] = __builtin_amdgcn_mfma_f32_32x32x16_bf16(pa3, (bf16x8){l3[0], l3[1], l3[2], l3[3], h3[0], h3[1], h3[2], h3[3]}, o[d0], 0, 0, 0); } while (0)
    PV_D0(0); PV_D0(1); PV_D0(2); PV_D0(3);
#undef PV_D0
#undef TRRD
}

struct ABase { const bf16* Q; const bf16* K; const bf16* V; bf16* O; const float* F; const unsigned* sel; int nh, ocol0; };
struct ADesc { __amdgpu_buffer_rsrc_t q, k, v, f; };
struct AItem { int bh, qb; };
#define A_HB(it)  ((size_t)(it).bh * SEQ * D)
#define A_Q(it)   (B.Q + A_HB(it) + (size_t)(it).qb * QB * D)
#define A_K(it)   (B.K + A_HB(it))
#define A_V(it)   (B.V + A_HB(it))
#define A_F(it)   (B.F + (size_t)(it).bh * SEQ)
#define A_O(it)   (B.O + ((size_t)((it).bh / B.nh) * SEQ + (size_t)(it).qb * QB) * OSTR + B.ocol0 + ((it).bh % B.nh) * D)
#define A_SEL(it) (B.sel + (size_t)(it).bh * SEQ + (size_t)(it).qb * QB)
#define A_P0(it)  ((it).qb * QB)
struct Seam { bf16x8 qr[8]; bf16x8 st_v0, st_v1, st_k0, st_k1; float st_g; };
template <int MODE> __device__ __forceinline__ int first_kb(int P0) { return MODE == 0 ? P0 + QB - KVBLK : 0; }
#define VMW() asm volatile("s_waitcnt vmcnt(0)" ::: "memory")
#define VMWN(n) asm volatile("s_waitcnt vmcnt(%0)" :: "i"(n) : "memory")
#define BL16(rs, vo, so) __builtin_bit_cast(bf16x8, __builtin_amdgcn_raw_buffer_load_b128((rs), (int)(vo), (int)(so), 0))
#define SLOAD_H(it, k0) do { const unsigned so_ = (unsigned)(((it).bh * SEQ + (k0)) * D * 2);                                                  \
                         S.st_v0 = BL16(DS.v, loff, so_); S.st_v1 = BL16(DS.v, loff, so_ + 32 * D * 2);                                     \
                         S.st_k0 = BL16(DS.k, loff, so_); S.st_k1 = BL16(DS.k, loff, so_ + 32 * D * 2);                                     \
                         if (MODE == 0) S.st_g = __builtin_bit_cast(float, __builtin_amdgcn_raw_buffer_load_b32(DS.f, (int)((tid & 63u) * 4u), (int)(((it).bh * SEQ + (k0)) * 4), 0)); } while (0)
#define QLOAD(it) do { const unsigned so_ = (unsigned)((((it).bh * SEQ) + (it).qb * QB) * D * 2);                                              \
                         _Pragma("unroll") for (int d0 = 0; d0 < 8; ++d0) S.qr[d0] = BL16(DS.q, qoff + d0 * 32, so_); } while (0)
#define SWRITE_HK(bf) do { *(bf16x8*)(K_lds + (bf) * SHM_K + kws) = S.st_k0; *(bf16x8*)(K_lds + (bf) * SHM_K + kws + 32 * 256) = S.st_k1; \
                           if (MODE == 0 && tid < 64) ((float*)(lds + OFF_G))[(bf) * 64 + tid] = S.st_g; } while (0)
#define SWRITE_HV(bf) do { *(bf16x8*)(V_lds + (bf) * SHM_V + vst0) = S.st_v0; *(bf16x8*)(V_lds + (bf) * SHM_V + vst1) = S.st_v1; } while (0)
#define SWRITE_H(bf) do { SWRITE_HV(bf); SWRITE_HK(bf); } while (0)
template <int MODE>
__device__ __forceinline__ void attn_prime(const ABase& B, const ADesc& DS, const AItem& cur, char* lds, Seam& S) {
    const int tid = threadIdx.x, wid = __builtin_amdgcn_readfirstlane(tid >> 6), lane = tid & 63, r32 = lane & 31, hi = lane >> 5;
    const int sr = tid >> 4, sc = (tid & 15) * 8, kws = KSWZ(sr, sc * 2); char* K_lds = lds + 2 * SHM_V; const unsigned loff = (unsigned)(sr * D + sc) * 2u, qoff = (unsigned)((wid * QBLK + r32) * D + hi * 8) * 2u;
    const int kb0 = first_kb<MODE>(A_P0(cur));
    QLOAD(cur);
    SLOAD_H(cur, kb0); VMW(); SWRITE_HK(0);
    __syncthreads();
}
template <int MODE>
__device__ __forceinline__ void attn_block(const ABase& B, const ADesc& DS, const AItem& cur, const AItem& nxt, char* lds, Seam& S) {
    const int tid = threadIdx.x, wid = __builtin_amdgcn_readfirstlane(tid >> 6), lane = tid & 63, r32 = lane & 31, hi = lane >> 5;
    const int P0 = A_P0(cur), NT = (P0 + QB) / KVBLK;
    const int kbn = first_kb<MODE>(A_P0(nxt));
    const int qlo = P0 + wid * QBLK, qm = qlo + r32 - 4 * hi;
    char* V_lds = lds; char* K_lds = lds + 2 * SHM_V;
    float* ws = (float*)(lds + OFF_WS) + wid * 64; float* li_l = ws, * al_l = ws + 32;
    float m_reg = -1e30f, l_reg = 0; f32x16 o[4] = {};
    const int sr = tid >> 4, sc = (tid & 15) * 8, vst0 = v_st(sr, sc), vst1 = v_st(32 + sr, sc), kws = KSWZ(sr, sc * 2);
    const unsigned loff = (unsigned)(sr * D + sc) * 2u, qoff = (unsigned)((wid * QBLK + r32) * D + hi * 8) * 2u;
    const int vb0 = (int)(uintptr_t)V_lds + v_rd_base(lane);
    const float* Fh = A_F(cur);
    const float* lut = (const float*)(lds + OFF_LUT) + (cur.bh % B.nh) * 512 + 256;
    unsigned selrow = 0; const int own = P0 >> 8;
    if (MODE == 1) { selrow = A_SEL(cur)[wid * QBLK + r32] | (1u << own); }
#define RESC(a) do { if (__any((a) < 1.f)) { if (hi == 0) al_l[r32] = (a); asm volatile("s_waitcnt lgkmcnt(0)" ::: "memory");              \
                     for (int d_ = 0; d_ < 4; ++d_) for (int r = 0; r < 16; ++r) o[d_][r] *= al_l[crow(r, hi)]; } } while (0)
#define KBASE(t) (MODE == 0 ? (NT - 1 - (t)) * KVBLK : (t) * KVBLK)
#define MASKT(P0_, P1_, t) do { const int kb_ = KBASE(t); if (kb_ + KVBLK - 1 > qlo) mask_tile(P0_, P1_, qm - kb_); } while (0)
#define CINIT(P0_, P1_, t, KB) do { const int kb_ = KBASE(t);                                                                               \
        if (MODE == 0) { const float* fp_ = (const float*)(lds + OFF_G) + (KB) * 64 + 4 * hi;                                               \
            _Pragma("unroll") for (int g_ = 0; g_ < 4; ++g_) { const f32x4 a_ = *(const f32x4*)(fp_ + 8 * g_), b_ = *(const f32x4*)(fp_ + 32 + 8 * g_);   \
                _Pragma("unroll") for (int i_ = 0; i_ < 4; ++i_) { P0_[4 * g_ + i_] = a_[i_]; P1_[4 * g_ + i_] = b_[i_]; } } }   \
        else { const bool keep_ = (selrow >> (kb_ >> 8)) & 1u; const float NEG_ = -__builtin_inff();                                         \
            if (CINIT_TEST == 1 || (CINIT_TEST == 0 && qlo - kb_ - (KVBLK - 1) >= 113)) { const float v_ = keep_ ? lut[127] : NEG_;                                                  \
                _Pragma("unroll") for (int r_ = 0; r_ < 16; ++r_) { P0_[r_] = v_; P1_[r_] = v_; } }                                          \
            else { const float* lp_ = keep_ ? lut + (qlo + r32 - kb_ - 4 * hi - 59) : (const float*)(lds + OFF_LUT) + 2048;                  \
                _Pragma("unroll") for (int r_ = 0; r_ < 16; ++r_) { const int c_ = (r_ & 3) + 8 * (r_ >> 2);                                 \
                    P0_[r_] = lp_[59 - c_]; P1_[r_] = lp_[27 - c_]; } } } } while (0)
    constexpr int NQL = 8;
#define SEAM_K0() do { VMWN(NQL); SWRITE_HK(0); SBAR(); } while (0)
    f32x16 pA0, pA1, pB0, pB1; float mnA, mnB, alA, alB; bf16x8 pa0, pa1, pa2, pa3;
    SWRITE_HV(0); SBAR();
    CINIT(pA0, pA1, 0, 0);
    SLOAD_H(cur, KBASE(1));
    SBAR(); qkt(pA0, pA1, K_lds, r32, hi, S.qr);
    MASKT(pA0, pA1, 0); partialSM(pA0, pA1, m_reg, mnA, alA);
    VMW(); SWRITE_H(1);
    __syncthreads();
#define HALF_STEP(PX0, PX1, mnX, alX, PY0, PY1, alY, t, KB, VB, SB) do {                                                      \
        SBAR(); CINIT(PX0, PX1, (t), (KB)); qkt(PX0, PX1, K_lds + (KB) * SHM_K, r32, hi, S.qr);                                   \
        finishSM(PY0, PY1, alY, l_reg, pa0, pa1, pa2, pa3); SBAR();                                                           \
        if ((t) + 1 < NT) { SLOAD_H(cur, KBASE((t) + 1)); SBAR(); }                                       \
        pv_tile<(VB) * SHM_V>(o, vb0, pa0, pa1, pa2, pa3); MASKT(PX0, PX1, (t)); partialSM(PX0, PX1, m_reg, mnX, alX);         \
        __syncthreads();                                                                                                      \
        if ((t) + 1 < NT) { VMW(); SWRITE_H(SB); }                                                                            \
        RESC(alX); __syncthreads(); } while (0)
    for (int t = 1; t + 1 < NT; t += 2) {
        HALF_STEP(pB0, pB1, mnB, alB, pA0, pA1, alA, t, 1, 0, 0);
        HALF_STEP(pA0, pA1, mnA, alA, pB0, pB1, alB, t + 1, 0, 1, 1);
    }
    SBAR(); CINIT(pB0, pB1, NT - 1, 1); qkt(pB0, pB1, K_lds + SHM_K, r32, hi, S.qr); SBAR();
    SLOAD_H(nxt, kbn); SBAR();
    QLOAD(nxt);
    SBAR();
    finishSM(pA0, pA1, alA, l_reg, pa0, pa1, pa2, pa3); SBAR();
    pv_tile<0>(o, vb0, pa0, pa1, pa2, pa3);
    MASKT(pB0, pB1, NT - 1); partialSM(pB0, pB1, m_reg, mnB, alB); __syncthreads(); RESC(alB);
    finishSM(pB0, pB1, alB, l_reg, pa0, pa1, pa2, pa3); SBAR(); pv_tile<SHM_V>(o, vb0, pa0, pa1, pa2, pa3);
    SBAR(); SEAM_K0();
    if (hi == 0) li_l[r32] = l_reg; asm volatile("s_waitcnt lgkmcnt(0)" ::: "memory");
    float rli[16];
#pragma unroll
    for (int r = 0; r < 16; ++r) rli[r] = __builtin_amdgcn_rcpf(li_l[crow(r, hi)]);
    bf16* Ow = A_O(cur) + (size_t)(wid * QBLK) * OSTR; const unsigned ooff = (unsigned)(4 * hi * OSTR + r32);
#pragma unroll
    for (int r = 0; r < 16; ++r) { const int orow = crow(r, hi);
#pragma unroll
        for (int d0 = 0; d0 < 4; ++d0) { const float v = o[d0][r] * rli[r];
            const float vn = __shfl_xor(v, 1);
            if ((r32 & 1) == 0) *(unsigned*)(Ow + ((r & 3) + 8 * (r >> 2)) * OSTR + d0 * 32 + ooff) = cvtpk(v, vn); } }
    __syncthreads();
#undef RESC
#undef KBASE
#undef MASKT
#undef CINIT
#undef SEAM_K0
#undef HALF_STEP
}
#undef ROW
#undef VMW
#undef VMWN
#undef SLOAD_H
#undef QLOAD
#undef BL16
#undef SWRITE_HK
#undef SWRITE_HV
#undef SWRITE_H
template <int MODE, class Sched>
__device__ __forceinline__ void attn_phase(char* lds, const ABase& B, const Sched& sch) {
    AItem cur, nxt; if (!sch.get(0, cur)) return;
    ADesc DS; const int tb_ = 8 * SEQ * B.nh * D * 2;
    DS.q = __builtin_amdgcn_make_buffer_rsrc((void*)B.Q, (short)0, tb_, 0x00020000); DS.k = __builtin_amdgcn_make_buffer_rsrc((void*)B.K, (short)0, tb_, 0x00020000);
    DS.v = __builtin_amdgcn_make_buffer_rsrc((void*)B.V, (short)0, tb_, 0x00020000); DS.f = __builtin_amdgcn_make_buffer_rsrc((void*)B.F, (short)0, MODE == 0 ? 8 * SEQ * B.nh * 4 : 0, 0x00020000);
    Seam S; attn_prime<MODE>(B, DS, cur, lds, S);
    for (int i = 0;; ++i) {
        const bool more = sch.get(i + 1, nxt); if (!more) nxt = cur;
        attn_block<MODE>(B, DS, cur, nxt, lds, S);
        if (!more) break;
        cur = nxt;
    }
}
#undef SBAR
}
namespace ret {
using att::bf16; using att::bf16x8; using att::s16x4; using att::f32x16; using att::f32x4; using att::u32x4;
using att::crow; using att::cvtpk; using att::load8; using att::v_st; using att::v_rd_base; using att::qkt; using att::pv_tile;
__device__ __forceinline__ float bf_lo(unsigned w) { return __uint_as_float(w << 16); }
__device__ __forceinline__ float bf_hi(unsigned w) { return __uint_as_float(w & 0xffff0000u); }
__device__ __forceinline__ float l2g_of(int h) { return __builtin_log2f(1.f - __builtin_amdgcn_exp2f(-5.f - (float)h)); }
#define SBAR() __builtin_amdgcn_sched_barrier(0)
__device__ __forceinline__ void kv_task(char* lds, const bf16* K, const bf16* V, float* KVt, int h) {
    const int tid = threadIdx.x, wid = __builtin_amdgcn_readfirstlane(tid >> 6), lane = tid & 63, r32 = lane & 31, hi = lane >> 5;
    const float l2g = l2g_of(h);
#pragma unroll
    for (int i = 0; i < 4; ++i) { const int idx = tid + 512 * i, row = idx >> 4, pc = idx & 15;
        const u32x4 kw = *(const u32x4*)(K + (size_t)row * 128 + pc * 8); const bf16x8 vv = load8(V + (size_t)row * 128 + pc * 8);
        const float dec = __builtin_amdgcn_exp2f(l2g * (float)(127 - row));
        u32x4 ks; ks.x = cvtpk(bf_lo(kw.x) * dec, bf_hi(kw.x) * dec); ks.y = cvtpk(bf_lo(kw.y) * dec, bf_hi(kw.y) * dec);
        ks.z = cvtpk(bf_lo(kw.z) * dec, bf_hi(kw.z) * dec); ks.w = cvtpk(bf_lo(kw.w) * dec, bf_hi(kw.w) * dec);
        const int off = (row >> 6) * 16384 + v_st(row & 63, pc * 8);
        *(u32x4*)(lds + off) = ks; *(bf16x8*)(lds + 32768 + off) = vv; }
    __syncthreads();
    const int dkb = wid >> 1, dvb0 = 2 * (wid & 1);
    const int kb = (int)(uintptr_t)lds + v_rd_base(lane) + dkb * 512, vb = (int)(uintptr_t)lds + 32768 + v_rd_base(lane) + dvb0 * 512;
    f32x16 acc0 = {}, acc1 = {};
#define TRRD(dst, base, off) asm volatile("ds_read_b64_tr_b16 %0, %1 offset:%2" : "=&v"(dst) : "v"(base), "i"(off) : "memory")
#define KV_STEP(tt, ks) do { s16x4 al, ah, b0l, b0h, b1l, b1h; constexpr int o_ = (tt) * 16384 + (ks) * 4096;                        \
        TRRD(al, kb, o_); TRRD(ah, kb, o_ + 2048); TRRD(b0l, vb, o_); TRRD(b0h, vb, o_ + 2048); TRRD(b1l, vb, o_ + 512); TRRD(b1h, vb, o_ + 2560);   \
        asm volatile("s_waitcnt lgkmcnt(0)" ::: "memory"); SBAR();                                                                     \
        const bf16x8 A_ = (bf16x8){al[0], al[1], al[2], al[3], ah[0], ah[1], ah[2], ah[3]};                                              \
        acc0 = __builtin_amdgcn_mfma_f32_32x32x16_bf16(A_, (bf16x8){b0l[0], b0l[1], b0l[2], b0l[3], b0h[0], b0h[1], b0h[2], b0h[3]}, acc0, 0, 0, 0);   \
        acc1 = __builtin_amdgcn_mfma_f32_32x32x16_bf16(A_, (bf16x8){b1l[0], b1l[1], b1l[2], b1l[3], b1h[0], b1h[1], b1h[2], b1h[3]}, acc1, 0, 0, 0); } while (0)
    KV_STEP(0, 0); KV_STEP(0, 1); KV_STEP(0, 2); KV_STEP(0, 3); KV_STEP(1, 0); KV_STEP(1, 1); KV_STEP(1, 2); KV_STEP(1, 3);
#undef KV_STEP
#pragma unroll
    for (int g = 0; g < 4; ++g) { const int dk = 32 * dkb + 8 * g + 4 * hi;
        *(f32x4*)(KVt + (size_t)(32 * dvb0 + r32) * 128 + dk) = (f32x4){acc0[4 * g], acc0[4 * g + 1], acc0[4 * g + 2], acc0[4 * g + 3]};
        *(f32x4*)(KVt + (size_t)(32 * (dvb0 + 1) + r32) * 128 + dk) = (f32x4){acc1[4 * g], acc1[4 * g + 1], acc1[4 * g + 2], acc1[4 * g + 3]}; }
    __syncthreads();
}
__device__ __forceinline__ void out_task(char* lds, const bf16* Q, const bf16* K, const bf16* V, const bf16* ST, const bf16* RG, const float* gn, bf16* CAT, int h) {
    const int tid = threadIdx.x, wid = __builtin_amdgcn_readfirstlane(tid >> 6), lane = tid & 63, r32 = lane & 31, hi = lane >> 5;
    const int ch = wid >> 2, wq = wid & 3, ltid = tid & 255;
    const float l2g = l2g_of(h);
    char* Vreg = lds + ch * 32768; char* Kreg = lds + 65536 + ch * 32768;
#pragma unroll
    for (int i = 0; i < 8; ++i) { const int row = (ltid >> 4) + 16 * i, pc = ltid & 15;
        const bf16x8 kv = load8(K + (size_t)(ch * 128 + row) * 128 + pc * 8), vv = load8(V + (size_t)(ch * 128 + row) * 128 + pc * 8);
        *(bf16x8*)(Kreg + (row >> 6) * 16384 + KSWZ(row & 63, pc * 16)) = kv;
        *(bf16x8*)(Vreg + (row >> 6) * 16384 + v_st(row & 63, pc * 8)) = vv; }
    bf16x8 qr[8];
#pragma unroll
    for (int d0 = 0; d0 < 8; ++d0) qr[d0] = load8(Q + (size_t)(ch * 128 + wq * 32 + r32) * 128 + d0 * 16 + hi * 8);
    f32x16 o[4] = {};
    const bf16* STc = ST + (size_t)ch * 16384;
#pragma unroll
    for (int d0 = 0; d0 < 4; ++d0) { bf16x8 sf[8];
#pragma unroll
        for (int ks = 0; ks < 8; ++ks) sf[ks] = load8(STc + (size_t)(d0 * 32 + r32) * 128 + ks * 16 + hi * 8);
#pragma unroll
        for (int ks = 0; ks < 8; ++ks) o[d0] = __builtin_amdgcn_mfma_f32_32x32x16_bf16(qr[ks], sf[ks], o[d0], 0, 0, 0); }
#pragma unroll
    for (int r = 0; r < 16; ++r) { const float qd = __builtin_amdgcn_exp2f(l2g * (float)(wq * 32 + crow(r, hi) + 1));
#pragma unroll
        for (int d0 = 0; d0 < 4; ++d0) o[d0][r] *= qd; }
    __syncthreads();
    const int vb0 = (int)(uintptr_t)Vreg + v_rd_base(lane), row = wq * 32 + r32;
    for (int kt = 0; kt < 2; ++kt) { if (kt * 64 > wq * 32 + 31) break;
        f32x16 p0 = {}, p1 = {};
        qkt(p0, p1, Kreg + kt * 16384, r32, hi, qr);
#pragma unroll
        for (int r = 0; r < 16; ++r) { const int k0 = kt * 64 + crow(r, hi), k1 = k0 + 32;
            p0[r] = (k0 <= row) ? p0[r] * __builtin_amdgcn_exp2f(l2g * (float)(row - k0)) : 0.f;
            p1[r] = (k1 <= row) ? p1[r] * __builtin_amdgcn_exp2f(l2g * (float)(row - k1)) : 0.f; }
        bf16x8 pa0, pa1, pa2, pa3;
        ATT_PK4(p0, 0, pa0); ATT_PK4(p0, 8, pa1); ATT_PK4(p1, 0, pa2); ATT_PK4(p1, 8, pa3);
        SBAR(); pv_tile<0>(o, vb0 + kt * 16384, pa0, pa1, pa2, pa3); }
    float gnv[4];
#pragma unroll
    for (int d0 = 0; d0 < 4; ++d0) gnv[d0] = gn[d0 * 32 + r32];
#pragma unroll
    for (int r = 0; r < 16; ++r) { const int trow = ch * 128 + wq * 32 + crow(r, hi);
        float s = (o[0][r] + o[1][r]) + (o[2][r] + o[3][r]);
        s += __shfl_xor(s, 1); s += __shfl_xor(s, 2); s += __shfl_xor(s, 4); s += __shfl_xor(s, 8); s += __shfl_xor(s, 16);
        const float mu = s * (1.f / 128.f); float dv[4], q = 0.f;
#pragma unroll
        for (int d0 = 0; d0 < 4; ++d0) { dv[d0] = o[d0][r] - mu; q += dv[d0] * dv[d0]; }
        q += __shfl_xor(q, 1); q += __shfl_xor(q, 2); q += __shfl_xor(q, 4); q += __shfl_xor(q, 8); q += __shfl_xor(q, 16);
        const float rstd = __builtin_amdgcn_rsqf(q * (1.f / 128.f) + 1e-5f);
#pragma unroll
        for (int d0 = 0; d0 < 4; ++d0) { const float g = __bfloat162float(RG[(size_t)trow * 512 + d0 * 32 + r32]);
            const float y = dv[d0] * rstd * gnv[d0] * g * __builtin_amdgcn_rcpf(1.f + __builtin_amdgcn_exp2f(-1.4426950408889634f * g));
            const float yn = __shfl_xor(y, 1);
            if ((r32 & 1) == 0) *(unsigned*)(CAT + (size_t)trow * 1024 + d0 * 32 + r32) = cvtpk(y, yn); } }
    __syncthreads();
}
#undef TRRD
#undef SBAR
}
constexpr int NWAVES = 8;
constexpr int BATCH = 8, SEQ = 4096, DM = 1024, T = BATCH * SEQ, FFH = 2816;
constexpr size_t MiB = 1u << 20;
constexpr size_t WS_CTL = 0, CTL_ZERO_BYTES = 1 * MiB;
constexpr size_t WS_COS = 1 * MiB, WS_SIN = 2 * MiB;
constexpr size_t WS_WFL = 3 * MiB;
constexpr size_t WS_KMEAN = 3 * MiB + 65536;
constexpr size_t WS_SEL = 4 * MiB;
constexpr size_t WS_LOGF = 5 * MiB;
constexpr size_t WS_FCUM = 6 * MiB;
constexpr size_t WS_WP0 = 8 * MiB, WS_WO0 = 15 * MiB, WS_WFI0 = 17 * MiB, WS_WFO0 = 28 * MiB, WS_WP1 = 34 * MiB, WS_WO1 = 40 * MiB, WS_WFI1 = 42 * MiB, WS_WFO1 = 53 * MiB;
constexpr size_t WS_A = 64 * MiB;
constexpr size_t WS_B = 128 * MiB;
constexpr size_t WS_C = 352 * MiB;
constexpr size_t WS_D = 416 * MiB;
constexpr size_t WS_END = 480 * MiB;
constexpr int CW_BAR = 4096;
constexpr int RING_BYTES = 131072, MISC_OFF = RING_BYTES + 320, LDS_BYTES = 147456;
constexpr int SCR_OFF = RING_BYTES + 1024;

typedef unsigned short bf16r;
typedef unsigned v4u __attribute__((ext_vector_type(4)));
typedef float f32x4 __attribute__((ext_vector_type(4)));
#define LDS_WAIT() asm volatile("s_waitcnt lgkmcnt(0)" ::: "memory")
__device__ __forceinline__ unsigned pk2(float lo, float hi) { unsigned r; asm volatile("v_cvt_pk_bf16_f32 %0, %1, %2" : "=v"(r) : "v"(lo), "v"(hi)); return r; }
__device__ __forceinline__ float wave_sum(float v) {
#pragma unroll
    for (int o = 1; o < 64; o <<= 1) v += __shfl_xor(v, o);
    return v;
}
__device__ __forceinline__ int t5_bucket(int rel) {
    int n = rel > 0 ? rel : 0; if (n < 16) return n;
    int large = 16 + (int)(logf((float)n / 16.f) / 2.0794415416798357f * 16.f);
    return large < 31 ? large : 31;
}
template <int MAP> __device__ __forceinline__ int dest_row(int n) {
    if (MAP == 1) { if (n >= 1024) return n; const int d = n & 127, j = d & 63; return (n & ~127) + 8 * (j >> 2) + (j & 3) + ((d >> 6) << 2); }
    if (MAP == 2) { if (n < FFH) return 256 * (n >> 7) + (n & 127); const int c = n - FFH; return 256 * (c >> 7) + 128 + (c & 127); }
    return n;
}
template <int MAP> __device__ __forceinline__ void transpose_item(const float* W, int K, int N, int ldw, bf16r* WT, LAS float* scr, int item, int lane) {
    const int nblk = N / 32, kb = item / nblk, nb = item % nblk, k0 = 64 * kb, n0 = 32 * nb;
#pragma unroll 8
    for (int i = 0; i < 32; ++i) { const int kk = 2 * i + (lane >> 5); scr[kk * 33 + (lane & 31)] = W[(size_t)(k0 + kk) * ldw + n0 + (lane & 31)]; }
    LDS_WAIT(); asm volatile("" ::: "memory");
    const int c = lane & 7;
#pragma unroll
    for (int j = 0; j < 4; ++j) { const int n = (lane >> 3) + 8 * j; const LAS float* s = scr + (8 * c) * 33 + n;
        v4u o; o.x = pk2(s[0 * 33], s[1 * 33]); o.y = pk2(s[2 * 33], s[3 * 33]); o.z = pk2(s[4 * 33], s[5 * 33]); o.w = pk2(s[6 * 33], s[7 * 33]);
        *(v4u*)(WT + (size_t)dest_row<MAP>(n0 + n) * K + k0 + 8 * c) = o; }
    LDS_WAIT(); asm volatile("" ::: "memory");
}
struct P {
    const float *x, *relb, *nmpre, *nmpost, *nfpre, *nfpost, *ewin, *egn, *ewout, *owin, *obf, *owout, *fwin, *fwout; float* out; unsigned char* ws;
};
template <bool HAS_M, bool HAS_HN, bool HAS_LOGF>
__device__ __forceinline__ void row_pass(int gw, int NGW, int lane, const float* xin, const bf16r* m, const float* gpost, const float* gpre, float* xout, bf16r* hn,
                                         const LAS float* wfl, const float* bfg, float* logf_out) {
    f32x4 gp[4], gq[4];
#pragma unroll
    for (int j = 0; j < 4; ++j) { if (HAS_M) gp[j] = *(const f32x4*)(gpost + 4 * lane + 256 * j); if (HAS_HN) gq[j] = *(const f32x4*)(gpre + 4 * lane + 256 * j); }
    for (int r = gw; r < T; r += NGW) {
        f32x4 v[4];
#pragma unroll
        for (int j = 0; j < 4; ++j) v[j] = *(const f32x4*)(xin + (size_t)r * DM + 4 * lane + 256 * j);
        if (HAS_M) { f32x4 mv[4]; float ss = 0.f;
#pragma unroll
            for (int j = 0; j < 4; ++j) { const uint2 w = *(const uint2*)(m + (size_t)r * DM + 4 * lane + 256 * j);
                mv[j] = (f32x4){__uint_as_float(w.x << 16), __uint_as_float(w.x & 0xffff0000u), __uint_as_float(w.y << 16), __uint_as_float(w.y & 0xffff0000u)};
                ss += (mv[j].x * mv[j].x + mv[j].y * mv[j].y) + (mv[j].z * mv[j].z + mv[j].w * mv[j].w); }
            const float r1 = 1.f / sqrtf(wave_sum(ss) * (1.f / DM) + 1e-6f);
#pragma unroll
            for (int j = 0; j < 4; ++j) { v[j] = v[j] + mv[j] * r1 * gp[j]; *(f32x4*)(xout + (size_t)r * DM + 4 * lane + 256 * j) = v[j]; } }
        if (HAS_HN) { float ss = 0.f;
#pragma unroll
            for (int j = 0; j < 4; ++j) ss += (v[j].x * v[j].x + v[j].y * v[j].y) + (v[j].z * v[j].z + v[j].w * v[j].w);
            const float r2 = 1.f / sqrtf(wave_sum(ss) * (1.f / DM) + 1e-6f);
#pragma unroll
            for (int j = 0; j < 4; ++j) { v[j] = v[j] * r2 * gq[j]; uint2 w; w.x = pk2(v[j].x, v[j].y); w.y = pk2(v[j].z, v[j].w); *(uint2*)(hn + (size_t)r * DM + 4 * lane + 256 * j) = w; }
            if (HAS_LOGF) { float myz = 0.f;
#pragma unroll
                for (int h = 0; h < 8; ++h) { float d = 0.f;
#pragma unroll
                    for (int j = 0; j < 4; ++j) { const f32x4 w = *(const LAS f32x4*)(wfl + h * DM + 4 * lane + 256 * j); d += (v[j].x * w.x + v[j].y * w.y) + (v[j].z * w.z + v[j].w * w.w); }
                    d = wave_sum(d); if (lane == h) myz = d; }
                if (lane < 8) { const float z = myz + bfg[lane]; logf_out[(size_t)r * 8 + lane] = fminf(z, 0.f) - log1pf(expf(-fabsf(z))); } } }
    }
}
struct AttSchedFox {
    int vcu;
    __device__ __forceinline__ bool get(int i, att::AItem& r) const { if (i >= 4) return false; const int p = vcu + 256 * (i >> 1), x = p & 7; r.bh = p >> 3; r.qb = (i & 1) ? x : 15 - x; return true; }
};
struct AttSchedMoba {
    int vcu;
    __device__ __forceinline__ bool get(int i, att::AItem& r) const { if (i >= 2) return false; const int x = vcu & 7; r.bh = vcu >> 3; r.qb = (i & 1) ? x : 15 - x; return true; }
};

struct Args { const float* in[14]; float* out; unsigned char* ws; int ph_lo, ph_hi; };
constexpr int NPHASE = 17;
__global__ void __launch_bounds__(NWAVES * 64, 2) mega_fwd(Args args) {
    extern __shared__ __attribute__((aligned(16))) unsigned char lds[];
    LAS unsigned char* ldsA = (LAS unsigned char*)lds;
    volatile LAS unsigned* MISC = (volatile LAS unsigned*)(ldsA + MISC_OFF);
    const int tid = threadIdx.x, lane = tid & 63, wave = __builtin_amdgcn_readfirstlane(tid >> 6);
    const int G = gridDim.x, bx = blockIdx.x, vcu = (G % 8 == 0) ? (bx % 8) * (G / 8) + bx / 8 : bx;
    const int gw = vcu * NWAVES + wave, NGW = G * NWAVES;
    typedef const __attribute__((address_space(4))) Args* CArgsP;
    const CArgsP ap0 = (CArgsP)__builtin_amdgcn_kernarg_segment_ptr();
#define ARGP() ({ unsigned lo_ = (unsigned)(uintptr_t)ap0, hi_ = (unsigned)((uintptr_t)ap0 >> 32); asm volatile("" : "+s"(lo_), "+s"(hi_)); \
    (CArgsP)(((uintptr_t)(unsigned)__builtin_amdgcn_readfirstlane(hi_) << 32) | (unsigned)__builtin_amdgcn_readfirstlane(lo_)); })
#define a_ws ((unsigned char*)(GAS unsigned char*)(ARGP()->ws))
    unsigned* ctl = (unsigned*)(a_ws + WS_CTL);
    for (int u = tid; u < (LDS_BYTES - RING_BYTES) / 4; u += NWAVES * 64) ((LAS unsigned*)(ldsA + RING_BYTES))[u] = 0u;
    __syncthreads();
    XcdBarrier bar = xcd_barrier_post(ctl + CW_BAR, MISC + 8);
    cg::grid_group grid = cg::this_grid();
    const int lo = ap0->ph_lo, hi = ap0->ph_hi;
#ifndef PHMASK
#define PHMASK 0x1ffff
#endif
#define IN(k) (((PHMASK >> (k)) & 1) && lo <= (k) && (k) < hi)
#define SEAM(k) do { if (IN(k) && IN((k) + 1)) { if ((k) == 0) grid.sync(); else xcd_barrier(bar); } } while (0)
#define a_x      ((const float*)(const GAS float*)(ARGP()->in[0]))
#define a_relb   ((const float*)(const GAS float*)(ARGP()->in[1]))
#define a_nmpre  ((const float*)(const GAS float*)(ARGP()->in[2]))
#define a_nmpost ((const float*)(const GAS float*)(ARGP()->in[3]))
#define a_nfpre  ((const float*)(const GAS float*)(ARGP()->in[4]))
#define a_nfpost ((const float*)(const GAS float*)(ARGP()->in[5]))
#define a_ewin   ((const float*)(const GAS float*)(ARGP()->in[6]))
#define a_egn    ((const float*)(const GAS float*)(ARGP()->in[7]))
#define a_ewout  ((const float*)(const GAS float*)(ARGP()->in[8]))
#define a_owin   ((const float*)(const GAS float*)(ARGP()->in[9]))
#define a_obf    ((const float*)(const GAS float*)(ARGP()->in[10]))
#define a_owout  ((const float*)(const GAS float*)(ARGP()->in[11]))
#define a_fwin   ((const float*)(const GAS float*)(ARGP()->in[12]))
#define a_fwout  ((const float*)(const GAS float*)(ARGP()->in[13]))
#define a_out    ((float*)(GAS float*)(ARGP()->out))
#define COS   ((float*)(a_ws + WS_COS))
#define SIN   ((float*)(a_ws + WS_SIN))
#define WFL   ((float*)(a_ws + WS_WFL))
#define KMEAN ((float*)(a_ws + WS_KMEAN))
#define SEL   ((unsigned*)(a_ws + WS_SEL))
#define LOGF  ((float*)(a_ws + WS_LOGF))
#define FCUM  ((float*)(a_ws + WS_FCUM))
#define WP0   ((bf16r*)(a_ws + WS_WP0))
#define WO0   ((bf16r*)(a_ws + WS_WO0))
#define WFI0  ((bf16r*)(a_ws + WS_WFI0))
#define WFO0  ((bf16r*)(a_ws + WS_WFO0))
#define WP1   ((bf16r*)(a_ws + WS_WP1))
#define WO1   ((bf16r*)(a_ws + WS_WO1))
#define WFI1  ((bf16r*)(a_ws + WS_WFI1))
#define WFO1  ((bf16r*)(a_ws + WS_WFO1))
#define HN    ((bf16r*)(a_ws + WS_A))
#define KVT   ((float*)(a_ws + WS_A))
#define PB    ((bf16r*)(a_ws + WS_B))
    constexpr size_t A32 = (size_t)T * 512;
#define RQ (PB)
#define RK (PB + A32)
#define RV (PB + 2 * A32)
#define RG (PB + 3 * A32)
#define MQ (PB + 4 * A32)
#define MK (PB + 5 * A32)
#define MV (PB + 6 * A32)
#define HB (PB)
#define FQ (PB)
#define FK (PB + 2 * A32)
#define FV (PB + 4 * A32)
#define CAT ((bf16r*)(a_ws + WS_C))
#define MB  ((bf16r*)(a_ws + WS_D))
#define STB ((bf16r*)(a_ws + WS_D))
    if (IN(0)) {
        LAS float* scr = (LAS float*)(ldsA + wave * 16384);
        constexpr int I_P0 = 16 * 112, I_O = 16 * 32, I_FI = 16 * 176, I_FO = 44 * 32, I_P1 = 16 * 96;
        constexpr int NITEMS = I_P0 + 2 * I_O + 2 * I_FI + 2 * I_FO + I_P1;
        for (int it = gw; it < NITEMS; it += NGW) { int r = it;
            if (r < I_P0) { transpose_item<1>(a_ewin, DM, 3584, 3584, WP0, scr, r, lane); continue; } r -= I_P0;
            if (r < I_O) { transpose_item<0>(a_ewout, DM, DM, DM, WO0, scr, r, lane); continue; } r -= I_O;
            if (r < I_FI) { transpose_item<2>(a_fwin, DM, 2 * FFH, 2 * FFH, WFI0, scr, r, lane); continue; } r -= I_FI;
            if (r < I_FO) { transpose_item<0>(a_fwout, FFH, DM, DM, WFO0, scr, r, lane); continue; } r -= I_FO;
            if (r < I_P1) { transpose_item<0>(a_owin, DM, 3072, 3080, WP1, scr, r, lane); continue; } r -= I_P1;
            if (r < I_O) { transpose_item<0>(a_owout, DM, DM, DM, WO1, scr, r, lane); continue; } r -= I_O;
            if (r < I_FI) { transpose_item<2>(a_fwin + (size_t)DM * 2 * FFH, DM, 2 * FFH, 2 * FFH, WFI1, scr, r, lane); continue; } r -= I_FI;
            transpose_item<0>(a_fwout + (size_t)FFH * DM, FFH, DM, DM, WFO1, scr, r, lane);
        }
        for (int i = bx * 512 + tid; i < SEQ * 64; i += G * 512) { const int j = i & 63, t = i >> 6;
            const float inv = powf(10000.f, -(float)(2 * j) / 128.f), ang = (float)t * inv;
            const double a = (double)ang, k = rint(a * 0.15915494309189535); const float rr = (float)(a - k * 6.283185307179586);
            COS[i] = cosf(rr); SIN[i] = sinf(rr); }
        for (int i = bx * 512 + tid; i < 8 * DM; i += G * 512) { const int h = i >> 10, k = i & 1023; WFL[i] = a_owin[(size_t)k * 3080 + 3072 + h]; }
        row_pass<false, true, false>(gw, NGW, lane, a_x, nullptr, nullptr, a_nmpre, nullptr, HN, nullptr, nullptr, nullptr);
    }
    SEAM(0);
    if (IN(1)) {
        pg8::Gemm g{HN, WP0, T, 3584, DM}; pg8::StaticOrder S; S.init(T, 3584, G, bx);
        pg8::EpiHeads<4, true, 3> E{PB, A32, COS, SIN, 0.08838834764831845f};
        pg8::gemm_phase<pg8::EpiHeads<4, true, 3>, pg8::StaticOrder, true, true>(ldsA, g, S, E);
    }
    SEAM(1);
    if (IN(2)) {
        for (int c = vcu; c < 1024; c += G) { const int bh = c >> 5;
            ret::kv_task((char*)lds, (const att::bf16*)(RK + (size_t)c * 128 * 128), (const att::bf16*)(RV + (size_t)c * 128 * 128), KVT + (size_t)c * 16384, bh & 3); }
        LAS float* red = (LAS float*)(ldsA + SCR_OFF);
        for (int u = vcu; u < 512; u += G) {
            const int d = tid & 127, part = tid >> 7; const bf16r* kp = MK + ((size_t)u * 256 + part * 64) * 128 + d; float s = 0.f;
            for (int i = 0; i < 64; ++i) s += __uint_as_float((unsigned)kp[(size_t)i * 128] << 16);
            red[tid] = s; __syncthreads();
            if (tid < 128) KMEAN[(size_t)u * 128 + tid] = ((red[tid] + red[tid + 128]) + (red[tid + 256] + red[tid + 384])) * (1.f / 256.f);
            __syncthreads(); }
    }
    SEAM(2);
    if (IN(3)) {
        for (int gid = bx * 512 + tid; gid < 32 * 4096; gid += G * 512) { const int bh = gid >> 12, e4 = gid & 4095;
            const float cd = __builtin_amdgcn_exp2f(ret::l2g_of(bh & 3) * 128.f); f32x4 s = {0.f, 0.f, 0.f, 0.f};
            const f32x4* kv = (const f32x4*)KVT + (size_t)bh * 32 * 4096 + e4; uint2* st = (uint2*)STB + (size_t)bh * 32 * 4096 + e4;
#pragma unroll 8
            for (int i = 0; i < 32; ++i) { const f32x4 k = kv[(size_t)i * 4096]; uint2 w; w.x = pk2(s.x, s.y); w.y = pk2(s.z, s.w); st[(size_t)i * 4096] = w; s = s * cd + k; } }
        for (int gid = bx * 512 + tid; gid < 32 * 4096; gid += G * 512) { const int bh = __builtin_amdgcn_readfirstlane(gid >> 12), s = gid & 4095, own = __builtin_amdgcn_readfirstlane(s >> 8);
            const v4u* qp = (const v4u*)(MQ + ((size_t)bh * SEQ + s) * 128); v4u q[16];
#pragma unroll
            for (int i = 0; i < 16; ++i) q[i] = qp[i];
            float v1 = 0.f, v2 = 0.f, v3 = 0.f; int i1 = -1, i2 = -1, i3 = -1;
            for (int n = 0; n < own; ++n) { const f32x4* km = (const f32x4*)(KMEAN + ((size_t)bh * 16 + n) * 128); float d = 0.f;
#pragma unroll
                for (int i = 0; i < 16; ++i) { const f32x4 a = km[2 * i], b = km[2 * i + 1];
                    d += (ret::bf_lo(q[i].x) * a.x + ret::bf_hi(q[i].x) * a.y) + (ret::bf_lo(q[i].y) * a.z + ret::bf_hi(q[i].y) * a.w)
                       + (ret::bf_lo(q[i].z) * b.x + ret::bf_hi(q[i].z) * b.y) + (ret::bf_lo(q[i].w) * b.z + ret::bf_hi(q[i].w) * b.w); }
                if (i1 < 0 || d > v1) { v3 = v2; i3 = i2; v2 = v1; i2 = i1; v1 = d; i1 = n; }
                else if (i2 < 0 || d > v2) { v3 = v2; i3 = i2; v2 = d; i2 = n; }
                else if (i3 < 0 || d > v3) { v3 = d; i3 = n; } }
            unsigned msk = 0; if (i1 >= 0) msk |= 1u << i1; if (i2 >= 0) msk |= 1u << i2; if (i3 >= 0) msk |= 1u << i3;
            SEL[gid] = msk; }
    }
    SEAM(3);
    if (IN(4)) {
        if (!(PHMASK & 0x100000)) for (int u = vcu; u < 512; u += G) { const int bh = u >> 4, cp = u & 15, b = bh >> 2, h = bh & 3; const size_t hb = ((size_t)bh * SEQ + cp * 256) * 128, tb = (size_t)b * SEQ + cp * 256;
            ret::out_task((char*)lds, (const att::bf16*)(RQ + hb), (const att::bf16*)(RK + hb), (const att::bf16*)(RV + hb), (const att::bf16*)(STB + ((size_t)bh * 32 + cp * 2) * 16384),
                          (const att::bf16*)(RG + tb * 512 + h * 128), a_egn + h * 128, (att::bf16*)(CAT + tb * DM + h * 128), h); }
        { LAS float* lut = (LAS float*)(ldsA + att::OFF_LUT); const float* rb = a_relb;
          for (int i = tid; i < att::LUT_FLOATS; i += 512) { const int h = i >> 9, rel = (i & 511) - 256; lut[i] = (i >= 2048) ? -__builtin_inff() : rb[t5_bucket(rel) * 4 + h] * att::INV_SCALE; }
          __syncthreads(); }
        if (!(PHMASK & 0x200000)) { AttSchedMoba sch{vcu}; const att::ABase AB{(const att::bf16*)MQ, (const att::bf16*)MK, (const att::bf16*)MV, (att::bf16*)CAT, nullptr, SEL, 4, 512};
        att::attn_phase<1, AttSchedMoba>((char*)lds, AB, sch); }
    }
    SEAM(4);
    if (IN(5)) { pg8::Gemm g{CAT, WO0, T, DM, DM}; pg8::StaticOrder S; S.init(T, DM, G, bx); pg8::EpiPlain E{MB, DM};
        pg8::gemm_phase<pg8::EpiPlain, pg8::StaticOrder, true, true>(ldsA, g, S, E); }
    SEAM(5);
    if (IN(6)) row_pass<true, true, false>(gw, NGW, lane, a_x, MB, a_nmpost, a_nfpre, a_out, HN, nullptr, nullptr, nullptr);
    SEAM(6);
    if (IN(7)) { pg8::Gemm g{HN, WFI0, T, 2 * FFH, DM}; pg8::StaticOrder S; S.init(T, 2 * FFH, G, bx); pg8::EpiSwiglu E{HB, FFH};
        pg8::gemm_phase<pg8::EpiSwiglu, pg8::StaticOrder, true, true>(ldsA, g, S, E); }
    SEAM(7);
    if (IN(8)) { pg8::Gemm g{HB, WFO0, T, DM, FFH}; pg8::StaticOrder S; S.init(T, DM, G, bx); pg8::EpiPlain E{MB, DM};
        pg8::gemm_phase<pg8::EpiPlain, pg8::StaticOrder, true, true>(ldsA, g, S, E); }
    SEAM(8);
    if (IN(9)) {
        LAS float* wfl = (LAS float*)ldsA;
        for (int i = tid; i < 8 * DM; i += 512) wfl[i] = WFL[i];
        __syncthreads();
        row_pass<true, true, true>(gw, NGW, lane, a_out, MB, a_nfpost, a_nmpre + DM, a_out, HN, wfl, a_obf, LOGF);
        __syncthreads();
    }
    SEAM(9);
    if (IN(10)) {
        for (int bh = vcu; bh < 64; bh += G) { LAS float* sc = (LAS float*)(ldsA + SCR_OFF); const int b = bh >> 3, h = bh & 7; float v[8], run = 0.f;
#pragma unroll
            for (int i = 0; i < 8; ++i) { run += LOGF[((size_t)b * SEQ + tid * 8 + i) * 8 + h]; v[i] = run; }
            sc[tid] = run; __syncthreads();
            for (int o = 1; o < 512; o <<= 1) { const float a = (tid >= o) ? sc[tid - o] : 0.f; __syncthreads(); sc[tid] += a; __syncthreads(); }
            const float base = (tid > 0) ? sc[tid - 1] : 0.f;
#pragma unroll
            for (int i = 0; i < 8; ++i) FCUM[(size_t)bh * SEQ + tid * 8 + i] = -(base + v[i]) * att::INV_SCALE;
            __syncthreads(); }
        pg8::Gemm g{HN, WP1, T, 3072, DM}; pg8::StaticOrder S; S.init(T, 3072, G, bx);
        pg8::EpiHeads<8, false, -1> E{PB, 2 * A32, nullptr, nullptr, 1.f};
        pg8::gemm_phase<pg8::EpiHeads<8, false, -1>, pg8::StaticOrder, true, true>(ldsA, g, S, E);
    }
    SEAM(10);
    if (IN(11)) { AttSchedFox sch{vcu}; const att::ABase AB{(const att::bf16*)FQ, (const att::bf16*)FK, (const att::bf16*)FV, (att::bf16*)CAT, FCUM, nullptr, 8, 0};
        att::attn_phase<0, AttSchedFox>((char*)lds, AB, sch); }
    SEAM(11);
    if (IN(12)) { pg8::Gemm g{CAT, WO1, T, DM, DM}; pg8::StaticOrder S; S.init(T, DM, G, bx); pg8::EpiPlain E{MB, DM};
        pg8::gemm_phase<pg8::EpiPlain, pg8::StaticOrder, true, true>(ldsA, g, S, E); }
    SEAM(12);
    if (IN(13)) row_pass<true, true, false>(gw, NGW, lane, a_out, MB, a_nmpost + DM, a_nfpre + DM, a_out, HN, nullptr, nullptr, nullptr);
    SEAM(13);
    if (IN(14)) { pg8::Gemm g{HN, WFI1, T, 2 * FFH, DM}; pg8::StaticOrder S; S.init(T, 2 * FFH, G, bx); pg8::EpiSwiglu E{HB, FFH};
        pg8::gemm_phase<pg8::EpiSwiglu, pg8::StaticOrder, true, true>(ldsA, g, S, E); }
    SEAM(14);
    if (IN(15)) { pg8::Gemm g{HB, WFO1, T, DM, FFH}; pg8::StaticOrder S; S.init(T, DM, G, bx); pg8::EpiPlain E{MB, DM};
        pg8::gemm_phase<pg8::EpiPlain, pg8::StaticOrder, true, true>(ldsA, g, S, E); }
    SEAM(15);
    if (IN(16)) row_pass<true, false, false>(gw, NGW, lane, a_out, MB, a_nfpost + DM, nullptr, a_out, nullptr, nullptr, nullptr, nullptr);
#undef IN
#undef SEAM
}

#ifndef N_LAUNCH_SPLIT
#define N_LAUNCH_SPLIT 0
#endif
extern "C" void kernel_launch(void* const* d_in, const int* in_sizes, int n_in, void* d_out, int out_size, void* d_ws, size_t ws_size, hipStream_t stream) {
    static int grid = 0;
    if (grid == 0) {
        if (n_in != 14 || in_sizes[0] != T * DM || out_size != T * DM || ws_size < WS_END) { fprintf(stderr, "kernel_launch: unexpected shapes (n_in %d in0 %d out %d ws %zu)\n", n_in, n_in > 0 ? in_sizes[0] : -1, out_size, ws_size); grid = -1; return; }
        int dev = 0, cus = 0, per_cu = 0;
        if (hipGetDevice(&dev) != hipSuccess || hipDeviceGetAttribute(&cus, hipDeviceAttributeMultiprocessorCount, dev) != hipSuccess) { grid = -1; return; }
        if (hipFuncSetAttribute((const void*)mega_fwd, hipFuncAttributeMaxDynamicSharedMemorySize, LDS_BYTES) != hipSuccess) { fprintf(stderr, "kernel_launch: hipFuncSetAttribute failed\n"); grid = -1; return; }
        if (hipOccupancyMaxActiveBlocksPerMultiprocessor(&per_cu, (const void*)mega_fwd, NWAVES * 64, LDS_BYTES) != hipSuccess || per_cu < 1) { fprintf(stderr, "kernel_launch: occupancy query says %d\n", per_cu); (void)hipGetLastError(); grid = -1; return; }
        grid = cus;
        if (grid != 256) fprintf(stderr, "kernel_launch: note: %d CUs (tuned for 256)\n", grid);
    }
    if (grid < 0) return;
    if (hipMemsetAsync((char*)d_ws + WS_CTL, 0, CTL_ZERO_BYTES, stream) != hipSuccess) return;
    Args a{};
    for (int i = 0; i < 14; ++i) a.in[i] = (const float*)d_in[i];
    a.out = (float*)d_out; a.ws = (unsigned char*)d_ws;
#if N_LAUNCH_SPLIT
    for (int p = 0; p < NPHASE; ++p) { a.ph_lo = p; a.ph_hi = p + 1; hipLaunchKernelGGL(mega_fwd, dim3(grid), dim3(NWAVES * 64), LDS_BYTES, stream, a); }
#else
    a.ph_lo = 0; a.ph_hi = NPHASE;
    void* kargs[] = {&a};
    hipError_t e = hipLaunchCooperativeKernel((const void*)mega_fwd, dim3(grid), dim3(NWAVES * 64), kargs, LDS_BYTES, stream);
    if (e != hipSuccess) fprintf(stderr, "kernel_launch: cooperative launch failed: %s (grid %d)\n", hipGetErrorString(e), grid);
#endif
}
```

```cpp
#include <hip/hip_runtime.h>
#include <hip/hip_bf16.h>
#include <hip/hip_cooperative_groups.h>
#include <cstdio>
#include <cstdint>
namespace cg = cooperative_groups;
#define LAS __attribute__((address_space(3)))
#define GAS __attribute__((address_space(1)))
__device__ __forceinline__ int ph_tid() { int t = (int)threadIdx.x; asm volatile("" : "+v"(t)); return t; }
#define XB_TMO      128
#define XB_XCNT(j)  (256  + 64 * (j))
#define XB_XSUB(j)  (1280 + 64 * (j))
#define XB_XGEN(j)  (2304 + 64 * (j))
#define XB_TOP      3328
#define XB_TOPGEN   3392
#define XCD_BAR_WORDS 3456
#define XB_SPIN_CAP (1u << 18)
__device__ __forceinline__ unsigned xb_ld(unsigned* p)              { return __hip_atomic_load(p, __ATOMIC_RELAXED, __HIP_MEMORY_SCOPE_AGENT); }
__device__ __forceinline__ unsigned xb_add(unsigned* p, unsigned v) { return __hip_atomic_fetch_add(p, v, __ATOMIC_RELAXED, __HIP_MEMORY_SCOPE_AGENT); }
__device__ __forceinline__ unsigned xb_xcc_id() { return (unsigned)__builtin_amdgcn_s_getreg((3 << 11) | 20) & 0xFu; }
#define XB_SPIN(cond, bar) do { unsigned _sp = 0; while (cond) { __builtin_amdgcn_s_sleep(1); \
    if ((++_sp & 255u) == 0u) { if (xb_ld(&(bar)[XB_TMO])) break; if (_sp > XB_SPIN_CAP) { atomicAdd(&(bar)[XB_TMO], 1u); break; } } } } while (0)
struct XcdBarrier { unsigned* bar; unsigned x; volatile LAS unsigned* st; };
__device__ __forceinline__ XcdBarrier xcd_barrier_post(unsigned* bar, volatile LAS unsigned* st) {
    XcdBarrier b; b.bar = bar; b.x = xb_xcc_id(); b.st = st;
    if (threadIdx.x == 0) (void)xb_add(&bar[XB_XCNT(b.x)], 1u);
    return b;
}
__device__ __forceinline__ void xcd_barrier_complete(unsigned* bar, unsigned x, unsigned& nloc, unsigned& nx) {
    const unsigned G = gridDim.x * gridDim.y * gridDim.z;
    unsigned sum, cnt, mine, sp = 0u;
    for (;;) {
        sum = 0u; cnt = 0u; mine = 0u;
#pragma unroll
        for (unsigned j = 0; j < 16; ++j) { const unsigned c = xb_ld(&bar[XB_XCNT(j)]); sum += c; cnt += (c > 0u) ? 1u : 0u; mine = (j == x) ? c : mine; }
        if (sum == G) break;
        __builtin_amdgcn_s_sleep(1);
        if ((++sp & 255u) == 0u) { if (xb_ld(&bar[XB_TMO])) break; if (sp > XB_SPIN_CAP) { atomicAdd(&bar[XB_TMO], 1u); break; } }
    }
    nloc = mine > 0u ? mine : 1u; nx = cnt > 0u ? cnt : 1u;
}
__device__ __forceinline__ void xcd_barrier(const XcdBarrier& b) {
    asm volatile("s_waitcnt vmcnt(0)" ::: "memory");
    __syncthreads();
    if (threadIdx.x == 0) {
        unsigned* bar = b.bar;
        __builtin_amdgcn_s_waitcnt(0);
        unsigned nloc = b.st[0], nx = b.st[1];
        if (nloc == 0u) { xcd_barrier_complete(bar, b.x, nloc, nx); b.st[0] = nloc; b.st[1] = nx; }
        const unsigned old = xb_add(&bar[XB_XSUB(b.x)], 1u);
        const unsigned gen = old / nloc;
        if (old + 1u == (gen + 1u) * nloc) {
            __builtin_amdgcn_fence(__ATOMIC_RELEASE, "agent");
            asm volatile("s_waitcnt vmcnt(0)" ::: "memory");
            const unsigned og = xb_add(&bar[XB_TOP], 1u);
            const unsigned tg = og / nx;
            if (og + 1u == (tg + 1u) * nx) xb_add(&bar[XB_TOPGEN], 1u);
            else XB_SPIN(xb_ld(&bar[XB_TOPGEN]) == tg, bar);
            __builtin_amdgcn_fence(__ATOMIC_ACQUIRE, "agent");
            xb_add(&bar[XB_XGEN(b.x)], 1u);
            asm volatile("s_waitcnt vmcnt(0)" ::: "memory");
        } else {
            XB_SPIN(xb_ld(&bar[XB_XGEN(b.x)]) == gen, bar);
            __builtin_amdgcn_fence(__ATOMIC_ACQUIRE, "agent");
            asm volatile("s_waitcnt vmcnt(0)" ::: "memory");
        }
    }
    __syncthreads();
}
#ifndef EPI_NOSTORE
#define EPI_NOSTORE 0
#endif
#ifndef PG8_WGM
#define PG8_WGM 8
#endif
namespace pg8 {
#define PG8_LAS __attribute__((address_space(3)))
typedef unsigned short bf16_t;
typedef short bf16x8 __attribute__((ext_vector_type(8)));
typedef float f32x4 __attribute__((ext_vector_type(4)));
typedef unsigned u32x4 __attribute__((ext_vector_type(4)));
constexpr int BM = 256, BK = 64, HALF = 128, HTB = HALF * BK * 2  , STAGE_BYTES = 8 * HTB, NXCD = 8, WGM = PG8_WGM;

__host__ __device__ __forceinline__ int lds_byte(int r, int c) { const int st = (r >> 4) * 2 + (c >> 5), rr = r & 15, cc = c & 31, ob = rr * 64 + cc * 2; return st * 1024 + (ob ^ (((ob >> 9) & 1) << 5)); }
__host__ __device__ __forceinline__ void stage_rc(int b, int& R, int& C) { const int st = b / 1024, sb = b % 1024, swz = sb ^ (((sb >> 9) & 1) << 5); R = (st >> 1) * 16 + swz / 64; C = (st & 1) * 32 + (swz % 64) / 2; }
__host__ __device__ __forceinline__ int perm32(int rho) { const int n = rho >> 4, i = rho & 15; return 8 * (i >> 2) + 4 * n + (i & 3); }

struct Unit { int pm, pn; };
struct Gemm { const bf16_t* A; const bf16_t* Bt; int M, N, K; };

struct StaticOrder {
    int nM, nN, nwg, G, c;
    __host__ __device__ __forceinline__ void init(int M, int N, int G_, int c_) { nM = M / BM; nN = N / BM; nwg = nM * nN; G = G_; c = c_; }
    __host__ __device__ __forceinline__ bool next(int i, Unit& u) const {
        const long L = (long)i * G + c; if (L >= nwg) return false;
        int wgid = (int)L; { const int q = nwg / NXCD, r = nwg % NXCD, xcd = wgid % NXCD, off = wgid / NXCD; wgid = (xcd < r ? xcd * (q + 1) : r * (q + 1) + (xcd - r) * q) + off; }
        const int nig = WGM * nN, gid = wgid / nig, fm = gid * WGM, gsz = (nM - fm) < WGM ? (nM - fm) : WGM;
        u.pm = fm + ((wgid % nig) % gsz); u.pn = (wgid % nig) / gsz; return true;
    }
    __device__ __forceinline__ void a_ready(const Unit&) const {}
    __device__ __forceinline__ void done(const Unit&) const {}
};

__device__ __forceinline__ unsigned cvt_pk_bf16(float lo, float hi) { unsigned r; asm volatile("v_cvt_pk_bf16_f32 %0, %1, %2" : "=v"(r) : "v"(lo), "v"(hi)); return r; }
typedef float f32x2 __attribute__((ext_vector_type(2)));
__device__ __forceinline__ unsigned cvt_pk_bf16_c(float lo, float hi) { typedef __bf16 b2_ __attribute__((ext_vector_type(2))); const f32x2 v_ = {lo, hi}; return __builtin_bit_cast(unsigned, __builtin_convertvector(v_, b2_)); }
#ifndef EPI_WT
#define EPI_WT 0
#endif
__device__ __forceinline__ void st16(void* p, u32x4 v) {
    if (EPI_WT == 1) asm volatile("global_store_dwordx4 %0, %1, off sc1\n\ts_nop 1" :: "v"(p), "v"(v) : "memory");
    else if (EPI_WT == 2) __builtin_nontemporal_store(v, (u32x4*)p);
    else *(u32x4*)p = v;
}
struct EpiPlain {
    static constexpr bool PERM = true, AFTER_DRAIN = false;
    bf16_t* O; int ldc;
    __device__ __forceinline__ void operator()(const f32x4 (&acc)[2][2][4][2], const Unit& u, int wr, int wc, int fr, int fq, int ui) const {
        const int row0 = u.pm * BM + wr * 64 + fr, col0 = u.pn * BM + wc * 32 + 8 * fq;
#pragma unroll
        for (int ai = 0; ai < 2; ++ai)
#pragma unroll
            for (int m = 0; m < 4; ++m) { bf16_t* rowp = O + (size_t)(row0 + ai * HALF + m * 16) * ldc + col0;
#pragma unroll
                for (int bj = 0; bj < 2; ++bj) { const f32x4 v0 = acc[ai][bj][m][0], v1 = acc[ai][bj][m][1];
                    u32x4 w; w.x = cvt_pk_bf16_c(v0[0], v0[1]); w.y = cvt_pk_bf16_c(v0[2], v0[3]); w.z = cvt_pk_bf16_c(v1[0], v1[1]); w.w = cvt_pk_bf16_c(v1[2], v1[3]);
                    if (!EPI_NOSTORE || w.x == 0x12345678u) st16(rowp + bj * HALF, w); } }
    }
};
struct EpiSwiglu {
    static constexpr bool PERM = true, AFTER_DRAIN = false;
    bf16_t* H; int ldh; const float* rs;
    __device__ __forceinline__ void operator()(const f32x4 (&acc)[2][2][4][2], const Unit& u, int wr, int wc, int fr, int fq, int ui) const {
        const int row0 = u.pm * BM + wr * 64 + fr, col0 = u.pn * HALF + wc * 32 + 8 * fq;
        float rsv[2][4];
#pragma unroll
        for (int ai = 0; ai < 2; ++ai)
#pragma unroll
            for (int m = 0; m < 4; ++m) rsv[ai][m] = rs[row0 + ai * HALF + m * 16];
#pragma unroll
        for (int ai = 0; ai < 2; ++ai)
#pragma unroll
            for (int m = 0; m < 4; ++m) { bf16_t* rowp = H + (size_t)(row0 + ai * HALF + m * 16) * ldh + col0; float o[8]; const float rsc = rsv[ai][m];
#pragma unroll
                for (int n = 0; n < 2; ++n) {
                    const f32x4 g = acc[ai][0][m][n] * rsc, uu = acc[ai][1][m][n] * rsc, t = g * -1.4426950408889634f;
                    f32x4 e; e[0] = __builtin_amdgcn_exp2f(t[0]); e[1] = __builtin_amdgcn_exp2f(t[1]); e[2] = __builtin_amdgcn_exp2f(t[2]); e[3] = __builtin_amdgcn_exp2f(t[3]);
                    const f32x4 d = e + 1.0f; f32x4 r; r[0] = __builtin_amdgcn_rcpf(d[0]); r[1] = __builtin_amdgcn_rcpf(d[1]); r[2] = __builtin_amdgcn_rcpf(d[2]); r[3] = __builtin_amdgcn_rcpf(d[3]);
                    const f32x4 y = (g * r) * uu; o[n * 4] = y[0]; o[n * 4 + 1] = y[1]; o[n * 4 + 2] = y[2]; o[n * 4 + 3] = y[3]; }
                u32x4 w; w.x = cvt_pk_bf16_c(o[0], o[1]); w.y = cvt_pk_bf16_c(o[2], o[3]); w.z = cvt_pk_bf16_c(o[4], o[5]); w.w = cvt_pk_bf16_c(o[6], o[7]);
                if (!EPI_NOSTORE || w.x == 0x12345678u) st16(rowp, w); }
    }
};
template <int NH, bool ROT, int TOKA, bool KMAX = false> struct EpiHeads {
    static constexpr bool PERM = true, AFTER_DRAIN = false;
    static constexpr int TPA = NH / 2;
    bf16_t* base; size_t astride; const float* cs; const float* sn; float qscale; const float* rs;
    unsigned* km;
    __device__ __forceinline__ void operator()(const f32x4 (&acc)[2][2][4][2], const Unit& u, int wr, int wc, int fr, int fq, int ui) const {
        const int a = u.pn / TPA, hp = u.pn % TPA, b = u.pm >> 4, s0 = (u.pm & 15) * BM + wr * 64 + fr, d0 = wc * 32 + 8 * fq;
        bf16_t* ab = base + (size_t)a * astride;
        const bool rot = ROT && a < 2; const float sc = (ROT && a == 0) ? qscale : 1.f;
        float kmx[2] = {0.f, 0.f};
        float rsv[2][4];
#pragma unroll
        for (int ai = 0; ai < 2; ++ai)
#pragma unroll
            for (int m = 0; m < 4; ++m) rsv[ai][m] = rs[b * 4096 + s0 + ai * HALF + m * 16];
        float rfreq[4];
#pragma unroll
        for (int i = 0; i < 4; ++i) rfreq[i] = __builtin_amdgcn_exp2f(-(float)(2 * (4 * (4 * wc + fq) + i)) * (13.287712379549449f / 128.f)) * 0.15915494309189535f;
#pragma unroll
        for (int ai = 0; ai < 2; ++ai)
#pragma unroll
            for (int m = 0; m < 4; ++m) { const int s = s0 + ai * HALF + m * 16; const float rsc = rsv[ai][m];
                f32x4 c4 = {1.f, 1.f, 1.f, 1.f}, s4 = {0.f, 0.f, 0.f, 0.f};
                if (rot) {
#pragma unroll
                    for (int i = 0; i < 4; ++i) { const float fr_ = __builtin_amdgcn_fractf((float)s * rfreq[i]); c4[i] = __builtin_amdgcn_cosf(fr_); s4[i] = __builtin_amdgcn_sinf(fr_); } }
#pragma unroll
                for (int bj = 0; bj < 2; ++bj) { f32x4 v0 = acc[ai][bj][m][0] * rsc, v1 = acc[ai][bj][m][1] * rsc;
                    if (rot) { const f32x4 o1 = (v0 * c4 - v1 * s4) * sc, o2 = (v0 * s4 + v1 * c4) * sc; v0 = o1; v1 = o2; }
                    u32x4 w; w.x = cvt_pk_bf16_c(v0[0], v0[1]); w.y = cvt_pk_bf16_c(v0[2], v0[3]); w.z = cvt_pk_bf16_c(v1[0], v1[1]); w.w = cvt_pk_bf16_c(v1[2], v1[3]);
                    if (KMAX && a == 1) { float ss = (v0[0] * v0[0] + v0[1] * v0[1]) + (v0[2] * v0[2] + v0[3] * v0[3]) + (v1[0] * v1[0] + v1[1] * v1[1]) + (v1[2] * v1[2] + v1[3] * v1[3]);
                        ss += __shfl_xor(ss, 16); ss += __shfl_xor(ss, 32); kmx[bj] = fmaxf(kmx[bj], ss); }
                    const int head = 2 * hp + bj;
                    bf16_t* dst = (a == TOKA) ? ab + (size_t)(b * 4096 + s) * (NH * 128) + head * 128 + d0
                                              : ab + ((size_t)(b * NH + head) * 4096 + s) * 128 + d0;
                    st16(dst, w); } }
        if (KMAX && a == 1) {
#pragma unroll
            for (int bj = 0; bj < 2; ++bj) { float x = kmx[bj]; x = fmaxf(x, __shfl_xor(x, 1)); x = fmaxf(x, __shfl_xor(x, 2)); x = fmaxf(x, __shfl_xor(x, 4)); x = fmaxf(x, __shfl_xor(x, 8));
                if (fr == 0 && fq == 0) atomicMax(km + ((b * NH + 2 * hp + bj) * 4 + wc), __float_as_uint(x)); } }
    }
};
template <class Epi, class Sched, bool ALIGN_EPI = false, bool SP2 = false>
__device__ __forceinline__ void gemm_phase(PG8_LAS unsigned char* lds, const Gemm g, const Sched& S, const Epi& E) {
    const int tid = ph_tid(), wid = __builtin_amdgcn_readfirstlane(tid >> 6), lane = tid & 63, wr = wid >> 2, wc = wid & 3, fr = lane & 15, fq = lane >> 4;
    const int K = g.K, nt = K / BK;
    unsigned voffA[2], voffB[2];
#pragma unroll
    for (int i = 0; i < 2; ++i) { int R, C; stage_rc(tid * 16 + i * 8192, R, C); const int Rb = Epi::PERM ? ((R & ~31) + perm32(R & 31)) : R;
        voffA[i] = (unsigned)(R * K + C) * 2u; voffB[i] = (unsigned)(Rb * K + C) * 2u; }
    const size_t kstep = (size_t)(BK * 2);
    const size_t hstep = (size_t)HALF * K * 2;
    const size_t tstep = 2 * hstep;
    const unsigned ldsw = (unsigned)wid * 1024u;
    const int aoff = lds_byte(wr * 64 + fr, fq * 8), boff = lds_byte(wc * 32 + fr, fq * 8);
#define PG8_SA(b, h) (((b) * 2 + (h)) * HTB)
#define PG8_SB(b, h) ((4 + (b) * 2 + (h)) * HTB)
#define PG8_STAGE(bufoff, gbase, voff) do { _Pragma("unroll") for (int _i = 0; _i < 2; ++_i) \
        __builtin_amdgcn_global_load_lds((const unsigned*)((const char*)(gbase) + (voff)[_i]), (PG8_LAS unsigned*)(lds + (bufoff) + ldsw + _i * 8192), 16, 0, 0); } while (0)
#define PG8_LDA(dst, b, h) do { _Pragma("unroll") for (int m = 0; m < 4; ++m) _Pragma("unroll") for (int k = 0; k < 2; ++k) dst[m][k] = *(const PG8_LAS bf16x8*)(lds + PG8_SA(b, h) + aoff + m * 2048 + k * 1024); } while (0)
#define PG8_LDB(dst, b, h) do { _Pragma("unroll") for (int n = 0; n < 2; ++n) _Pragma("unroll") for (int k = 0; k < 2; ++k) dst[n][k] = *(const PG8_LAS bf16x8*)(lds + PG8_SB(b, h) + boff + n * 2048 + k * 1024); } while (0)
#define PG8_MMA(ai, bj, At, Bt) do { __builtin_amdgcn_s_setprio(1); _Pragma("unroll") for (int m = 0; m < 4; ++m) _Pragma("unroll") for (int n = 0; n < 2; ++n) _Pragma("unroll") for (int k = 0; k < 2; ++k) \
        acc[ai][bj][m][n] = __builtin_amdgcn_mfma_f32_16x16x32_bf16(Bt[n][k], At[m][k], acc[ai][bj][m][n], 0, 0, 0); __builtin_amdgcn_s_setprio(0); } while (0)
#define PG8_WAIT_V(n) asm volatile("s_waitcnt vmcnt(" #n ")" ::: "memory")
#define PG8_WAIT_L(n) asm volatile("s_waitcnt lgkmcnt(" #n ")" ::: "memory")
#define PG8_BAR __builtin_amdgcn_s_barrier()
#define PG8_SCHED __builtin_amdgcn_sched_barrier(0)
    Unit cur, nxt; int ui = 0;
    if (!S.next(0, cur)) return;
    f32x4 acc[2][2][4][2];
#pragma unroll
    for (int a = 0; a < 2; ++a)
#pragma unroll
        for (int b = 0; b < 2; ++b)
#pragma unroll
            for (int m = 0; m < 4; ++m)
#pragma unroll
                for (int n = 0; n < 2; ++n) acc[a][b][m][n] = (f32x4){0.f, 0.f, 0.f, 0.f};
    bf16x8 At[4][2], B0[2][2], B1[2][2];
    const char* cA = (const char*)g.A + (size_t)cur.pm * tstep; const char* cB = (const char*)g.Bt + (size_t)cur.pn * tstep;
    S.a_ready(cur);
    if constexpr (SP2) {
        PG8_STAGE(PG8_SB(0, 0), cB, voffB); PG8_STAGE(PG8_SB(0, 1), cB + hstep, voffB); PG8_STAGE(PG8_SA(0, 0), cA, voffA); PG8_STAGE(PG8_SA(0, 1), cA + hstep, voffA);
        if (wr == 1) PG8_BAR;
        PG8_WAIT_V(2); PG8_BAR;
        PG8_STAGE(PG8_SB(1, 0), cB + kstep, voffB); PG8_STAGE(PG8_SA(1, 0), cA + kstep, voffA); PG8_STAGE(PG8_SB(1, 1), cB + hstep + kstep, voffB);
        PG8_WAIT_V(6); PG8_BAR;
    } else {
        PG8_STAGE(PG8_SB(0, 0), cB, voffB); PG8_STAGE(PG8_SA(0, 0), cA, voffA); PG8_STAGE(PG8_SB(0, 1), cB + hstep, voffB); PG8_STAGE(PG8_SA(0, 1), cA + hstep, voffA);
        if (wr == 1) PG8_BAR;
        PG8_WAIT_V(4); PG8_BAR;
        PG8_STAGE(PG8_SB(1, 0), cB + kstep, voffB); PG8_STAGE(PG8_SA(1, 0), cA + kstep, voffA); PG8_STAGE(PG8_SB(1, 1), cB + hstep + kstep, voffB);
        PG8_WAIT_V(6); PG8_BAR;
    }
    for (;;) {
        const bool has_next = S.next(ui + 1, nxt);
        const char* nA = has_next ? (const char*)g.A + (size_t)nxt.pm * tstep : cA; const char* nB = has_next ? (const char*)g.Bt + (size_t)nxt.pn * tstep : cB;
        for (int t = 0; t < nt; t += 2) {
            const bool last = (t == nt - 2);
            const char* a1 = cA + (size_t)(t + 1) * kstep;
            const char* a2 = last ? nA : cA + (size_t)(t + 2) * kstep; const char* b2 = last ? nB : cB + (size_t)(t + 2) * kstep;
            const char* a3 = a2 + kstep; const char* b3 = b2 + kstep;
            if (last && has_next) S.a_ready(nxt);
            if constexpr (SP2) {
            PG8_LDB(B0, 0, 0); PG8_LDB(B1, 0, 1); PG8_SCHED; PG8_LDA(At, 0, 0); PG8_STAGE(PG8_SA(1, 1), a1 + hstep, voffA);
            PG8_WAIT_V(8); PG8_WAIT_L(0); PG8_BAR; PG8_MMA(0, 0, At, B0); PG8_MMA(0, 1, At, B1); PG8_BAR; PG8_SCHED;
            PG8_LDA(At, 0, 1); PG8_STAGE(PG8_SB(0, 0), b2, voffB); PG8_STAGE(PG8_SB(0, 1), b2 + hstep, voffB); PG8_STAGE(PG8_SA(0, 0), a2, voffA);
            PG8_WAIT_V(8); PG8_WAIT_L(0); PG8_BAR; PG8_MMA(1, 0, At, B0); PG8_MMA(1, 1, At, B1); PG8_BAR; PG8_SCHED;
            PG8_LDB(B0, 1, 0); PG8_LDB(B1, 1, 1); PG8_SCHED; PG8_LDA(At, 1, 0); PG8_STAGE(PG8_SA(0, 1), a2 + hstep, voffA);
            PG8_WAIT_V(8); PG8_WAIT_L(0); PG8_BAR; PG8_MMA(0, 0, At, B0); PG8_MMA(0, 1, At, B1); PG8_BAR; PG8_SCHED;
            PG8_LDA(At, 1, 1); PG8_STAGE(PG8_SB(1, 0), b3, voffB); PG8_STAGE(PG8_SB(1, 1), b3 + hstep, voffB); PG8_STAGE(PG8_SA(1, 0), a3, voffA);
            PG8_WAIT_V(8); PG8_WAIT_L(0); PG8_BAR; PG8_MMA(1, 0, At, B0); PG8_MMA(1, 1, At, B1); PG8_BAR; PG8_SCHED;
            } else {
            PG8_LDB(B0, 0, 0); PG8_SCHED; PG8_LDA(At, 0, 0); PG8_STAGE(PG8_SA(1, 1), a1 + hstep, voffA);
            PG8_WAIT_L(8); PG8_BAR; PG8_WAIT_L(0); PG8_MMA(0, 0, At, B0); PG8_BAR; PG8_SCHED;
            PG8_LDB(B1, 0, 1); PG8_STAGE(PG8_SB(0, 0), b2, voffB);
            PG8_BAR; PG8_WAIT_L(0); PG8_MMA(0, 1, At, B1); PG8_BAR;
            PG8_LDA(At, 0, 1); PG8_STAGE(PG8_SA(0, 0), a2, voffA);
            PG8_BAR; PG8_WAIT_L(0); PG8_MMA(1, 0, At, B0); PG8_BAR; PG8_SCHED;
            PG8_STAGE(PG8_SB(0, 1), b2 + hstep, voffB);
            PG8_WAIT_V(6); PG8_BAR; PG8_MMA(1, 1, At, B1); PG8_BAR;
            PG8_LDB(B0, 1, 0); PG8_SCHED; PG8_LDA(At, 1, 0); PG8_STAGE(PG8_SA(0, 1), a2 + hstep, voffA);
            PG8_WAIT_L(8); PG8_BAR; PG8_WAIT_L(0); PG8_MMA(0, 0, At, B0); PG8_BAR; PG8_SCHED;
            PG8_LDB(B1, 1, 1); PG8_STAGE(PG8_SB(1, 0), b3, voffB);
            PG8_BAR; PG8_WAIT_L(0); PG8_MMA(0, 1, At, B1); PG8_BAR;
            PG8_LDA(At, 1, 1); PG8_STAGE(PG8_SA(1, 0), a3, voffA);
            PG8_BAR; PG8_WAIT_L(0); PG8_MMA(1, 0, At, B0); PG8_BAR; PG8_SCHED;
            PG8_STAGE(PG8_SB(1, 1), b3 + hstep, voffB);
            PG8_WAIT_V(6); PG8_BAR; PG8_MMA(1, 1, At, B1); PG8_BAR;
            }
        }
        if constexpr (ALIGN_EPI) { if (wr == 0) PG8_BAR; }
        if constexpr (!Epi::AFTER_DRAIN) { E(acc, cur, wr, wc, fr, fq, ui); S.done(cur); }
        if (!has_next) break;
#pragma unroll
        for (int a = 0; a < 2; ++a)
#pragma unroll
            for (int b = 0; b < 2; ++b)
#pragma unroll
                for (int m = 0; m < 4; ++m)
#pragma unroll
                    for (int n = 0; n < 2; ++n) acc[a][b][m][n] = (f32x4){0.f, 0.f, 0.f, 0.f};
        cur = nxt; cA = nA; cB = nB; ++ui;
        if constexpr (ALIGN_EPI) { if (wr == 1) PG8_BAR; }
    }
    PG8_WAIT_V(0);
    if constexpr (!ALIGN_EPI) { if (wr == 0) PG8_BAR; }
    PG8_BAR;
    if constexpr (Epi::AFTER_DRAIN) { E.fused(acc, cur, wr, wc, fr, fq, lds, wid, lane); S.done(cur); }
#undef PG8_SA
#undef PG8_SB
#undef PG8_STAGE
#undef PG8_LDA
#undef PG8_LDB
#undef PG8_MMA
#undef PG8_WAIT_V
#undef PG8_WAIT_L
#undef PG8_BAR
#undef PG8_SCHED
}
}
#ifndef PV_BUILTIN
#define PV_BUILTIN 0
#endif
#ifndef PV_PIPE
#define PV_PIPE 1
#endif
namespace att {
#ifdef CSTAMP_ON
#define CS(i) do { if (MODE == 1 && blockIdx.x == 0 && tid == 0) { const unsigned long long c_ = __builtin_amdgcn_s_memtime(); volatile unsigned* M_ = (volatile unsigned*)(lds + 131072 + 320); M_[32 + 2 * (i)] = (unsigned)c_; M_[33 + 2 * (i)] = (unsigned)(c_ >> 32); } } while (0)
#else
#define CS(i) do {} while (0)
#endif
#ifndef ABL
#define ABL 0
#endif
#ifndef ORD_SPLIT
#ifndef ORD_SPLIT
#define ORD_SPLIT 0
#endif
#endif
#ifndef NO_QKT_SPLIT
#define QKT_SPLIT 1
#endif
#ifndef CINIT_TEST
#define CINIT_TEST 0
#endif
using bf16 = __hip_bfloat16;
typedef short bf16x8 __attribute__((ext_vector_type(8)));
typedef short s16x4 __attribute__((ext_vector_type(4)));
typedef float f32x16 __attribute__((ext_vector_type(16)));
typedef float f32x4 __attribute__((ext_vector_type(4)));
typedef unsigned u32x4 __attribute__((ext_vector_type(4)));
constexpr int D = 128, NW = 8, QBLK = 32, KVBLK = 64, QB = NW * QBLK, SEQ = 4096;
constexpr int SHM_V = KVBLK * D * 2, SHM_K = KVBLK * D * 2;
constexpr int OFF_WS = 2 * SHM_V + 2 * SHM_K;
constexpr int OFF_LUT = OFF_WS + NW * 64 * 4;
constexpr int LUT_FLOATS = 4 * 512 + 64;
constexpr int OFF_G = OFF_LUT + LUT_FLOATS * 4;
constexpr int OFF_QN = OFF_G + 2 * 64 * 4;
constexpr int OFF_KM = OFF_QN + 8 * 4;
constexpr int LDS_BYTES = OFF_KM + 2 * 4 + 24;
#ifndef PRUNE_TV
#define PRUNE_TV 24.f
#endif
constexpr float PRUNE_T = PRUNE_TV;
constexpr float SCALE = 0.08838834764831845f, INV_SCALE = 11.313708498984761f, THR = 8.f;
constexpr int OSTR = 1024;

#define KSWZ(row, colB) ((row) * 256 + ((colB) ^ (((row) & 7) << 4)))
#define SBAR() __builtin_amdgcn_sched_barrier(0)
__device__ __forceinline__ int v_st(int k, int c) { const int kk = (k & ~0xC) | ((k & 4) << 1) | ((k & 8) >> 1); return ((kk >> 3) * 4 + (c >> 5)) * 512 + ((kk & 7) * 32 + (c & 31)) * 2; }
__device__ __forceinline__ int v_rd_base(int lane) { return ((lane & 3) << 3) | (((lane >> 2) & 3) << 6) | (((lane >> 4) & 1) << 5) | (((lane >> 5) & 1) << 8); }
constexpr int v_rd_off(int d0, int ks, int half) { return d0 * 512 + ks * 4096 + half * 2048; }
__device__ __forceinline__ int crow(int r, int hi) { return (r & 3) + 8 * (r >> 2) + 4 * hi; }
__device__ __forceinline__ unsigned cvtpk(float lo, float hi) { typedef float f2_ __attribute__((ext_vector_type(2))); typedef __bf16 b2_ __attribute__((ext_vector_type(2))); const f2_ v_ = {lo, hi}; return __builtin_bit_cast(unsigned, __builtin_convertvector(v_, b2_)); }
__device__ __forceinline__ bf16x8 load8(const bf16* p) { return *reinterpret_cast<const bf16x8*>(p); }
__device__ __forceinline__ void mask_tile(f32x16& p0, f32x16& p1, int dq) {
    const float NEG = -__builtin_inff();
#pragma unroll
    for (int r = 0; r < 16; ++r) { const int c = (r & 3) + 8 * (r >> 2);
        if (dq - c < 0) p0[r] = NEG;
        if (dq - c - 32 < 0) p1[r] = NEG; }
}
__device__ __forceinline__ void partialSM(f32x16& p0, f32x16& p1, float& m_reg, float& mn, float& alpha, bool keep = true) {
    float pmax = fmaxf(p0[0], p0[1]);
#pragma unroll
    for (int r = 2; r < 16; r += 2) pmax = __builtin_fmaxf(__builtin_fmaxf(pmax, p0[r]), p0[r + 1]);
#pragma unroll
    for (int r = 0; r < 16; r += 2) pmax = __builtin_fmaxf(__builtin_fmaxf(pmax, p1[r]), p1[r + 1]);
    { auto rr = __builtin_amdgcn_permlane32_swap(__float_as_uint(pmax), __float_as_uint(pmax), false, false);
      pmax = fmaxf(__uint_as_float(rr[0]), __uint_as_float(rr[1])); }
    if (!keep) pmax = -__builtin_inff();
    constexpr float C2 = 1.4426950408889634f * SCALE;
    if (__builtin_expect(__all((pmax - m_reg) * SCALE <= THR), 1)) { mn = m_reg; alpha = 1.f; }
    else { mn = fmaxf(m_reg, pmax); alpha = __builtin_amdgcn_exp2f((m_reg - mn) * C2); m_reg = mn; }
    const float mnL = keep ? -mn * C2 : -__builtin_inff();
    { typedef float f32x2_ __attribute__((ext_vector_type(2))); const f32x2_ c2v = {C2, C2}, mlv = {mnL, mnL};
#pragma unroll
      for (int r = 0; r < 16; r += 2) { f32x2_ a = {p0[r], p0[r + 1]}, b = {p1[r], p1[r + 1]}; a = __builtin_elementwise_fma(a, c2v, mlv); b = __builtin_elementwise_fma(b, c2v, mlv);
          p0[r] = a.x; p0[r + 1] = a.y; p1[r] = b.x; p1[r + 1] = b.y; } }
    for (int r = 0; r < 16; ++r) p0[r] = (ABL == 1) ? fminf(fabsf(p0[r]) * 1e-30f, 1.f) + 0.01f : __builtin_amdgcn_exp2f(p0[r]);
}
#define ATT_PK4(P, B_, OUT) do { unsigned a0 = cvtpk(P[B_+0], P[B_+1]), a1 = cvtpk(P[B_+2], P[B_+3]);                          \
        unsigned b0 = cvtpk(P[B_+4], P[B_+5]), b1 = cvtpk(P[B_+6], P[B_+7]);                                             \
        auto r0 = __builtin_amdgcn_permlane32_swap(a0, b0, false, false); auto r1 = __builtin_amdgcn_permlane32_swap(a1, b1, false, false); \
        u32x4 w = {r0[0], r1[0], r0[1], r1[1]}; OUT = *reinterpret_cast<bf16x8*>(&w); } while (0)
__device__ __forceinline__ void finishSM(f32x16& p0, f32x16& p1, float alpha, float& l_reg, bf16x8& pa0, bf16x8& pa1, bf16x8& pa2, bf16x8& pa3) {
    for (int r = 0; r < 16; ++r) p1[r] = (ABL == 1) ? fminf(fabsf(p1[r]) * 1e-30f, 1.f) + 0.01f : __builtin_amdgcn_exp2f(p1[r]);
    float ps; { typedef float f32x2_ __attribute__((ext_vector_type(2))); f32x2_ s2 = {p0[0], p0[1]};
#pragma unroll
      for (int r = 2; r < 16; r += 2) s2 += (f32x2_){p0[r], p0[r + 1]};
#pragma unroll
      for (int r = 0; r < 16; r += 2) s2 += (f32x2_){p1[r], p1[r + 1]};
      ps = s2.x + s2.y; }
    { auto rr = __builtin_amdgcn_permlane32_swap(__float_as_uint(ps), __float_as_uint(ps), false, false);
      ps = __uint_as_float(rr[0]) + __uint_as_float(rr[1]); }
    l_reg = l_reg * alpha + ps;
    ATT_PK4(p0, 0, pa0); ATT_PK4(p0, 8, pa1); ATT_PK4(p1, 0, pa2); ATT_PK4(p1, 8, pa3);
}
template <bool ZERO = false>
__device__ __forceinline__ void qkt(f32x16& p0, f32x16& p1, const char* K_tile, int r32, int hi, const bf16x8* qr) {
    if (ZERO) { p0 = f32x16{}; p1 = f32x16{}; }
    const char* kb[4];
#pragma unroll
    for (int dd = 0; dd < 4; ++dd) kb[dd] = K_tile + KSWZ(r32, (dd * 16 + hi * 8) * 2);
#pragma unroll
    for (int d0 = 0; d0 < 8; ++d0) { const char* a = kb[d0 & 3] + (d0 >> 2) * 128;
        bf16x8 b0 = *reinterpret_cast<const bf16x8*>(a);
        bf16x8 b1 = *reinterpret_cast<const bf16x8*>(a + 32 * 256);
        if (ABL == 3 || ABL == 5) { asm volatile("" :: "v"(b0), "v"(b1), "v"(qr[d0])); } else {
        p0 = __builtin_amdgcn_mfma_f32_32x32x16_bf16(b0, qr[d0], p0, 0, 0, 0);
        p1 = __builtin_amdgcn_mfma_f32_32x32x16_bf16(b1, qr[d0], p1, 0, 0, 0); }
#ifdef QKT_SPLIT
        if (d0 == 3) SBAR();
#endif
    }
}
template <int VOFF>
__device__ __forceinline__ void pv_tile(f32x16* o, int vb0, bf16x8 pa0, bf16x8 pa1, bf16x8 pa2, bf16x8 pa3) {
#define TRRD(dst, off) asm volatile("ds_read_b64_tr_b16 %0, %1 offset:%2" : "=&v"(dst) : "v"(vb0), "i"(off) : "memory")
#define VFRAG(l, h) (bf16x8){l[0], l[1], l[2], l[3], h[0], h[1], h[2], h[3]}
#if PV_BUILTIN
    typedef short v4i16_t_ __attribute__((ext_vector_type(4)));
    const LAS char* vp_ = (const LAS char*)(unsigned)vb0;
#define VTR(off) __builtin_bit_cast(s16x4, __builtin_amdgcn_ds_read_tr16_b64_v4i16((LAS v4i16_t_*)(vp_ + (off))))
#pragma unroll
    for (int d0 = 0; d0 < 4; ++d0) { const int b_ = VOFF + v_rd_off(d0, 0, 0);
        const s16x4 l0 = VTR(b_), h0 = VTR(b_ + 2048), l1 = VTR(b_ + 4096), h1 = VTR(b_ + 6144), l2 = VTR(b_ + 8192), h2 = VTR(b_ + 10240), l3 = VTR(b_ + 12288), h3 = VTR(b_ + 14336);
        o[d0] = __builtin_amdgcn_mfma_f32_32x32x16_bf16(pa0, VFRAG(l0, h0), o[d0], 0, 0, 0);
        o[d0] = __builtin_amdgcn_mfma_f32_32x32x16_bf16(pa1, VFRAG(l1, h1), o[d0], 0, 0, 0);
        o[d0] = __builtin_amdgcn_mfma_f32_32x32x16_bf16(pa2, VFRAG(l2, h2), o[d0], 0, 0, 0);
        o[d0] = __builtin_amdgcn_mfma_f32_32x32x16_bf16(pa3, VFRAG(l3, h3), o[d0], 0, 0, 0);
        if (d0 == 1) SBAR(); }
#undef VTR
#elif PV_PIPE
    s16x4 l0, h0, l1, h1, l2, h2, l3, h3, n0, m0, n1, m1;
#define RD_A(L0, H0, L1, H1, d0) do { constexpr int b_ = VOFF + v_rd_off(d0, 0, 0); TRRD(L0, b_); TRRD(H0, b_ + 2048); TRRD(L1, b_ + 4096); TRRD(H1, b_ + 6144); } while (0)
#define RD_B(L2, H2, L3, H3, d0) do { constexpr int b_ = VOFF + v_rd_off(d0, 0, 0); TRRD(L2, b_ + 8192); TRRD(H2, b_ + 10240); TRRD(L3, b_ + 12288); TRRD(H3, b_ + 14336); } while (0)
#define WAITL(n) do { asm volatile("s_waitcnt lgkmcnt(" #n ")" ::: "memory"); SBAR(); } while (0)
    RD_A(l0, h0, l1, h1, 0); RD_B(l2, h2, l3, h3, 0);
    RD_A(n0, m0, n1, m1, 1); WAITL(4);
    o[0] = __builtin_amdgcn_mfma_f32_32x32x16_bf16(pa0, VFRAG(l0, h0), o[0], 0, 0, 0); o[0] = __builtin_amdgcn_mfma_f32_32x32x16_bf16(pa1, VFRAG(l1, h1), o[0], 0, 0, 0);
    o[0] = __builtin_amdgcn_mfma_f32_32x32x16_bf16(pa2, VFRAG(l2, h2), o[0], 0, 0, 0); o[0] = __builtin_amdgcn_mfma_f32_32x32x16_bf16(pa3, VFRAG(l3, h3), o[0], 0, 0, 0);
    SBAR(); RD_B(l2, h2, l3, h3, 1);
    RD_A(l0, h0, l1, h1, 2); WAITL(4);
    o[1] = __builtin_amdgcn_mfma_f32_32x32x16_bf16(pa0, VFRAG(n0, m0), o[1], 0, 0, 0); o[1] = __builtin_amdgcn_mfma_f32_32x32x16_bf16(pa1, VFRAG(n1, m1), o[1], 0, 0, 0);
    o[1] = __builtin_amdgcn_mfma_f32_32x32x16_bf16(pa2, VFRAG(l2, h2), o[1], 0, 0, 0); o[1] = __builtin_amdgcn_mfma_f32_32x32x16_bf16(pa3, VFRAG(l3, h3), o[1], 0, 0, 0);
    SBAR(); RD_B(l2, h2, l3, h3, 2);
    RD_A(n0, m0, n1, m1, 3); WAITL(4);
    o[2] = __builtin_amdgcn_mfma_f32_32x32x16_bf16(pa0, VFRAG(l0, h0), o[2], 0, 0, 0); o[2] = __builtin_amdgcn_mfma_f32_32x32x16_bf16(pa1, VFRAG(l1, h1), o[2], 0, 0, 0);
    o[2] = __builtin_amdgcn_mfma_f32_32x32x16_bf16(pa2, VFRAG(l2, h2), o[2], 0, 0, 0); o[2] = __builtin_amdgcn_mfma_f32_32x32x16_bf16(pa3, VFRAG(l3, h3), o[2], 0, 0, 0);
    SBAR(); RD_B(l2, h2, l3, h3, 3);
    WAITL(0);
    o[3] = __builtin_amdgcn_mfma_f32_32x32x16_bf16(pa0, VFRAG(n0, m0), o[3], 0, 0, 0); o[3] = __builtin_amdgcn_mfma_f32_32x32x16_bf16(pa1, VFRAG(n1, m1), o[3], 0, 0, 0);
    o[3] = __builtin_amdgcn_mfma_f32_32x32x16_bf16(pa2, VFRAG(l2, h2), o[3], 0, 0, 0); o[3] = __builtin_amdgcn_mfma_f32_32x32x16_bf16(pa3, VFRAG(l3, h3), o[3], 0, 0, 0);
#undef RD_A
#undef RD_B
#undef WAITL
#else
#define PV_D0(d0) do { s16x4 l0, l1, l2, l3, h0, h1, h2, h3; constexpr int b_ = VOFF + v_rd_off(d0, 0, 0); \
        TRRD(l0, b_); TRRD(h0, b_ + 2048); TRRD(l1, b_ + 4096); TRRD(h1, b_ + 6144); TRRD(l2, b_ + 8192); TRRD(h2, b_ + 10240); TRRD(l3, b_ + 12288); TRRD(h3, b_ + 14336); \
        asm volatile("s_waitcnt lgkmcnt(0)" ::: "memory"); SBAR();   \
        if (ABL == 2 || ABL == 5) { asm volatile("" :: "v"(l0), "v"(h0), "v"(l1), "v"(h1), "v"(l2), "v"(h2), "v"(l3), "v"(h3), "v"(pa0), "v"(pa1), "v"(pa2), "v"(pa3)); } else { \
        o[d0] = __builtin_amdgcn_mfma_f32_32x32x16_bf16(pa0, VFRAG(l0, h0), o[d0], 0, 0, 0);   \
        o[d0] = __builtin_amdgcn_mfma_f32_32x32x16_bf16(pa1, VFRAG(l1, h1), o[d0], 0, 0, 0);   \
        o[d0] = __builtin_amdgcn_mfma_f32_32x32x16_bf16(pa2, VFRAG(l2, h2), o[d0], 0, 0, 0);   \
        o[d0] = __builtin_amdgcn_mfma_f32_32x32x16_bf16(pa3, VFRAG(l3, h3), o[d0], 0, 0, 0); } } while (0)
    PV_D0(0); PV_D0(1); PV_D0(2); PV_D0(3);
#undef PV_D0
#endif
#undef VFRAG
#undef TRRD
}

struct ABase { const bf16* Q; const bf16* K; const bf16* V; bf16* O; const float* F; const unsigned* sel; int nh, ocol0; };
struct ADesc { __amdgpu_buffer_rsrc_t q, k, v, f; };
struct AItem { int bh, qb, slot; };
#define A_HB(it)  ((size_t)(it).bh * SEQ * D)
#define A_Q(it)   (B.Q + A_HB(it) + (size_t)(it).qb * QB * D)
#define A_K(it)   (B.K + A_HB(it))
#define A_V(it)   (B.V + A_HB(it))
#define A_F(it)   (B.F + (size_t)(it).bh * SEQ)
#define A_O(it)   (B.O + ((size_t)((it).bh / B.nh) * SEQ + (size_t)(it).qb * QB) * OSTR + B.ocol0 + ((it).bh % B.nh) * D)
#define A_SEL(it) (B.sel + (size_t)(it).bh * SEQ + (size_t)(it).qb * QB)
#define A_P0(it)  ((it).qb * QB)
struct Seam { bf16x8 qr[8]; bf16x8 st_v0, st_v1, st_k0, st_k1; float st_g; };
template <int MODE> __device__ __forceinline__ int first_kb(int P0) { return MODE == 0 ? P0 + QB - KVBLK : 0; }
#define VMW() asm volatile("s_waitcnt vmcnt(0)" ::: "memory")
#define VMWN(n) asm volatile("s_waitcnt vmcnt(%0)" :: "i"(n) : "memory")
#define BL16(rs, vo, so) __builtin_bit_cast(bf16x8, __builtin_amdgcn_raw_buffer_load_b128((rs), (int)(vo), (int)(so), 0))
#define SLOAD_H(it, k0) do { const unsigned so_ = (unsigned)(((it).bh * SEQ + (ABL == 4 ? 0 : (k0))) * D * 2);                                                  \
                         S.st_v0 = BL16(DS.v, loff, so_); S.st_v1 = BL16(DS.v, loff, so_ + 32 * D * 2);                                     \
                         S.st_k0 = BL16(DS.k, loff, so_); S.st_k1 = BL16(DS.k, loff, so_ + 32 * D * 2);                                     \
                         if (MODE == 0) S.st_g = __builtin_bit_cast(float, __builtin_amdgcn_raw_buffer_load_b32(DS.f, (int)((tid & 63u) * 4u), (int)(((it).bh * SEQ + (k0)) * 4), 0)); } while (0)
#define QLOAD(it) do { const unsigned so_ = (unsigned)((((it).bh * SEQ) + (it).qb * QB) * D * 2);                                              \
                         _Pragma("unroll") for (int d0 = 0; d0 < 8; ++d0) S.qr[d0] = BL16(DS.q, qoff + d0 * 32, so_); } while (0)
#define SWRITE_HK(bf) do { *(bf16x8*)(K_lds + (bf) * SHM_K + kws) = S.st_k0; *(bf16x8*)(K_lds + (bf) * SHM_K + kws + 32 * 256) = S.st_k1; \
                           if (MODE == 0 && tid < 64) ((float*)(lds + OFF_G))[(bf) * 64 + tid] = S.st_g; } while (0)
#define SWRITE_HV(bf) do { *(bf16x8*)(V_lds + (bf) * SHM_V + vst0) = S.st_v0; *(bf16x8*)(V_lds + (bf) * SHM_V + vst0 + 8192) = S.st_v1; } while (0)
#define SWRITE_H(bf) do { SWRITE_HV(bf); SWRITE_HK(bf); } while (0)
template <int MODE>
__device__ __forceinline__ void attn_prime(const ABase& B, const ADesc& DS, const AItem& cur, char* lds, Seam& S) {
    const int tid = ph_tid(), wid = __builtin_amdgcn_readfirstlane(tid >> 6), lane = tid & 63, r32 = lane & 31, hi = lane >> 5;
    const int sr = tid >> 4, sc = (tid & 15) * 8, kws = KSWZ(sr, sc * 2); char* K_lds = lds + 2 * SHM_V; const unsigned loff = (unsigned)(sr * D + sc) * 2u, qoff = (unsigned)((wid * QBLK + r32) * D + hi * 8) * 2u;
    const int kb0 = first_kb<MODE>(A_P0(cur));
    QLOAD(cur);
    SLOAD_H(cur, kb0); VMW(); SWRITE_HK(0);
    __syncthreads();
}
template <int MODE>
__device__ __forceinline__ void attn_block(const ABase& B, const ADesc& DS, const AItem& cur, const AItem& nxt, char* lds, Seam& S) {
    const int tid = ph_tid(), wid = __builtin_amdgcn_readfirstlane(tid >> 6), lane = tid & 63, r32 = lane & 31, hi = lane >> 5;
    const int P0 = A_P0(cur), NT = (P0 + QB) / KVBLK;
    int NTE = NT;
    float g0 = 0.f, gl = 0.f;
    if (MODE == 0) { const float* Gh = A_F(cur); g0 = Gh[P0]; gl = Gh[((tid & 63) < NT ? (tid & 63) : NT - 1) * KVBLK + KVBLK - 1]; }
    const int kbn = first_kb<MODE>(A_P0(nxt));
    const int qlo = P0 + wid * QBLK, qm = qlo + r32 - 4 * hi;
    char* V_lds = lds; char* K_lds = lds + 2 * SHM_V;
    float* ws = (float*)(lds + OFF_WS) + wid * 64; float* li_l = ws, * al_l = ws + 32;
    float m_reg = -1e30f, l_reg = 0; f32x16 o[4] = {};
    const int sr = tid >> 4, sc = (tid & 15) * 8, vst0 = v_st(sr, sc)  , kws = KSWZ(sr, sc * 2);
    const unsigned loff = (unsigned)(sr * D + sc) * 2u;
    const int vb0 = (int)(uintptr_t)V_lds + v_rd_base(lane);
    const float* Fh = A_F(cur);
    const float* lut = (const float*)(lds + OFF_LUT) + (cur.bh % B.nh) * 512 + 256;
    const bool ordB = ORD_SPLIT && ((ORD_SPLIT == 1) ? (wid >= 4) : ((ORD_SPLIT == 2) ? (wid & 1) : ((wid >> 1) & 1)));
    const int own = P0 >> 8;
    if (MODE == 1) { const unsigned sr_ = A_SEL(cur)[wid * QBLK + r32] | (1u << own); if (hi == 0) ((unsigned*)li_l)[r32] = sr_; asm volatile("s_waitcnt lgkmcnt(0)" ::: "memory"); }
#define RESC(a) do { if (__any((a) < 1.f)) { if (hi == 0) al_l[r32] = (a); asm volatile("s_waitcnt lgkmcnt(0)" ::: "memory");              \
                     for (int d_ = 0; d_ < 4; ++d_) for (int r = 0; r < 16; ++r) o[d_][r] *= al_l[crow(r, hi)]; } } while (0)
#define KBASE(t) (MODE == 0 ? (NT - 1 - (t)) * KVBLK : (t) * KVBLK)
#define MASKT(P0_, P1_, t) do { const int kb_ = KBASE(t); if (kb_ + KVBLK - 1 > qlo) mask_tile(P0_, P1_, qm - kb_); } while (0)
#define CINIT(P0_, P1_, t, KB) do { const int kb_ = KBASE(t);                                                                               \
        if (MODE == 0) { const float* fp_ = (const float*)(lds + OFF_G) + (KB) * 64 + 4 * hi;                                               \
            _Pragma("unroll") for (int g_ = 0; g_ < 4; ++g_) { const f32x4 a_ = *(const f32x4*)(fp_ + 8 * g_), b_ = *(const f32x4*)(fp_ + 32 + 8 * g_);   \
                _Pragma("unroll") for (int i_ = 0; i_ < 4; ++i_) { P0_[4 * g_ + i_] = a_[i_]; P1_[4 * g_ + i_] = b_[i_]; } } }   \
        else { if (qlo - kb_ - (KVBLK - 1) >= 113) { P0_ = f32x16{}; P1_ = f32x16{}; }     \
            else { const float* lp_ = lut + (qlo + r32 - kb_ - 4 * hi - 59);                                                                 \
                _Pragma("unroll") for (int r_ = 0; r_ < 16; ++r_) { const int c_ = (r_ & 3) + 8 * (r_ >> 2);                                 \
                    P0_[r_] = lp_[59 - c_]; P1_[r_] = lp_[27 - c_]; } } } } while (0)
#define KEEP(t) (MODE == 0 ? true : (bool)((((const unsigned*)li_l)[r32] >> (KBASE(t) >> 8)) & 1u))
    constexpr int NQL = 8;
#define SEAM_K0() do { VMWN(NQL); SWRITE_HK(0); SBAR(); } while (0)
    f32x16 pA0, pA1, pB0, pB1; float mnA, mnB, alA, alB; bf16x8 pa0, pa1, pa2, pa3;
    SWRITE_HV(0); SBAR();
    CINIT(pA0, pA1, 0, 0);
    SLOAD_H(cur, KBASE(1));
    SBAR(); qkt(pA0, pA1, K_lds, r32, hi, S.qr);
    MASKT(pA0, pA1, 0); partialSM(pA0, pA1, m_reg, mnA, alA, KEEP(0));
    if (MODE == 0) {
        float qs = 0.f;
#pragma unroll
        for (int d0 = 0; d0 < 8; ++d0) { const u32x4 w = __builtin_bit_cast(u32x4, S.qr[d0]);
#pragma unroll
            for (int e = 0; e < 4; ++e) { const float a = __uint_as_float(w[e] << 16), b = __uint_as_float(w[e] & 0xffff0000u); qs += a * a + b * b; } }
        { auto rr = __builtin_amdgcn_permlane32_swap(__float_as_uint(qs), __float_as_uint(qs), false, false); qs = __uint_as_float(rr[0]) + __uint_as_float(rr[1]); }
#pragma unroll
        for (int o_ = 1; o_ < 32; o_ <<= 1) qs = fmaxf(qs, __shfl_xor(qs, o_));
        if (lane == 0) ((float*)(lds + OFF_QN))[wid] = qs; }
    VMW(); SWRITE_H(1);
    __syncthreads();
    if (MODE == 0) {
        const float* qn = (const float*)(lds + OFF_QN); float q2 = qn[0];
#pragma unroll
        for (int w_ = 1; w_ < 8; ++w_) q2 = fmaxf(q2, qn[w_]);
        const float k2 = ((const float*)(lds + OFF_KM))[cur.slot];
        const float thr = 2.04f * sqrtf(q2 * k2) + PRUNE_T * INV_SCALE;
        const unsigned long long bal = __ballot(lane < NT && (g0 - gl > thr));
        int jlo = bal == ~0ull ? 64 : __builtin_ctzll(~bal);
        jlo = __builtin_amdgcn_readfirstlane(jlo);
        if (jlo > NT - 4) jlo = NT - 4;
        jlo &= ~1;
        NTE = NT - jlo; }
#define HALF_STEP(PX0, PX1, mnX, alX, PY0, PY1, alY, t, KB, VB, SB) do {                                                      \
        SBAR(); CS(60);                                                                                                       \
        if (MODE == 1 && qlo - KBASE(t) - (KVBLK - 1) >= 113) { qkt<true>(PX0, PX1, K_lds + (KB) * SHM_K, r32, hi, S.qr); }            \
        else { CINIT(PX0, PX1, (t), (KB)); qkt(PX0, PX1, K_lds + (KB) * SHM_K, r32, hi, S.qr); }                                  \
        finishSM(PY0, PY1, alY, l_reg, pa0, pa1, pa2, pa3); SBAR(); CS(62);                   \
        if ((t) + 1 < NTE && ABL != 6 && ABL != 8) { SLOAD_H(cur, KBASE((t) + 1)); SBAR(); } CS(63);                           \
        pv_tile<(VB) * SHM_V>(o, vb0, pa0, pa1, pa2, pa3); MASKT(PX0, PX1, (t)); partialSM(PX0, PX1, m_reg, mnX, alX, KEEP(t)); CS(65); \
        if (ABL != 7 && ABL != 8) __syncthreads(); CS(66);                                                                    \
        if ((t) + 1 < NTE) { VMW(); SWRITE_H(SB); } CS(67);                                                                    \
        RESC(alX); if (ABL != 7 && ABL != 8) __syncthreads(); CS(68); } while (0)
    for (int t = 1; t + 1 < NTE; t += 2) {
        HALF_STEP(pB0, pB1, mnB, alB, pA0, pA1, alA, t, 1, 0, 0);
        HALF_STEP(pA0, pA1, mnA, alA, pB0, pB1, alB, t + 1, 0, 1, 1);
    }
    SBAR(); CINIT(pB0, pB1, NTE - 1, 1); qkt(pB0, pB1, K_lds + SHM_K, r32, hi, S.qr); SBAR();
    SLOAD_H(nxt, kbn); SBAR();
    { const int t2_ = ph_tid(), l2_ = t2_ & 63; const unsigned qoff = (unsigned)((wid * QBLK + (l2_ & 31)) * D + (l2_ >> 5) * 8) * 2u; QLOAD(nxt); }
    SBAR();
    finishSM(pA0, pA1, alA, l_reg, pa0, pa1, pa2, pa3); SBAR();
    pv_tile<0>(o, vb0, pa0, pa1, pa2, pa3);
    MASKT(pB0, pB1, NTE - 1); partialSM(pB0, pB1, m_reg, mnB, alB, KEEP(NTE - 1)); __syncthreads(); RESC(alB);
    finishSM(pB0, pB1, alB, l_reg, pa0, pa1, pa2, pa3); SBAR(); pv_tile<SHM_V>(o, vb0, pa0, pa1, pa2, pa3);
    SBAR(); SEAM_K0();
    if (hi == 0) li_l[r32] = l_reg; asm volatile("s_waitcnt lgkmcnt(0)" ::: "memory");
    float rli[16];
#pragma unroll
    for (int r = 0; r < 16; ++r) rli[r] = __builtin_amdgcn_rcpf(li_l[crow(r, hi)]);
    bf16* Ow = A_O(cur) + (size_t)(wid * QBLK) * OSTR; const unsigned ooff = (unsigned)(4 * hi * OSTR + r32);
#pragma unroll
    for (int r = 0; r < 16; ++r) { const int orow = crow(r, hi);
#pragma unroll
        for (int d0 = 0; d0 < 4; ++d0) { const float v = o[d0][r] * rli[r];
            const float vn = __uint_as_float((unsigned)__builtin_amdgcn_mov_dpp((int)__float_as_uint(v), 0xB1, 0xF, 0xF, true));
            if ((r32 & 1) == 0) *(unsigned*)(Ow + ((r & 3) + 8 * (r >> 2)) * OSTR + d0 * 32 + ooff) = cvtpk(v, vn); } }
    __syncthreads();
#undef RESC
#undef KBASE
#undef MASKT
#undef CINIT
#undef KEEP
#undef SEAM_K0
#undef HALF_STEP
}
#undef ROW
#undef VMW
#undef VMWN
#undef SLOAD_H
#undef QLOAD
#undef BL16
#undef SWRITE_HK
#undef SWRITE_HV
#undef SWRITE_H
template <int MODE, class Sched>
__device__ __forceinline__ void attn_phase(char* lds, const ABase& B, const Sched& sch) {
    AItem cur, nxt; if (!sch.get(0, cur)) return;
    ADesc DS; const int tb_ = 8 * SEQ * B.nh * D * 2;
    DS.q = __builtin_amdgcn_make_buffer_rsrc((void*)B.Q, (short)0, tb_, 0x00020000); DS.k = __builtin_amdgcn_make_buffer_rsrc((void*)B.K, (short)0, tb_, 0x00020000);
    DS.v = __builtin_amdgcn_make_buffer_rsrc((void*)B.V, (short)0, tb_, 0x00020000); DS.f = __builtin_amdgcn_make_buffer_rsrc((void*)B.F, (short)0, MODE == 0 ? 8 * SEQ * B.nh * 4 : 0, 0x00020000);
    Seam S; attn_prime<MODE>(B, DS, cur, lds, S);
    for (int i = 0;; ++i) {
        const bool more = sch.get(i + 1, nxt); if (!more) nxt = cur;
        attn_block<MODE>(B, DS, cur, nxt, lds, S);
        if (!more) break;
        cur = nxt;
    }
}
#undef SBAR
}
namespace ret {
using att::bf16; using att::bf16x8; using att::s16x4; using att::f32x16; using att::f32x4; using att::u32x4;
using att::crow; using att::cvtpk; using att::load8; using att::v_st; using att::v_rd_base; using att::qkt; using att::pv_tile;
typedef float f32x2c_ __attribute__((ext_vector_type(2))); typedef __bf16 bf16x2c_ __attribute__((ext_vector_type(2)));
__device__ __forceinline__ unsigned cvtpk_c(float lo, float hi) { const f32x2c_ v = {lo, hi}; const bf16x2c_ b = __builtin_convertvector(v, bf16x2c_); return __builtin_bit_cast(unsigned, b); }
__device__ __forceinline__ float bf_lo(unsigned w) { return __uint_as_float(w << 16); }
__device__ __forceinline__ float bf_hi(unsigned w) { return __uint_as_float(w & 0xffff0000u); }
__device__ __forceinline__ float l2g_of(int h) { return __builtin_log2f(1.f - __builtin_amdgcn_exp2f(-5.f - (float)h)); }
#define SBAR() __builtin_amdgcn_sched_barrier(0)
#ifdef RSTAMP_ON
#define RSTAMP(i) do { if (blockIdx.x == 0 && threadIdx.x == 0) { const unsigned long long t_ = __builtin_amdgcn_s_memrealtime(); volatile unsigned* M_ = (volatile unsigned*)(lds + 131072 + 320); M_[32 + 2 * (i)] = (unsigned)t_; M_[33 + 2 * (i)] = (unsigned)(t_ >> 32); } } while (0)
#else
#define RSTAMP(i) do {} while (0)
#endif
__device__ __forceinline__ int frag_idx(int dv, int dk) { return (((((dv >> 5) * 8 + (dk >> 4)) * 2 + ((dk >> 3) & 1)) * 32 + (dv & 31)) << 3) + (dk & 7); }
struct KVStage { u32x4 kw[4]; bf16x8 vv[4]; };
__device__ __forceinline__ void kv_load(KVStage& st, const bf16* K, const bf16* V) {
    const int tid = ph_tid();
#pragma unroll
    for (int i = 0; i < 4; ++i) { const int idx = tid + 512 * i, row = idx >> 4, pc = idx & 15;
        st.kw[i] = *(const u32x4*)(K + (size_t)row * 128 + pc * 8); st.vv[i] = load8(V + (size_t)row * 128 + pc * 8); }
}
__device__ __forceinline__ void kv_task(char* lds, KVStage& st, const bf16* Kn, const bf16* Vn, bool has_next, bf16* KVt, int h) {
    const int tid = ph_tid(), wid = __builtin_amdgcn_readfirstlane(tid >> 6), lane = tid & 63, r32 = lane & 31, hi = lane >> 5;
    const float l2g = l2g_of(h);
#pragma unroll
    for (int i = 0; i < 4; ++i) { const int idx = tid + 512 * i, row = idx >> 4, pc = idx & 15;
        const u32x4 kw = st.kw[i];
        const float dec = __builtin_amdgcn_exp2f(l2g * (float)(127 - row));
        u32x4 ks; ks.x = cvtpk(bf_lo(kw.x) * dec, bf_hi(kw.x) * dec); ks.y = cvtpk(bf_lo(kw.y) * dec, bf_hi(kw.y) * dec);
        ks.z = cvtpk(bf_lo(kw.z) * dec, bf_hi(kw.z) * dec); ks.w = cvtpk(bf_lo(kw.w) * dec, bf_hi(kw.w) * dec);
        const int off = (row >> 6) * 16384 + v_st(row & 63, pc * 8);
        *(u32x4*)(lds + off) = ks; *(bf16x8*)(lds + 32768 + off) = st.vv[i]; }
    if (has_next) kv_load(st, Kn, Vn);
    __syncthreads();
    const int dkb = wid >> 1, dvb0 = 2 * (wid & 1);
    const int kb = (int)(uintptr_t)lds + v_rd_base(lane) + dkb * 512, vb = (int)(uintptr_t)lds + 32768 + v_rd_base(lane) + dvb0 * 512;
    f32x16 acc0 = {}, acc1 = {};
#define TRRD(dst, base, off) asm volatile("ds_read_b64_tr_b16 %0, %1 offset:%2" : "=&v"(dst) : "v"(base), "i"(off) : "memory")
#define KV_STEP(tt, ks) do { s16x4 al, ah, b0l, b0h, b1l, b1h; constexpr int o_ = (tt) * 16384 + (ks) * 4096;                        \
        TRRD(al, kb, o_); TRRD(ah, kb, o_ + 2048); TRRD(b0l, vb, o_); TRRD(b0h, vb, o_ + 2048); TRRD(b1l, vb, o_ + 512); TRRD(b1h, vb, o_ + 2560);   \
        asm volatile("s_waitcnt lgkmcnt(0)" ::: "memory"); SBAR();                                                                     \
        const bf16x8 A_ = (bf16x8){al[0], al[1], al[2], al[3], ah[0], ah[1], ah[2], ah[3]};                                              \
        acc0 = __builtin_amdgcn_mfma_f32_32x32x16_bf16(A_, (bf16x8){b0l[0], b0l[1], b0l[2], b0l[3], b0h[0], b0h[1], b0h[2], b0h[3]}, acc0, 0, 0, 0);   \
        acc1 = __builtin_amdgcn_mfma_f32_32x32x16_bf16(A_, (bf16x8){b1l[0], b1l[1], b1l[2], b1l[3], b1h[0], b1h[1], b1h[2], b1h[3]}, acc1, 0, 0, 0); } while (0)
    KV_STEP(0, 0); KV_STEP(0, 1); KV_STEP(0, 2); KV_STEP(0, 3); KV_STEP(1, 0); KV_STEP(1, 1); KV_STEP(1, 2); KV_STEP(1, 3);
#undef KV_STEP
#pragma unroll
    for (int g = 0; g < 4; ++g) { const int dk = 32 * dkb + 8 * g + 4 * hi;
        uint2 w0, w1; w0.x = cvtpk_c(acc0[4 * g], acc0[4 * g + 1]); w0.y = cvtpk_c(acc0[4 * g + 2], acc0[4 * g + 3]); w1.x = cvtpk_c(acc1[4 * g], acc1[4 * g + 1]); w1.y = cvtpk_c(acc1[4 * g + 2], acc1[4 * g + 3]);
        *(uint2*)(KVt + frag_idx(32 * dvb0 + r32, dk)) = w0; *(uint2*)(KVt + frag_idx(32 * (dvb0 + 1) + r32, dk)) = w1; }
    __syncthreads();
}
__device__ __forceinline__ void out_task(char* lds, const bf16* Q, const bf16* K, const bf16* V, const bf16* ST, const bf16* RG, const float* gn, bf16* CAT, int h) {
    const int tid = ph_tid(), wid = __builtin_amdgcn_readfirstlane(tid >> 6), lane = tid & 63, r32 = lane & 31, hi = lane >> 5;
    const int ch = wid >> 2, wq = wid & 3, ltid = tid & 255;
    const float l2g = l2g_of(h);
    char* Vreg = lds + ch * 32768; char* Kreg = lds + 65536 + ch * 32768;
    bf16x8 kst[8];
#pragma unroll
    for (int i = 0; i < 8; ++i) { const int row = (ltid >> 4) + 16 * i, pc = ltid & 15; kst[i] = load8(K + (size_t)(ch * 128 + row) * 128 + pc * 8); }
    { const bf16* STc = ST + (size_t)ch * 16384; bf16x8 sst[8];
#pragma unroll
      for (int i = 0; i < 8; ++i) sst[i] = load8(STc + ((ltid + 256 * i) << 3));
#pragma unroll
      for (int i0 = 0; i0 < 8; i0 += 4) {
#pragma unroll
        for (int i = i0; i < i0 + 4; ++i) { const int row = (ltid >> 4) + 16 * i, pc = ltid & 15;
          const bf16x8 vv = load8(V + (size_t)(ch * 128 + row) * 128 + pc * 8);
          *(bf16x8*)(Vreg + (row >> 6) * 16384 + v_st(row & 63, pc * 8)) = vv; }
        SBAR(); }
#pragma unroll
      for (int i = 0; i < 8; ++i) *(bf16x8*)(Kreg + ((ltid + 256 * i) << 4)) = sst[i]; }
    RSTAMP(21);
    bf16x8 qr[8];
#pragma unroll
    for (int d0 = 0; d0 < 8; ++d0) qr[d0] = load8(Q + (size_t)(ch * 128 + wq * 32 + r32) * 128 + d0 * 16 + hi * 8);
    f32x16 o[4] = {};
    __syncthreads();
#pragma unroll
    for (int d0 = 0; d0 < 4; ++d0) { bf16x8 sf[8];
#pragma unroll
        for (int ks = 0; ks < 8; ++ks) sf[ks] = *(const bf16x8*)(Kreg + ((((d0 * 8 + ks) * 2 + hi) * 32 + r32) << 4));
#pragma unroll
        for (int ks = 0; ks < 8; ++ks) o[d0] = __builtin_amdgcn_mfma_f32_32x32x16_bf16(qr[ks], sf[ks], o[d0], 0, 0, 0); }
#pragma unroll
    for (int r = 0; r < 16; ++r) { const float qd = __builtin_amdgcn_exp2f(l2g * (float)(wq * 32 + crow(r, hi) + 1));
#pragma unroll
        for (int d0 = 0; d0 < 4; ++d0) o[d0][r] *= qd; }
    u32x4 gwv[8];
    { const bf16* rgp0 = RG + (size_t)(ch * 128 + wq * 32 + (lane & 31)) * 512 + (lane >> 5) * 64;
#pragma unroll
      for (int i = 0; i < 8; ++i) gwv[i] = *(const u32x4*)(rgp0 + 8 * i); }
    __syncthreads();
#pragma unroll
    for (int i = 0; i < 8; ++i) { const int row = (ltid >> 4) + 16 * i, pc = ltid & 15; *(bf16x8*)(Kreg + (row >> 6) * 16384 + KSWZ(row & 63, pc * 16)) = kst[i]; }
    __syncthreads();
    RSTAMP(22);
    const int vb0 = (int)(uintptr_t)Vreg + v_rd_base(lane), row = wq * 32 + r32;
    for (int kt = 0; kt < 2; ++kt) { if (kt * 64 > wq * 32 + 31) break;
        f32x16 p0 = {}, p1 = {};
        qkt(p0, p1, Kreg + kt * 16384, r32, hi, qr);
#pragma unroll
        for (int r = 0; r < 16; ++r) { const int k0 = kt * 64 + crow(r, hi), k1 = k0 + 32;
            p0[r] = (k0 <= row) ? p0[r] * __builtin_amdgcn_exp2f(l2g * (float)(row - k0)) : 0.f;
            p1[r] = (k1 <= row) ? p1[r] * __builtin_amdgcn_exp2f(l2g * (float)(row - k1)) : 0.f; }
        bf16x8 pa0, pa1, pa2, pa3;
        ATT_PK4(p0, 0, pa0); ATT_PK4(p0, 8, pa1); ATT_PK4(p1, 0, pa2); ATT_PK4(p1, 8, pa3);
        SBAR(); pv_tile<0>(o, vb0 + kt * 16384, pa0, pa1, pa2, pa3); }
    RSTAMP(23);
    __syncthreads();
    { float* tile = (float*)(lds + wid * 16384);
#pragma unroll
      for (int r = 0; r < 16; ++r) { const int rw = crow(r, hi);
#pragma unroll
          for (int d0 = 0; d0 < 4; ++d0) { const int c = d0 * 8 + (r32 >> 2); tile[rw * 128 + ((c ^ (rw & 15)) << 2) + (r32 & 3)] = o[d0][r]; } }
      asm volatile("s_waitcnt lgkmcnt(0)" ::: "memory");
      const int rw = lane & 31, hf = lane >> 5, trow = ch * 128 + wq * 32 + rw;
      const float* trp = tile + rw * 128; const int sw = rw & 15;
#define TV(i) (*(const f32x4*)(trp + ((((hf * 16 + (i)) ^ sw)) << 2)))
      float s = 0.f;
#pragma unroll
      for (int i = 0; i < 16; ++i) { const f32x4 t = TV(i); s += (t[0] + t[1]) + (t[2] + t[3]); }
      { auto rr = __builtin_amdgcn_permlane32_swap(__float_as_uint(s), __float_as_uint(s), false, false); s = __uint_as_float(rr[0]) + __uint_as_float(rr[1]); }
      const float mu = s * (1.f / 128.f); float q = 0.f;
#pragma unroll
      for (int i = 0; i < 16; ++i) { const f32x4 t = TV(i) - mu; q += (t[0] * t[0] + t[1] * t[1]) + (t[2] * t[2] + t[3] * t[3]); }
      { auto rr = __builtin_amdgcn_permlane32_swap(__float_as_uint(q), __float_as_uint(q), false, false); q = __uint_as_float(rr[0]) + __uint_as_float(rr[1]); }
      const float rstd = __builtin_amdgcn_rsqf(q * (1.f / 128.f) + 1e-5f);
      bf16* cp = CAT + (size_t)trow * 1024 + hf * 64; const float* gp = gn + hf * 64;
#pragma unroll
      for (int i = 0; i < 8; ++i) { const u32x4 gw = gwv[i]; const f32x4 ga = *(const f32x4*)(gp + 8 * i), gb = *(const f32x4*)(gp + 8 * i + 4);
          const f32x4 va = (TV(2 * i) - mu) * rstd * ga, vb = (TV(2 * i + 1) - mu) * rstd * gb;
          float y[8];
#pragma unroll
          for (int e = 0; e < 4; ++e) { const float g0 = bf_lo(gw[e]), g1 = bf_hi(gw[e]);
              const float x0 = (e < 2) ? va[(e & 1) * 2] : vb[(e & 1) * 2], x1 = (e < 2) ? va[(e & 1) * 2 + 1] : vb[(e & 1) * 2 + 1];
              y[2 * e] = x0 * g0 * __builtin_amdgcn_rcpf(1.f + __builtin_amdgcn_exp2f(-1.4426950408889634f * g0));
              y[2 * e + 1] = x1 * g1 * __builtin_amdgcn_rcpf(1.f + __builtin_amdgcn_exp2f(-1.4426950408889634f * g1)); }
          u32x4 w; w.x = cvtpk(y[0], y[1]); w.y = cvtpk(y[2], y[3]); w.z = cvtpk(y[4], y[5]); w.w = cvtpk(y[6], y[7]);
          *(u32x4*)(cp + 8 * i) = w; }
#undef TV
    }
    __syncthreads();
}
#undef TRRD
#undef SBAR
}
constexpr int NWAVES = 8;
#ifndef PLAIN_ALIGN
#define PLAIN_ALIGN true
#endif
#ifndef PLAIN_SP2
#define PLAIN_SP2 true
#endif
constexpr int BATCH = 8, SEQ = 4096, DM = 1024, T = BATCH * SEQ, FFH = 2816;
constexpr size_t MiB = 1u << 20;
constexpr size_t WS_CTL = 0, CTL_ZERO_BYTES = 1 * MiB;
constexpr size_t WS_COS = 1 * MiB, WS_SIN = 2 * MiB;
constexpr size_t WS_WFL = 3 * MiB;
constexpr size_t WS_KMEAN = 3 * MiB + 65536;
constexpr size_t WS_SEL = 4 * MiB;
constexpr size_t WS_LOGF = 5 * MiB;
constexpr size_t WS_FCUM = 6 * MiB;
constexpr size_t WS_RS = 7 * MiB;
constexpr size_t WS_WP0 = 8 * MiB, WS_WO0 = 15 * MiB, WS_WFI0 = 17 * MiB, WS_WFO0 = 28 * MiB, WS_WP1 = 34 * MiB, WS_WO1 = 40 * MiB, WS_WFI1 = 42 * MiB, WS_WFO1 = 53 * MiB;
constexpr size_t WS_A = 64 * MiB;
constexpr size_t WS_B = 128 * MiB;
constexpr size_t WS_C = 352 * MiB;
constexpr size_t WS_D = 416 * MiB;
constexpr size_t WS_END = 480 * MiB;
constexpr int CW_BAR = 4096, CW_KM = 8192;
constexpr int RING_BYTES = 131072, MISC_OFF = RING_BYTES + 320, LDS_BYTES = 147456;
constexpr int SCR_OFF = RING_BYTES + 1024;

typedef unsigned short bf16r;
typedef unsigned v4u __attribute__((ext_vector_type(4)));
typedef float f32x4 __attribute__((ext_vector_type(4)));
#define LDS_WAIT() asm volatile("s_waitcnt lgkmcnt(0)" ::: "memory")
__device__ __forceinline__ unsigned pk2(float lo, float hi) { unsigned r; asm volatile("v_cvt_pk_bf16_f32 %0, %1, %2" : "=v"(r) : "v"(lo), "v"(hi)); return r; }
template <int CTRL> __device__ __forceinline__ float dpp_f(float v) { return __uint_as_float((unsigned)__builtin_amdgcn_mov_dpp((int)__float_as_uint(v), CTRL, 0xF, 0xF, true)); }
__device__ __forceinline__ float xsum16(float v) { auto rr = __builtin_amdgcn_permlane16_swap(__float_as_uint(v), __float_as_uint(v), false, false); return __uint_as_float(rr[0]) + __uint_as_float(rr[1]); }
__device__ __forceinline__ float xsum32(float v) { auto rr = __builtin_amdgcn_permlane32_swap(__float_as_uint(v), __float_as_uint(v), false, false); return __uint_as_float(rr[0]) + __uint_as_float(rr[1]); }
__device__ __forceinline__ float wave_sum(float v) {
    v += dpp_f<0xB1>(v);
    v += dpp_f<0x4E>(v);
    v += dpp_f<0x141>(v);
    v += dpp_f<0x140>(v);
    return xsum32(xsum16(v));
}
__device__ __forceinline__ int t5_bucket(int rel) {
    int n = rel > 0 ? rel : 0; if (n < 16) return n;
    int large = 16 + (int)(logf((float)n / 16.f) / 2.0794415416798357f * 16.f);
    return large < 31 ? large : 31;
}
template <int MAP> __device__ __forceinline__ int dest_row(int n) {
    if (MAP == 1) { if (n >= 1024) return n; const int d = n & 127, j = d & 63; return (n & ~127) + 8 * (j >> 2) + (j & 3) + ((d >> 6) << 2); }
    if (MAP == 2) { if (n < FFH) return 256 * (n >> 7) + (n & 127); const int c = n - FFH; return 256 * (c >> 7) + 128 + (c & 127); }
    return n;
}
struct TItem { const float* W; bf16r* WT; const float* gk; int K, ldw, map, k0, n0; };
__device__ __forceinline__ int dest_row_rt(int map, int n) { return map == 1 ? dest_row<1>(n) : (map == 2 ? dest_row<2>(n) : n); }
__device__ __forceinline__ void titem_load(const TItem& t, float (&rg)[32], float (&gg)[32], int lane) {
#pragma unroll
    for (int i = 0; i < 32; ++i) { const int kk = 2 * i + (lane >> 5); rg[i] = t.W[(size_t)(t.k0 + kk) * t.ldw + t.n0 + (lane & 31)]; gg[i] = t.gk ? t.gk[t.k0 + kk] : 1.f; }
}
__device__ __forceinline__ void titem_store(const TItem& t, const float (&rg)[32], const float (&gg)[32], LAS float* scr, int lane) {
#pragma unroll
    for (int i = 0; i < 32; ++i) { const int kk = 2 * i + (lane >> 5); scr[kk * 33 + (lane & 31)] = rg[i] * gg[i]; }
    LDS_WAIT(); asm volatile("" ::: "memory");
    const int c = lane & 7;
#pragma unroll
    for (int j = 0; j < 4; ++j) { const int n = (lane >> 3) + 8 * j; const LAS float* s = scr + (8 * c) * 33 + n;
        v4u o; o.x = pk2(s[0 * 33], s[1 * 33]); o.y = pk2(s[2 * 33], s[3 * 33]); o.z = pk2(s[4 * 33], s[5 * 33]); o.w = pk2(s[6 * 33], s[7 * 33]);
        *(v4u*)(t.WT + (size_t)dest_row_rt(t.map, t.n0 + n) * t.K + t.k0 + 8 * c) = o; }
    LDS_WAIT(); asm volatile("" ::: "memory");
}
struct P {
    const float *x, *relb, *nmpre, *nmpost, *nfpre, *nfpost, *ewin, *egn, *ewout, *owin, *obf, *owout, *fwin, *fwout; float* out; unsigned char* ws;
};
template <int XIN, bool HAS_M, int OUT, bool HAS_LOGF>
__device__ __forceinline__ void row_pass(int gw, int NGW, int lane, const float* xin32, const bf16r* xb_in, const bf16r* m, const float* gpost, bf16r* xb_out, float* rs, float* out32,
                                         const LAS float* wfl, const float* bfg, float* logf_out) {
    f32x4 gp[4];
#pragma unroll
    for (int j = 0; j < 4; ++j) { if (HAS_M) gp[j] = *(const f32x4*)(gpost + 4 * lane + 256 * j); }
    constexpr int RPW = 2;
#define UNPK(w) ((f32x4){__uint_as_float((w).x << 16), __uint_as_float((w).x & 0xffff0000u), __uint_as_float((w).y << 16), __uint_as_float((w).y & 0xffff0000u)})
    struct Raw { f32x4 v[RPW][4]; uint2 xw[RPW][4]; uint2 mw[RPW][4]; };
    auto rp_load = [&](Raw& R, int r0) {
#pragma unroll
        for (int p = 0; p < RPW; ++p) { const int rr = r0 + p * NGW; if (rr < T) {
#pragma unroll
            for (int j = 0; j < 4; ++j) { if (XIN == 0) R.v[p][j] = *(const f32x4*)(xin32 + (size_t)rr * DM + 4 * lane + 256 * j); else R.xw[p][j] = *(const uint2*)(xb_in + (size_t)rr * DM + 4 * lane + 256 * j);
                if (HAS_M) R.mw[p][j] = *(const uint2*)(m + (size_t)rr * DM + 4 * lane + 256 * j); } } } };
    auto rp_proc = [&](Raw& R, int r0) {
#pragma unroll
        for (int p = 0; p < RPW; ++p) { const int r = r0 + p * NGW; if (r < T) { f32x4 v[4];
#pragma unroll
            for (int j = 0; j < 4; ++j) v[j] = (XIN == 0) ? R.v[p][j] : UNPK(R.xw[p][j]);
            if (HAS_M) { f32x4 mv[4]; float ss = 0.f;
#pragma unroll
                for (int j = 0; j < 4; ++j) { mv[j] = UNPK(R.mw[p][j]); ss += (mv[j].x * mv[j].x + mv[j].y * mv[j].y) + (mv[j].z * mv[j].z + mv[j].w * mv[j].w); }
                const float r1 = 1.f / sqrtf(wave_sum(ss) * (1.f / DM) + 1e-6f);
#pragma unroll
                for (int j = 0; j < 4; ++j) v[j] = v[j] + mv[j] * r1 * gp[j]; }
            if (OUT == 1) {
#pragma unroll
                for (int j = 0; j < 4; ++j) *(f32x4*)(out32 + (size_t)r * DM + 4 * lane + 256 * j) = v[j];
            } else { float ss = 0.f;
#pragma unroll
                for (int j = 0; j < 4; ++j) { ss += (v[j].x * v[j].x + v[j].y * v[j].y) + (v[j].z * v[j].z + v[j].w * v[j].w);
                    uint2 w; w.x = pk2(v[j].x, v[j].y); w.y = pk2(v[j].z, v[j].w); *(uint2*)(xb_out + (size_t)r * DM + 4 * lane + 256 * j) = w; }
                const float r2 = 1.f / sqrtf(wave_sum(ss) * (1.f / DM) + 1e-6f);
                if (lane == 0) rs[r] = r2;
                if (HAS_LOGF) { float d[8];
#pragma unroll
                    for (int h = 0; h < 8; ++h) { typedef float f32x2_ __attribute__((ext_vector_type(2))); f32x2_ a2 = {0.f, 0.f};
#pragma unroll
                        for (int j = 0; j < 4; ++j) { const f32x4 w = *(const LAS f32x4*)(wfl + h * DM + 4 * lane + 256 * j);
                            a2 = __builtin_elementwise_fma((f32x2_){v[j].x, v[j].y}, (f32x2_){w.x, w.y}, a2); a2 = __builtin_elementwise_fma((f32x2_){v[j].z, v[j].w}, (f32x2_){w.z, w.w}, a2); }
                        d[h] = a2.x + a2.y; }
                    float e4[4], e2[2], e1;
#pragma unroll
                    for (int i = 0; i < 4; ++i) { const float keep = (lane & 4) ? d[4 + i] : d[i], send = (lane & 4) ? d[i] : d[4 + i]; e4[i] = keep + dpp_f<0x141>(send); }
#pragma unroll
                    for (int i = 0; i < 2; ++i) { const float keep = (lane & 2) ? e4[2 + i] : e4[i], send = (lane & 2) ? e4[i] : e4[2 + i]; e2[i] = keep + dpp_f<0x4E>(send); }
                    { const float keep = (lane & 1) ? e2[1] : e2[0], send = (lane & 1) ? e2[0] : e2[1]; e1 = keep + dpp_f<0xB1>(send); }
                    e1 += dpp_f<0x128>(e1);
                    e1 = xsum32(xsum16(e1));
                    if (lane < 8) { const float z = e1 * r2 + bfg[lane]; logf_out[(size_t)r * 8 + lane] = fminf(z, 0.f) - 0.6931471805599453f * __builtin_amdgcn_logf(1.f + __builtin_amdgcn_exp2f(-1.4426950408889634f * fabsf(z))); } } } } } };
    Raw A, B; const int step = RPW * NGW;
    rp_load(A, gw);
    for (int r0 = gw; r0 < T; r0 += 2 * step) {
        rp_load(B, r0 + step);
        rp_proc(A, r0);
        rp_load(A, r0 + 2 * step);
        rp_proc(B, r0 + step);
    }
#undef UNPK
}
struct AttSchedFox {
    int vcu;
    __device__ __forceinline__ bool get(int i, att::AItem& r) const { if (i >= 4) return false; const int p = vcu + 256 * (i >> 1), x = p & 7; r.bh = p >> 3; r.qb = (i & 1) ? x : 15 - x; r.slot = i >> 1; return true; }
};
struct AttSchedMoba {
    int vcu;
    __device__ __forceinline__ bool get(int i, att::AItem& r) const { if (i >= 2) return false; const int x = vcu & 7; r.bh = vcu >> 3; r.qb = (i & 1) ? x : 15 - x; r.slot = 0; return true; }
};

struct Args { const float* in[14]; float* out; unsigned char* ws; int ph_lo, ph_hi; };
constexpr int NPHASE = 17;
__global__ void __launch_bounds__(NWAVES * 64, 2) mega_fwd(Args args) {
    extern __shared__ __attribute__((aligned(16))) unsigned char lds[];
    LAS unsigned char* ldsA = (LAS unsigned char*)lds;
    volatile LAS unsigned* MISC = (volatile LAS unsigned*)(ldsA + MISC_OFF);
    const int tid = threadIdx.x, lane = tid & 63, wave = __builtin_amdgcn_readfirstlane(tid >> 6);
    const int G = gridDim.x, bx = blockIdx.x, vcu = (G % 8 == 0) ? (bx % 8) * (G / 8) + bx / 8 : bx;
    const int NGW = G * NWAVES;
    typedef const __attribute__((address_space(4))) Args* CArgsP;
    const CArgsP ap0 = (CArgsP)__builtin_amdgcn_kernarg_segment_ptr();
#define ARGP() ({ unsigned lo_ = (unsigned)(uintptr_t)ap0, hi_ = (unsigned)((uintptr_t)ap0 >> 32); asm volatile("" : "+s"(lo_), "+s"(hi_)); \
    (CArgsP)(((uintptr_t)(unsigned)__builtin_amdgcn_readfirstlane(hi_) << 32) | (unsigned)__builtin_amdgcn_readfirstlane(lo_)); })
#define a_ws ((unsigned char*)(GAS unsigned char*)(ARGP()->ws))
    unsigned* ctl = (unsigned*)(a_ws + WS_CTL);
    for (int u = tid; u < (LDS_BYTES - RING_BYTES) / 4; u += NWAVES * 64) ((LAS unsigned*)(ldsA + RING_BYTES))[u] = 0u;
    __syncthreads();
    XcdBarrier bar = xcd_barrier_post(ctl + CW_BAR, MISC + 8);
    cg::grid_group grid = cg::this_grid();
    const int lo = ap0->ph_lo, hi = ap0->ph_hi;
    if (hi < 0) grid.sync();
#ifndef PHMASK
#define PHMASK 0x1ffff
#endif
#define IN(k) (((PHMASK >> (k)) & 1) && lo <= (k) && (k) < hi)
#ifndef REPEAT_PH
#define REPEAT_PH -1
#endif
#ifndef REP_PART
#define REP_PART 0
#endif
#ifndef REPEAT_N
#define REPEAT_N 2
#endif
#define REP(k) for (int rep_ = 0; rep_ < (((k) == REPEAT_PH) ? REPEAT_N : 1); ++rep_)
#define STAGE_RS(S_) do { LAS float* rsl_ = (LAS float*)(ldsA + SCR_OFF); pg8::Unit u_; _Pragma("unroll 1") for (int i_ = 0; i_ < 15 && (S_).next(i_, u_); ++i_) { if (tid < 256) rsl_[i_ * 256 + tid] = RSV[u_.pm * 256 + tid]; } __syncthreads(); } while (0)
#define REPBAR() do { if (rep_ > 0) xcd_barrier(bar); } while (0)
#define PHIDS() const int tid = ph_tid(), lane = tid & 63, wave = __builtin_amdgcn_readfirstlane(tid >> 6), gw = vcu * NWAVES + wave; (void)lane; (void)gw
#ifndef TSA
#define TSA TSK
#endif
#ifndef TSB
#define TSB (TSK + 1)
#endif
#ifndef TSQC
#define TSQC 100.f
#endif
#ifndef TSCYC
#define TSCYC 0
#endif
#ifndef TSCLK
#define TSCLK 0
#endif
#ifndef TSTHR
#define TSTHR 0.f
#endif
#ifndef TSQ
#define TSQ 10.f
#endif
#ifndef TSK
#define TSK -1
#endif
#define STAMP(i) do { if (TSK >= 0 && bx == 0 && tid == 0) { const unsigned long long t_ = __builtin_amdgcn_s_memrealtime(); MISC[32 + 2 * (i)] = (unsigned)t_; MISC[33 + 2 * (i)] = (unsigned)(t_ >> 32); const unsigned long long c_ = __builtin_amdgcn_s_memtime(); MISC[80 + 2 * (i)] = (unsigned)c_; MISC[81 + 2 * (i)] = (unsigned)(c_ >> 32); } } while (0)
#define SEAM(k) do { if (IN(k) && IN((k) + 1)) { xcd_barrier(bar); } STAMP((k) + 1); } while (0)
#define a_x      ((const float*)(const GAS float*)(ARGP()->in[0]))
#define a_relb   ((const float*)(const GAS float*)(ARGP()->in[1]))
#define a_nmpre  ((const float*)(const GAS float*)(ARGP()->in[2]))
#define a_nmpost ((const float*)(const GAS float*)(ARGP()->in[3]))
#define a_nfpre  ((const float*)(const GAS float*)(ARGP()->in[4]))
#define a_nfpost ((const float*)(const GAS float*)(ARGP()->in[5]))
#define a_ewin   ((const float*)(const GAS float*)(ARGP()->in[6]))
#define a_egn    ((const float*)(const GAS float*)(ARGP()->in[7]))
#define a_ewout  ((const float*)(const GAS float*)(ARGP()->in[8]))
#define a_owin   ((const float*)(const GAS float*)(ARGP()->in[9]))
#define a_obf    ((const float*)(const GAS float*)(ARGP()->in[10]))
#define a_owout  ((const float*)(const GAS float*)(ARGP()->in[11]))
#define a_fwin   ((const float*)(const GAS float*)(ARGP()->in[12]))
#define a_fwout  ((const float*)(const GAS float*)(ARGP()->in[13]))
#define a_out    ((float*)(GAS float*)(ARGP()->out))
#define COS   ((float*)(a_ws + WS_COS))
#define SIN   ((float*)(a_ws + WS_SIN))
#define WFL   ((float*)(a_ws + WS_WFL))
#define KMEAN ((float*)(a_ws + WS_KMEAN))
#define SEL   ((unsigned*)(a_ws + WS_SEL))
#define LOGF  ((float*)(a_ws + WS_LOGF))
#define FCUM  ((float*)(a_ws + WS_FCUM))
#define WP0   ((bf16r*)(a_ws + WS_WP0))
#define WO0   ((bf16r*)(a_ws + WS_WO0))
#define WFI0  ((bf16r*)(a_ws + WS_WFI0))
#define WFO0  ((bf16r*)(a_ws + WS_WFO0))
#define WP1   ((bf16r*)(a_ws + WS_WP1))
#define WO1   ((bf16r*)(a_ws + WS_WO1))
#define WFI1  ((bf16r*)(a_ws + WS_WFI1))
#define WFO1  ((bf16r*)(a_ws + WS_WFO1))
#define HN    ((bf16r*)(a_ws + WS_A))
#define RSV   ((float*)(a_ws + WS_RS))
#define KVT   ((bf16r*)(a_ws + WS_A))
#define PB    ((bf16r*)(a_ws + WS_B))
    constexpr size_t A32 = (size_t)T * 512;
#define RQ (PB)
#define RK (PB + A32)
#define RV (PB + 2 * A32)
#define RG (PB + 3 * A32)
#define MQ (PB + 4 * A32)
#define MK (PB + 5 * A32)
#define MV (PB + 6 * A32)
#define HB (PB)
#define FQ (PB)
#define FK (PB + 2 * A32)
#define FV (PB + 4 * A32)
#define CAT ((bf16r*)(a_ws + WS_C))
#define MB  ((bf16r*)(a_ws + WS_D))
#define STB ((bf16r*)(a_ws + WS_D))
    STAMP(0);
    if (IN(0)) REP(0) { REPBAR(); PHIDS();
        LAS float* scr = (LAS float*)(ldsA + wave * 16384);
        constexpr int I_P0 = 16 * 112, I_O = 16 * 32, I_FI = 16 * 176, I_FO = 44 * 32, I_P1 = 16 * 96;
        constexpr int NITEMS = I_P0 + 2 * I_O + 2 * I_FI + 2 * I_FO + I_P1;
        auto decode = [&](int it, TItem& t) { int r = it; const float* W; bf16r* WT; const float* gk = nullptr; int K = DM, N, ldw, map = 0;
            if (r < I_P0) { W = a_ewin; WT = WP0; N = 3584; ldw = 3584; map = 1; gk = a_nmpre; }
            else if ((r -= I_P0) < I_O) { W = a_ewout; WT = WO0; N = DM; ldw = DM; }
            else if ((r -= I_O) < I_FI) { W = a_fwin; WT = WFI0; N = 2 * FFH; ldw = 2 * FFH; map = 2; gk = a_nfpre; }
            else if ((r -= I_FI) < I_FO) { W = a_fwout; WT = WFO0; K = FFH; N = DM; ldw = DM; }
            else if ((r -= I_FO) < I_P1) { W = a_owin; WT = WP1; N = 3072; ldw = 3080; gk = a_nmpre + DM; }
            else if ((r -= I_P1) < I_O) { W = a_owout; WT = WO1; N = DM; ldw = DM; }
            else if ((r -= I_O) < I_FI) { W = a_fwin + (size_t)DM * 2 * FFH; WT = WFI1; N = 2 * FFH; ldw = 2 * FFH; map = 2; gk = a_nfpre + DM; }
            else { r -= I_FI; W = a_fwout + (size_t)FFH * DM; WT = WFO1; K = FFH; N = DM; ldw = DM; }
            const int nblk = N / 32; t.W = W; t.WT = WT; t.gk = gk; t.K = K; t.ldw = ldw; t.map = map; t.k0 = 64 * (r / nblk); t.n0 = 32 * (r % nblk); };
        { TItem cur, nxt; float ra[32], rb[32], ga[32], gb[32];
          if (gw < NITEMS) { decode(gw, cur); titem_load(cur, ra, ga, lane); }
          for (int it = gw; it < NITEMS; it += 2 * NGW) {
              const bool h1 = it + NGW < NITEMS, h2 = it + 2 * NGW < NITEMS;
              if (h1) { decode(it + NGW, nxt); titem_load(nxt, rb, gb, lane); }
              titem_store(cur, ra, ga, scr, lane);
              if (h1) { if (h2) { decode(it + 2 * NGW, cur); titem_load(cur, ra, ga, lane); } titem_store(nxt, rb, gb, scr, lane); } } }
        for (int i = bx * 512 + tid; i < 8 * DM; i += G * 512) { const int h = i >> 10, k = i & 1023; WFL[i] = a_owin[(size_t)k * 3080 + 3072 + h] * (a_nmpre + DM)[k]; }
        row_pass<0, false, 0, false>(gw, NGW, lane, a_x, nullptr, nullptr, nullptr, HN, RSV, nullptr, nullptr, nullptr, nullptr);
    }
    SEAM(0);
    if (IN(1)) REP(1) { REPBAR(); PHIDS();
        pg8::Gemm g{HN, WP0, T, 3584, DM}; pg8::StaticOrder S; S.init(T, 3584, G, bx);
        pg8::EpiHeads<4, true, 3> E{PB, A32, COS, SIN, 0.08838834764831845f, RSV, nullptr};
        pg8::gemm_phase<pg8::EpiHeads<4, true, 3>, pg8::StaticOrder, true, true>(ldsA, g, S, E);
    }
    SEAM(1);
    if (IN(2)) REP(2) { REPBAR(); PHIDS();
        { ret::KVStage kst; if (vcu < 1024) ret::kv_load(kst, (const att::bf16*)(RK + (size_t)vcu * 16384), (const att::bf16*)(RV + (size_t)vcu * 16384));
          for (int c = vcu; c < 1024; c += G) { const int bh = c >> 5, cn = c + G; const bool hn = cn < 1024; const size_t on = (size_t)(hn ? cn : c) * 16384;
            ret::kv_task((char*)lds, kst, (const att::bf16*)(RK + on), (const att::bf16*)(RV + on), hn, (att::bf16*)(KVT + (size_t)c * 16384), bh & 3); } }
        LAS float* red = (LAS float*)(ldsA + SCR_OFF);
        for (int u = vcu; u < 512; u += G) {
            const int d = tid & 127, part = tid >> 7; const bf16r* kp = MK + ((size_t)u * 256 + part * 64) * 128 + d; float s = 0.f;
            { float s4[4] = {0.f, 0.f, 0.f, 0.f};
#pragma unroll 4
              for (int i = 0; i < 64; i += 4) {
#pragma unroll
                  for (int j = 0; j < 4; ++j) s4[j] += __uint_as_float((unsigned)kp[(size_t)(i + j) * 128] << 16); }
              s = (s4[0] + s4[1]) + (s4[2] + s4[3]); }
            red[tid] = s; __syncthreads();
            if (tid < 128) KMEAN[(size_t)u * 128 + tid] = ((red[tid] + red[tid + 128]) + (red[tid + 256] + red[tid + 384])) * (1.f / 256.f);
            __syncthreads(); }
    }
    SEAM(2);
    if (IN(3)) REP(3) { REPBAR(); PHIDS();
        for (int gid = bx * 512 + tid; gid < 32 * 4096; gid += G * 512) { const int bh = gid >> 12, e4 = gid & 4095;
            const float cd = __builtin_amdgcn_exp2f(ret::l2g_of(bh & 3) * 128.f); f32x4 s = {0.f, 0.f, 0.f, 0.f};
            typedef unsigned u32x2_ __attribute__((ext_vector_type(2)));
            const u32x2_* kv = (const u32x2_*)KVT + (size_t)bh * 32 * 4096 + e4; uint2* st = (uint2*)STB + (size_t)bh * 32 * 4096 + e4;
            u32x2_ k[32];
#pragma unroll
            for (int i = 0; i < 32; ++i) k[i] = __builtin_nontemporal_load(kv + (size_t)i * 4096);
#pragma unroll
            for (int i = 0; i < 32; ++i) { uint2 w; w.x = pk2(s.x, s.y); w.y = pk2(s.z, s.w); st[(size_t)i * 4096] = w;
                s = s * cd + (f32x4){__uint_as_float(k[i].x << 16), __uint_as_float(k[i].x & 0xffff0000u), __uint_as_float(k[i].y << 16), __uint_as_float(k[i].y & 0xffff0000u)}; } }
        STAMP(19);
        for (int g0 = bx * 512; g0 < 32 * 4096; g0 += G * 512) { const int bh = g0 >> 12, s0 = g0 & 4095;
            typedef short bf16x8v __attribute__((ext_vector_type(8)));
            LAS float* gl = (LAS float*)ldsA + wave * 64 * 16;
            const int nn = lane & 15, kg = lane >> 4; bf16x8v bhi[4], blo[4];
            const float* kmp = KMEAN + ((size_t)bh * 16 + nn) * 128 + 8 * kg;
#pragma unroll
            for (int ks = 0; ks < 4; ++ks) { const f32x4 a = *(const f32x4*)(kmp + 32 * ks), b = *(const f32x4*)(kmp + 32 * ks + 4); const float v[8] = {a.x, a.y, a.z, a.w, b.x, b.y, b.z, b.w};
                unsigned hw[4], lw[4];
#pragma unroll
                for (int e = 0; e < 4; ++e) { const unsigned h2 = pk2(v[2 * e], v[2 * e + 1]); hw[e] = h2; lw[e] = pk2(v[2 * e] - __uint_as_float(h2 << 16), v[2 * e + 1] - __uint_as_float(h2 & 0xffff0000u)); }
                bhi[ks] = __builtin_bit_cast(bf16x8v, (v4u){hw[0], hw[1], hw[2], hw[3]}); blo[ks] = __builtin_bit_cast(bf16x8v, (v4u){lw[0], lw[1], lw[2], lw[3]}); }
#pragma unroll
            for (int g = 0; g < 4; ++g) { const bf16r* qp = MQ + ((size_t)bh * SEQ + s0 + wave * 64 + g * 16 + nn) * 128 + 8 * kg; f32x4 acc = {0.f, 0.f, 0.f, 0.f};
#pragma unroll
                for (int ks = 0; ks < 4; ++ks) { const bf16x8v a = *(const bf16x8v*)(qp + 32 * ks);
                    acc = __builtin_amdgcn_mfma_f32_16x16x32_bf16(a, bhi[ks], acc, 0, 0, 0); acc = __builtin_amdgcn_mfma_f32_16x16x32_bf16(a, blo[ks], acc, 0, 0, 0); }
#pragma unroll
                for (int r = 0; r < 4; ++r) gl[(g * 16 + 4 * kg + r) * 16 + nn] = acc[r]; }
            LDS_WAIT(); asm volatile("" ::: "memory");
            const int s = s0 + wave * 64 + lane, own = s >> 8; float gt[16];
#pragma unroll
            for (int c = 0; c < 4; ++c) { const f32x4 t4 = *(const LAS f32x4*)(gl + lane * 16 + 4 * c); gt[4 * c] = t4.x; gt[4 * c + 1] = t4.y; gt[4 * c + 2] = t4.z; gt[4 * c + 3] = t4.w; }
            float v1 = 0.f, v2 = 0.f, v3 = 0.f; int i1 = -1, i2 = -1, i3 = -1;
#pragma unroll
            for (int n = 0; n < 15; ++n) { const float d = gt[n]; if (n < own) {
                if (i1 < 0 || d > v1) { v3 = v2; i3 = i2; v2 = v1; i2 = i1; v1 = d; i1 = n; }
                else if (i2 < 0 || d > v2) { v3 = v2; i3 = i2; v2 = d; i2 = n; }
                else if (i3 < 0 || d > v3) { v3 = d; i3 = n; } } }
            unsigned msk = 0; if (i1 >= 0) msk |= 1u << i1; if (i2 >= 0) msk |= 1u << i2; if (i3 >= 0) msk |= 1u << i3;
            SEL[(size_t)bh * SEQ + s] = msk;
            LDS_WAIT(); asm volatile("" ::: "memory"); }
    }
    SEAM(3);
    if (IN(4)) REP(4) { REPBAR(); PHIDS();
        if (!(rep_ > 0 && REP_PART == 2)) for (int u = vcu; u < 512; u += G) { const int bh = u >> 4, cp = u & 15, b = bh >> 2, h = bh & 3; const size_t hb = ((size_t)bh * SEQ + cp * 256) * 128, tb = (size_t)b * SEQ + cp * 256;
            ret::out_task((char*)lds, (const att::bf16*)(RQ + hb), (const att::bf16*)(RK + hb), (const att::bf16*)(RV + hb), (const att::bf16*)(STB + ((size_t)bh * 32 + cp * 2) * 16384),
                          (const att::bf16*)(RG + tb * 512 + h * 128), a_egn + h * 128, (att::bf16*)(CAT + tb * DM + h * 128), h); }
        { LAS float* lut = (LAS float*)(ldsA + att::OFF_LUT); const float* rb = a_relb;
          STAMP(18);
          for (int i = tid; i < att::LUT_FLOATS; i += 512) { const int h = i >> 9, rel = (i & 511) - 256; lut[i] = (i >= 2048) ? 0.f : (rb[t5_bucket(rel) * 4 + (h & 3)] - rb[31 * 4 + (h & 3)]) * att::INV_SCALE; }
          __syncthreads(); }
        if (!(rep_ > 0 && REP_PART == 1)) { AttSchedMoba sch{vcu}; const att::ABase AB{(const att::bf16*)MQ, (const att::bf16*)MK, (const att::bf16*)MV, (att::bf16*)CAT, nullptr, SEL, 4, 512};
        att::attn_phase<1, AttSchedMoba>((char*)lds, AB, sch); }
    }
    SEAM(4);
    if (IN(5)) REP(5) { REPBAR(); PHIDS(); pg8::Gemm g{CAT, WO0, T, DM, DM}; pg8::StaticOrder S; S.init(T, DM, G, bx); pg8::EpiPlain E{MB, DM};
        pg8::gemm_phase<pg8::EpiPlain, pg8::StaticOrder, PLAIN_ALIGN, PLAIN_SP2>(ldsA, g, S, E); }
    SEAM(5);
    if (IN(6)) REP(6) { REPBAR(); PHIDS(); row_pass<0, true, 0, false>(gw, NGW, lane, a_x, nullptr, MB, a_nmpost, HN, RSV, nullptr, nullptr, nullptr, nullptr); }
    SEAM(6);
    if (IN(7)) REP(7) { REPBAR(); PHIDS(); pg8::Gemm g{HN, WFI0, T, 2 * FFH, DM}; pg8::StaticOrder S; S.init(T, 2 * FFH, G, bx); pg8::EpiSwiglu E{HB, FFH, RSV};
        pg8::gemm_phase<pg8::EpiSwiglu, pg8::StaticOrder, true, true>(ldsA, g, S, E); }
    SEAM(7);
    if (IN(8)) REP(8) { REPBAR(); PHIDS(); pg8::Gemm g{HB, WFO0, T, DM, FFH}; pg8::StaticOrder S; S.init(T, DM, G, bx); pg8::EpiPlain E{MB, DM};
        pg8::gemm_phase<pg8::EpiPlain, pg8::StaticOrder, PLAIN_ALIGN, PLAIN_SP2>(ldsA, g, S, E); }
    SEAM(8);
    if (IN(9)) { PHIDS();
        LAS float* wfl = (LAS float*)ldsA;
        for (int i = tid; i < 8 * DM; i += 512) wfl[i] = WFL[i];
        __syncthreads();
        row_pass<1, true, 0, true>(gw, NGW, lane, nullptr, HN, MB, a_nfpost, HN, RSV, nullptr, wfl, a_obf, LOGF);
        __syncthreads();
    }
    SEAM(9);
    if (IN(10)) REP(10) { REPBAR(); PHIDS();
        for (int bh = vcu; bh < 64; bh += G) { LAS float* sc = (LAS float*)(ldsA + SCR_OFF); const int b = bh >> 3, h = bh & 7; float v[8], run = 0.f;
#pragma unroll
            for (int i = 0; i < 8; ++i) { run += LOGF[((size_t)b * SEQ + tid * 8 + i) * 8 + h]; v[i] = run; }
            sc[tid] = run; __syncthreads();
            for (int o = 1; o < 512; o <<= 1) { const float a = (tid >= o) ? sc[tid - o] : 0.f; __syncthreads(); sc[tid] += a; __syncthreads(); }
            const float base = (tid > 0) ? sc[tid - 1] : 0.f;
#pragma unroll
            for (int i = 0; i < 8; ++i) FCUM[(size_t)bh * SEQ + tid * 8 + i] = -(base + v[i]) * att::INV_SCALE;
            __syncthreads(); }
        pg8::Gemm g{HN, WP1, T, 3072, DM}; pg8::StaticOrder S; S.init(T, 3072, G, bx);
        pg8::EpiHeads<8, false, -1, true> E{PB, 2 * A32, nullptr, nullptr, 1.f, RSV, ctl + CW_KM};
        pg8::gemm_phase<pg8::EpiHeads<8, false, -1, true>, pg8::StaticOrder, true, true>(ldsA, g, S, E);
    }
    SEAM(10);
    if (IN(11)) REP(11) { REPBAR(); PHIDS();
        if (tid < 2) { const int bh = (vcu + 256 * tid) >> 3; float k2 = 0.f;
            for (int w = 0; w < 4; ++w) k2 += __uint_as_float(__hip_atomic_load(ctl + CW_KM + bh * 4 + w, __ATOMIC_RELAXED, __HIP_MEMORY_SCOPE_AGENT));
            ((LAS float*)(ldsA + att::OFF_KM))[tid] = k2; }
        __syncthreads();
        STAMP(20);
        AttSchedFox sch{vcu}; const att::ABase AB{(const att::bf16*)FQ, (const att::bf16*)FK, (const att::bf16*)FV, (att::bf16*)CAT, FCUM, nullptr, 8, 0};
        att::attn_phase<0, AttSchedFox>((char*)lds, AB, sch); }
    SEAM(11);
    if (IN(12)) REP(12) { REPBAR(); PHIDS(); pg8::Gemm g{CAT, WO1, T, DM, DM}; pg8::StaticOrder S; S.init(T, DM, G, bx); pg8::EpiPlain E{MB, DM};
        pg8::gemm_phase<pg8::EpiPlain, pg8::StaticOrder, PLAIN_ALIGN, PLAIN_SP2>(ldsA, g, S, E); }
    SEAM(12);
    if (IN(13)) { PHIDS(); row_pass<1, true, 0, false>(gw, NGW, lane, nullptr, HN, MB, a_nmpost + DM, HN, RSV, nullptr, nullptr, nullptr, nullptr); }
    SEAM(13);
    if (IN(14)) REP(14) { REPBAR(); PHIDS(); pg8::Gemm g{HN, WFI1, T, 2 * FFH, DM}; pg8::StaticOrder S; S.init(T, 2 * FFH, G, bx); pg8::EpiSwiglu E{HB, FFH, RSV};
        pg8::gemm_phase<pg8::EpiSwiglu, pg8::StaticOrder, true, true>(ldsA, g, S, E); }
    SEAM(14);
    if (IN(15)) REP(15) { REPBAR(); PHIDS(); pg8::Gemm g{HB, WFO1, T, DM, FFH}; pg8::StaticOrder S; S.init(T, DM, G, bx); pg8::EpiPlain E{MB, DM};
        pg8::gemm_phase<pg8::EpiPlain, pg8::StaticOrder, PLAIN_ALIGN, PLAIN_SP2>(ldsA, g, S, E); }
    SEAM(15);
    if (IN(16)) { PHIDS(); row_pass<1, true, 1, false>(gw, NGW, lane, nullptr, HN, MB, a_nfpost + DM, nullptr, nullptr, a_out, nullptr, nullptr, nullptr); }
    STAMP(17);
    if (TSK >= 0 && bx == 0) { __syncthreads(); if (tid == 0) { asm volatile("s_waitcnt vmcnt(0)" ::: "memory");
        const unsigned long long t1 = ((unsigned long long)MISC[33 + 2 * (TSB)] << 32) | MISC[32 + 2 * (TSB)], t0 = ((unsigned long long)MISC[33 + 2 * (TSA)] << 32) | MISC[32 + 2 * (TSA)];
        float us_ = (float)(t1 - t0) * 0.01f; us_ = us_ >= 100.f ? TSQ * rintf(us_ * (1.f / TSQ)) : rintf(us_);
        if (TSCLK) { const unsigned long long c1 = ((unsigned long long)MISC[81 + 2 * (TSB)] << 32) | MISC[80 + 2 * (TSB)], c0 = ((unsigned long long)MISC[81 + 2 * (TSA)] << 32) | MISC[80 + 2 * (TSA)];
            us_ = 100.f * rintf((float)(c1 - c0) / ((float)(t1 - t0) * 0.01f) * 0.01f); }
        if (TSCYC) { const float cy_ = (float)(t1 - t0); us_ = cy_ >= 1000.f ? TSQC * rintf(cy_ * (1.f / TSQC)) : (cy_ >= 100.f ? 10.f * rintf(cy_ * 0.1f) : cy_); }
        if (TSTHR > 0.f) us_ = ((float)(t1 - t0) * 0.01f > TSTHR) ? 1000.f : 500.f;
        a_out[0] = us_; } }
#undef IN
#undef SEAM
}

#ifndef N_LAUNCH_SPLIT
#define N_LAUNCH_SPLIT 0
#endif
extern "C" void kernel_launch(void* const* d_in, const int* in_sizes, int n_in, void* d_out, int out_size, void* d_ws, size_t ws_size, hipStream_t stream) {
    static int grid = 0;
    if (grid == 0) {
        if (n_in != 14 || in_sizes[0] != T * DM || out_size != T * DM || ws_size < WS_END) { fprintf(stderr, "kernel_launch: unexpected shapes (n_in %d in0 %d out %d ws %zu)\n", n_in, n_in > 0 ? in_sizes[0] : -1, out_size, ws_size); grid = -1; return; }
        int dev = 0, cus = 0, per_cu = 0;
        if (hipGetDevice(&dev) != hipSuccess || hipDeviceGetAttribute(&cus, hipDeviceAttributeMultiprocessorCount, dev) != hipSuccess) { grid = -1; return; }
        if (hipFuncSetAttribute((const void*)mega_fwd, hipFuncAttributeMaxDynamicSharedMemorySize, LDS_BYTES) != hipSuccess) { fprintf(stderr, "kernel_launch: hipFuncSetAttribute failed\n"); grid = -1; return; }
        if (hipOccupancyMaxActiveBlocksPerMultiprocessor(&per_cu, (const void*)mega_fwd, NWAVES * 64, LDS_BYTES) != hipSuccess || per_cu < 1) { fprintf(stderr, "kernel_launch: occupancy query says %d\n", per_cu); (void)hipGetLastError(); grid = -1; return; }
        grid = cus;
        if (grid != 256) fprintf(stderr, "kernel_launch: note: %d CUs (tuned for 256)\n", grid);
    }
    if (grid < 0) return;
    if (hipMemsetAsync((char*)d_ws + WS_CTL, 0, CTL_ZERO_BYTES, stream) != hipSuccess) return;
    Args a{};
    for (int i = 0; i < 14; ++i) a.in[i] = (const float*)d_in[i];
    a.out = (float*)d_out; a.ws = (unsigned char*)d_ws;
#if N_LAUNCH_SPLIT
    for (int p = 0; p < NPHASE; ++p) { a.ph_lo = p; a.ph_hi = p + 1; hipLaunchKernelGGL(mega_fwd, dim3(grid), dim3(NWAVES * 64), LDS_BYTES, stream, a); }
#else
    a.ph_lo = 0; a.ph_hi = NPHASE;
    void* kargs[] = {&a};
    hipError_t e = hipLaunchCooperativeKernel((const void*)mega_fwd, dim3(grid), dim3(NWAVES * 64), kargs, LDS_BYTES, stream);
    if (e != hipSuccess) fprintf(stderr, "kernel_launch: cooperative launch failed: %s (grid %d)\n", hipGetErrorString(e), grid);
#endif
}
```

```cpp
#include <hip/hip_runtime.h>
#include <hip/hip_bf16.h>
#include <hip/hip_cooperative_groups.h>
#include <cstdio>
#include <cstdint>
namespace cg = cooperative_groups;
#define LAS __attribute__((address_space(3)))
#define GAS __attribute__((address_space(1)))
__device__ __forceinline__ int ph_tid() { int t = (int)threadIdx.x; asm volatile("" : "+v"(t)); return t; }
#define XB_TMO      128
#define XB_XCNT(j)  (256  + 64 * (j))
#define XB_XSUB(j)  (1280 + 64 * (j))
#define XB_XGEN(j)  (2304 + 64 * (j))
#define XB_TOP      3328
#define XB_TOPGEN   3392
#define XCD_BAR_WORDS 3456
#define XB_SPIN_CAP (1u << 18)
__device__ __forceinline__ unsigned xb_ld(unsigned* p)              { return __hip_atomic_load(p, __ATOMIC_RELAXED, __HIP_MEMORY_SCOPE_AGENT); }
__device__ __forceinline__ unsigned xb_add(unsigned* p, unsigned v) { return __hip_atomic_fetch_add(p, v, __ATOMIC_RELAXED, __HIP_MEMORY_SCOPE_AGENT); }
__device__ __forceinline__ unsigned xb_xcc_id() { return (unsigned)__builtin_amdgcn_s_getreg((3 << 11) | 20) & 0xFu; }
#define XB_SPIN(cond, bar) do { unsigned _sp = 0; while (cond) { __builtin_amdgcn_s_sleep(1); \
    if ((++_sp & 255u) == 0u) { if (xb_ld(&(bar)[XB_TMO])) break; if (_sp > XB_SPIN_CAP) { atomicAdd(&(bar)[XB_TMO], 1u); break; } } } } while (0)
struct XcdBarrier { unsigned* bar; unsigned x; volatile LAS unsigned* st; };
__device__ __forceinline__ XcdBarrier xcd_barrier_post(unsigned* bar, volatile LAS unsigned* st) {
    XcdBarrier b; b.bar = bar; b.x = xb_xcc_id(); b.st = st;
    if (threadIdx.x == 0) (void)xb_add(&bar[XB_XCNT(b.x)], 1u);
    return b;
}
__device__ __forceinline__ void xcd_barrier_complete(unsigned* bar, unsigned x, unsigned& nloc, unsigned& nx) {
    const unsigned G = gridDim.x * gridDim.y * gridDim.z;
    unsigned sum, cnt, mine, sp = 0u;
    for (;;) {
        sum = 0u; cnt = 0u; mine = 0u;
#pragma unroll
        for (unsigned j = 0; j < 16; ++j) { const unsigned c = xb_ld(&bar[XB_XCNT(j)]); sum += c; cnt += (c > 0u) ? 1u : 0u; mine = (j == x) ? c : mine; }
        if (sum == G) break;
        __builtin_amdgcn_s_sleep(1);
        if ((++sp & 255u) == 0u) { if (xb_ld(&bar[XB_TMO])) break; if (sp > XB_SPIN_CAP) { atomicAdd(&bar[XB_TMO], 1u); break; } }
    }
    nloc = mine > 0u ? mine : 1u; nx = cnt > 0u ? cnt : 1u;
}
#define XB_LSUB(j)  (32768 + 64 * (j))
#define XB_LGEN(j)  (34816 + 64 * (j))
__device__ __forceinline__ void xcd_local_barrier(const XcdBarrier& b) {
    asm volatile("s_waitcnt vmcnt(0)" ::: "memory");
    __syncthreads();
    if (threadIdx.x == 0) {
        unsigned* bar = b.bar;
        __builtin_amdgcn_s_waitcnt(0);
        const unsigned nloc = b.st[0];
        const unsigned old = xb_add(&bar[XB_LSUB(b.x)], 1u);
        const unsigned gen = old / nloc;
        if (old + 1u == (gen + 1u) * nloc) xb_add(&bar[XB_LGEN(b.x)], 1u);
        else XB_SPIN(xb_ld(&bar[XB_LGEN(b.x)]) == gen, bar);
        __builtin_amdgcn_fence(__ATOMIC_ACQUIRE, "agent");
        asm volatile("s_waitcnt vmcnt(0)" ::: "memory");
    }
    __syncthreads();
}
__device__ __forceinline__ void xcd_barrier(const XcdBarrier& b) {
    asm volatile("s_waitcnt vmcnt(0)" ::: "memory");
    __syncthreads();
    if (threadIdx.x == 0) {
        unsigned* bar = b.bar;
        __builtin_amdgcn_s_waitcnt(0);
        unsigned nloc = b.st[0], nx = b.st[1];
        if (nloc == 0u) { xcd_barrier_complete(bar, b.x, nloc, nx); b.st[0] = nloc; b.st[1] = nx; }
        const unsigned old = xb_add(&bar[XB_XSUB(b.x)], 1u);
        const unsigned gen = old / nloc;
        if (old + 1u == (gen + 1u) * nloc) {
            __builtin_amdgcn_fence(__ATOMIC_RELEASE, "agent");
            asm volatile("s_waitcnt vmcnt(0)" ::: "memory");
            const unsigned og = xb_add(&bar[XB_TOP], 1u);
            const unsigned tg = og / nx;
            if (og + 1u == (tg + 1u) * nx) xb_add(&bar[XB_TOPGEN], 1u);
            else XB_SPIN(xb_ld(&bar[XB_TOPGEN]) == tg, bar);
            __builtin_amdgcn_fence(__ATOMIC_ACQUIRE, "agent");
            xb_add(&bar[XB_XGEN(b.x)], 1u);
            asm volatile("s_waitcnt vmcnt(0)" ::: "memory");
        } else {
            XB_SPIN(xb_ld(&bar[XB_XGEN(b.x)]) == gen, bar);
            __builtin_amdgcn_fence(__ATOMIC_ACQUIRE, "agent");
            asm volatile("s_waitcnt vmcnt(0)" ::: "memory");
        }
    }
    __syncthreads();
}
#ifndef EPI_NOSTORE
#define EPI_NOSTORE 0
#endif
#ifndef PG8_WGM
#define PG8_WGM 8
#endif
namespace pg8 {
#define PG8_LAS __attribute__((address_space(3)))
typedef unsigned short bf16_t;
typedef short bf16x8 __attribute__((ext_vector_type(8)));
typedef float f32x4 __attribute__((ext_vector_type(4)));
typedef unsigned u32x4 __attribute__((ext_vector_type(4)));
constexpr int BM = 256, BK = 64, HALF = 128, HTB = HALF * BK * 2  , STAGE_BYTES = 8 * HTB, NXCD = 8, WGM = PG8_WGM;

__host__ __device__ __forceinline__ int lds_byte(int r, int c) { const int st = (r >> 4) * 2 + (c >> 5), rr = r & 15, cc = c & 31, ob = rr * 64 + cc * 2; return st * 1024 + (ob ^ (((ob >> 9) & 1) << 5)); }
__host__ __device__ __forceinline__ void stage_rc(int b, int& R, int& C) { const int st = b / 1024, sb = b % 1024, swz = sb ^ (((sb >> 9) & 1) << 5); R = (st >> 1) * 16 + swz / 64; C = (st & 1) * 32 + (swz % 64) / 2; }
__host__ __device__ __forceinline__ int perm32(int rho) { const int n = rho >> 4, i = rho & 15; return 8 * (i >> 2) + 4 * n + (i & 3); }

struct Unit { int pm, pn; };
struct Gemm { const bf16_t* A; const bf16_t* Bt; int M, N, K; };

struct StaticOrder {
    int nM, nN, nwg, G, c;
    __host__ __device__ __forceinline__ void init(int M, int N, int G_, int c_) { nM = M / BM; nN = N / BM; nwg = nM * nN; G = G_; c = c_; }
    __host__ __device__ __forceinline__ bool next(int i, Unit& u) const {
        const long L = (long)i * G + c; if (L >= nwg) return false;
        int wgid = (int)L; { const int q = nwg / NXCD, r = nwg % NXCD, xcd = wgid % NXCD, off = wgid / NXCD; wgid = (xcd < r ? xcd * (q + 1) : r * (q + 1) + (xcd - r) * q) + off; }
        const int nig = WGM * nN, gid = wgid / nig, fm = gid * WGM, gsz = (nM - fm) < WGM ? (nM - fm) : WGM;
        u.pm = fm + ((wgid % nig) % gsz); u.pn = (wgid % nig) / gsz; return true;
    }
    __device__ __forceinline__ void a_ready(const Unit&) const {}
    __device__ __forceinline__ void done(const Unit&) const {}
};

__device__ __forceinline__ unsigned cvt_pk_bf16(float lo, float hi) { unsigned r; asm volatile("v_cvt_pk_bf16_f32 %0, %1, %2" : "=v"(r) : "v"(lo), "v"(hi)); return r; }
typedef float f32x2 __attribute__((ext_vector_type(2)));
__device__ __forceinline__ unsigned cvt_pk_bf16_c(float lo, float hi) { typedef __bf16 b2_ __attribute__((ext_vector_type(2))); const f32x2 v_ = {lo, hi}; return __builtin_bit_cast(unsigned, __builtin_convertvector(v_, b2_)); }
#ifndef EPI_WT
#define EPI_WT 0
#endif
__device__ __forceinline__ void st16(void* p, u32x4 v) {
    if (EPI_WT == 1) asm volatile("global_store_dwordx4 %0, %1, off sc1\n\ts_nop 1" :: "v"(p), "v"(v) : "memory");
    else if (EPI_WT == 2) __builtin_nontemporal_store(v, (u32x4*)p);
    else *(u32x4*)p = v;
}
struct EpiPlain {
    static constexpr bool PERM = true, AFTER_DRAIN = false;
    bf16_t* O; int ldc;
    __device__ __forceinline__ void operator()(const f32x4 (&acc)[2][2][4][2], const Unit& u, int wr, int wc, int fr, int fq, int ui) const {
        const int row0 = u.pm * BM + wr * 64 + fr, col0 = u.pn * BM + wc * 32 + 8 * fq;
#pragma unroll
        for (int ai = 0; ai < 2; ++ai)
#pragma unroll
            for (int m = 0; m < 4; ++m) { bf16_t* rowp = O + (size_t)(row0 + ai * HALF + m * 16) * ldc + col0;
#pragma unroll
                for (int bj = 0; bj < 2; ++bj) { const f32x4 v0 = acc[ai][bj][m][0], v1 = acc[ai][bj][m][1];
                    u32x4 w; w.x = cvt_pk_bf16_c(v0[0], v0[1]); w.y = cvt_pk_bf16_c(v0[2], v0[3]); w.z = cvt_pk_bf16_c(v1[0], v1[1]); w.w = cvt_pk_bf16_c(v1[2], v1[3]);
                    if (!EPI_NOSTORE || w.x == 0x12345678u) st16(rowp + bj * HALF, w); } }
    }
};
struct EpiSwiglu {
    static constexpr bool PERM = true, AFTER_DRAIN = false;
    bf16_t* H; int ldh; const float* rs;
    __device__ __forceinline__ void operator()(const f32x4 (&acc)[2][2][4][2], const Unit& u, int wr, int wc, int fr, int fq, int ui) const {
        const int row0 = u.pm * BM + wr * 64 + fr, col0 = u.pn * HALF + wc * 32 + 8 * fq;
        float rsv[2][4];
#pragma unroll
        for (int ai = 0; ai < 2; ++ai)
#pragma unroll
            for (int m = 0; m < 4; ++m) rsv[ai][m] = rs[row0 + ai * HALF + m * 16];
#pragma unroll
        for (int ai = 0; ai < 2; ++ai)
#pragma unroll
            for (int m = 0; m < 4; ++m) { bf16_t* rowp = H + (size_t)(row0 + ai * HALF + m * 16) * ldh + col0; float o[8]; const float rsc = rsv[ai][m];
#pragma unroll
                for (int n = 0; n < 2; ++n) {
                    const f32x4 g = acc[ai][0][m][n] * rsc, uu = acc[ai][1][m][n] * rsc, t = g * -1.4426950408889634f;
                    f32x4 e; e[0] = __builtin_amdgcn_exp2f(t[0]); e[1] = __builtin_amdgcn_exp2f(t[1]); e[2] = __builtin_amdgcn_exp2f(t[2]); e[3] = __builtin_amdgcn_exp2f(t[3]);
                    const f32x4 d = e + 1.0f; f32x4 r; r[0] = __builtin_amdgcn_rcpf(d[0]); r[1] = __builtin_amdgcn_rcpf(d[1]); r[2] = __builtin_amdgcn_rcpf(d[2]); r[3] = __builtin_amdgcn_rcpf(d[3]);
                    const f32x4 y = (g * r) * uu; o[n * 4] = y[0]; o[n * 4 + 1] = y[1]; o[n * 4 + 2] = y[2]; o[n * 4 + 3] = y[3]; }
                u32x4 w; w.x = cvt_pk_bf16_c(o[0], o[1]); w.y = cvt_pk_bf16_c(o[2], o[3]); w.z = cvt_pk_bf16_c(o[4], o[5]); w.w = cvt_pk_bf16_c(o[6], o[7]);
                if (!EPI_NOSTORE || w.x == 0x12345678u) st16(rowp, w); }
    }
};
template <int NH, bool ROT, int TOKA, bool KMAX = false> struct EpiHeads {
    static constexpr bool PERM = true, AFTER_DRAIN = false;
    static constexpr int TPA = NH / 2;
    bf16_t* base; size_t astride; const float* cs; const float* sn; float qscale; const float* rs;
    unsigned* km;
    __device__ __forceinline__ void operator()(const f32x4 (&acc)[2][2][4][2], const Unit& u, int wr, int wc, int fr, int fq, int ui) const {
        const int a = u.pn / TPA, hp = u.pn % TPA, b = u.pm >> 4, s0 = (u.pm & 15) * BM + wr * 64 + fr, d0 = wc * 32 + 8 * fq;
        bf16_t* ab = base + (size_t)a * astride;
        const bool rot = ROT && a < 2; const float sc = (ROT && a == 0) ? qscale : 1.f;
        float kmx[2] = {0.f, 0.f};
        float rsv[2][4];
#pragma unroll
        for (int ai = 0; ai < 2; ++ai)
#pragma unroll
            for (int m = 0; m < 4; ++m) rsv[ai][m] = rs[b * 4096 + s0 + ai * HALF + m * 16];
        float rfreq[4];
#pragma unroll
        for (int i = 0; i < 4; ++i) rfreq[i] = __builtin_amdgcn_exp2f(-(float)(2 * (4 * (4 * wc + fq) + i)) * (13.287712379549449f / 128.f)) * 0.15915494309189535f;
#pragma unroll
        for (int ai = 0; ai < 2; ++ai)
#pragma unroll
            for (int m = 0; m < 4; ++m) { const int s = s0 + ai * HALF + m * 16; const float rsc = rsv[ai][m];
                f32x4 c4 = {1.f, 1.f, 1.f, 1.f}, s4 = {0.f, 0.f, 0.f, 0.f};
                if (rot) {
#pragma unroll
                    for (int i = 0; i < 4; ++i) { const float fr_ = __builtin_amdgcn_fractf((float)s * rfreq[i]); c4[i] = __builtin_amdgcn_cosf(fr_); s4[i] = __builtin_amdgcn_sinf(fr_); } }
#pragma unroll
                for (int bj = 0; bj < 2; ++bj) { f32x4 v0 = acc[ai][bj][m][0] * rsc, v1 = acc[ai][bj][m][1] * rsc;
                    if (rot) { const f32x4 o1 = (v0 * c4 - v1 * s4) * sc, o2 = (v0 * s4 + v1 * c4) * sc; v0 = o1; v1 = o2; }
                    u32x4 w; w.x = cvt_pk_bf16_c(v0[0], v0[1]); w.y = cvt_pk_bf16_c(v0[2], v0[3]); w.z = cvt_pk_bf16_c(v1[0], v1[1]); w.w = cvt_pk_bf16_c(v1[2], v1[3]);
                    if (KMAX && a == 1) { float ss = (v0[0] * v0[0] + v0[1] * v0[1]) + (v0[2] * v0[2] + v0[3] * v0[3]) + (v1[0] * v1[0] + v1[1] * v1[1]) + (v1[2] * v1[2] + v1[3] * v1[3]);
                        ss += __shfl_xor(ss, 16); ss += __shfl_xor(ss, 32); kmx[bj] = fmaxf(kmx[bj], ss); }
                    const int head = 2 * hp + bj;
                    bf16_t* dst = (a == TOKA) ? ab + (size_t)(b * 4096 + s) * (NH * 128) + head * 128 + d0
                                              : ab + ((size_t)(b * NH + head) * 4096 + s) * 128 + d0;
                    st16(dst, w); } }
        if (KMAX && a == 1) {
#pragma unroll
            for (int bj = 0; bj < 2; ++bj) { float x = kmx[bj]; x = fmaxf(x, __shfl_xor(x, 1)); x = fmaxf(x, __shfl_xor(x, 2)); x = fmaxf(x, __shfl_xor(x, 4)); x = fmaxf(x, __shfl_xor(x, 8));
                if (fr == 0 && fq == 0) atomicMax(km + ((b * NH + 2 * hp + bj) * 4 + wc), __float_as_uint(x)); } }
    }
};
template <class Epi, class Sched, bool ALIGN_EPI = false, bool SP2 = false>
__device__ __forceinline__ void gemm_phase(PG8_LAS unsigned char* lds, const Gemm g, const Sched& S, const Epi& E) {
    const int tid = ph_tid(), wid = __builtin_amdgcn_readfirstlane(tid >> 6), lane = tid & 63, wr = wid >> 2, wc = wid & 3, fr = lane & 15, fq = lane >> 4;
    const int K = g.K, nt = K / BK;
    unsigned voffA[2], voffB[2];
#pragma unroll
    for (int i = 0; i < 2; ++i) { int R, C; stage_rc(tid * 16 + i * 8192, R, C); const int Rb = Epi::PERM ? ((R & ~31) + perm32(R & 31)) : R;
        voffA[i] = (unsigned)(R * K + C) * 2u; voffB[i] = (unsigned)(Rb * K + C) * 2u; }
    const size_t kstep = (size_t)(BK * 2);
    const size_t hstep = (size_t)HALF * K * 2;
    const size_t tstep = 2 * hstep;
    const unsigned ldsw = (unsigned)wid * 1024u;
    const int aoff = lds_byte(wr * 64 + fr, fq * 8), boff = lds_byte(wc * 32 + fr, fq * 8);
#define PG8_SA(b, h) (((b) * 2 + (h)) * HTB)
#define PG8_SB(b, h) ((4 + (b) * 2 + (h)) * HTB)
#define PG8_STAGE(bufoff, gbase, voff) do { _Pragma("unroll") for (int _i = 0; _i < 2; ++_i) \
        __builtin_amdgcn_global_load_lds((const unsigned*)((const char*)(gbase) + (voff)[_i]), (PG8_LAS unsigned*)(lds + (bufoff) + ldsw + _i * 8192), 16, 0, 0); } while (0)
#define PG8_LDA(dst, b, h) do { _Pragma("unroll") for (int m = 0; m < 4; ++m) _Pragma("unroll") for (int k = 0; k < 2; ++k) dst[m][k] = *(const PG8_LAS bf16x8*)(lds + PG8_SA(b, h) + aoff + m * 2048 + k * 1024); } while (0)
#define PG8_LDB(dst, b, h) do { _Pragma("unroll") for (int n = 0; n < 2; ++n) _Pragma("unroll") for (int k = 0; k < 2; ++k) dst[n][k] = *(const PG8_LAS bf16x8*)(lds + PG8_SB(b, h) + boff + n * 2048 + k * 1024); } while (0)
#define PG8_MMA(ai, bj, At, Bt) do { __builtin_amdgcn_s_setprio(1); _Pragma("unroll") for (int m = 0; m < 4; ++m) _Pragma("unroll") for (int n = 0; n < 2; ++n) _Pragma("unroll") for (int k = 0; k < 2; ++k) \
        acc[ai][bj][m][n] = __builtin_amdgcn_mfma_f32_16x16x32_bf16(Bt[n][k], At[m][k], acc[ai][bj][m][n], 0, 0, 0); __builtin_amdgcn_s_setprio(0); } while (0)
#define PG8_WAIT_V(n) asm volatile("s_waitcnt vmcnt(" #n ")" ::: "memory")
#define PG8_WAIT_L(n) asm volatile("s_waitcnt lgkmcnt(" #n ")" ::: "memory")
#define PG8_BAR __builtin_amdgcn_s_barrier()
#define PG8_SCHED __builtin_amdgcn_sched_barrier(0)
    Unit cur, nxt; int ui = 0;
    if (!S.next(0, cur)) return;
    f32x4 acc[2][2][4][2];
#pragma unroll
    for (int a = 0; a < 2; ++a)
#pragma unroll
        for (int b = 0; b < 2; ++b)
#pragma unroll
            for (int m = 0; m < 4; ++m)
#pragma unroll
                for (int n = 0; n < 2; ++n) acc[a][b][m][n] = (f32x4){0.f, 0.f, 0.f, 0.f};
    bf16x8 At[4][2], B0[2][2], B1[2][2];
    const char* cA = (const char*)g.A + (size_t)cur.pm * tstep; const char* cB = (const char*)g.Bt + (size_t)cur.pn * tstep;
    S.a_ready(cur);
    if constexpr (SP2) {
        PG8_STAGE(PG8_SB(0, 0), cB, voffB); PG8_STAGE(PG8_SB(0, 1), cB + hstep, voffB); PG8_STAGE(PG8_SA(0, 0), cA, voffA); PG8_STAGE(PG8_SA(0, 1), cA + hstep, voffA);
        if (wr == 1) PG8_BAR;
        PG8_WAIT_V(2); PG8_BAR;
        PG8_STAGE(PG8_SB(1, 0), cB + kstep, voffB); PG8_STAGE(PG8_SA(1, 0), cA + kstep, voffA); PG8_STAGE(PG8_SB(1, 1), cB + hstep + kstep, voffB);
        PG8_WAIT_V(6); PG8_BAR;
    } else {
        PG8_STAGE(PG8_SB(0, 0), cB, voffB); PG8_STAGE(PG8_SA(0, 0), cA, voffA); PG8_STAGE(PG8_SB(0, 1), cB + hstep, voffB); PG8_STAGE(PG8_SA(0, 1), cA + hstep, voffA);
        if (wr == 1) PG8_BAR;
        PG8_WAIT_V(4); PG8_BAR;
        PG8_STAGE(PG8_SB(1, 0), cB + kstep, voffB); PG8_STAGE(PG8_SA(1, 0), cA + kstep, voffA); PG8_STAGE(PG8_SB(1, 1), cB + hstep + kstep, voffB);
        PG8_WAIT_V(6); PG8_BAR;
    }
    for (;;) {
        const bool has_next = S.next(ui + 1, nxt);
        const char* nA = has_next ? (const char*)g.A + (size_t)nxt.pm * tstep : cA; const char* nB = has_next ? (const char*)g.Bt + (size_t)nxt.pn * tstep : cB;
        for (int t = 0; t < nt; t += 2) {
            const bool last = (t == nt - 2);
            const char* a1 = cA + (size_t)(t + 1) * kstep;
            const char* a2 = last ? nA : cA + (size_t)(t + 2) * kstep; const char* b2 = last ? nB : cB + (size_t)(t + 2) * kstep;
            const char* a3 = a2 + kstep; const char* b3 = b2 + kstep;
            if (last && has_next) S.a_ready(nxt);
            if constexpr (SP2) {
            PG8_LDB(B0, 0, 0); PG8_LDB(B1, 0, 1); PG8_SCHED; PG8_LDA(At, 0, 0); PG8_STAGE(PG8_SA(1, 1), a1 + hstep, voffA);
            PG8_WAIT_V(8); PG8_WAIT_L(0); PG8_BAR; PG8_MMA(0, 0, At, B0); PG8_MMA(0, 1, At, B1); PG8_BAR; PG8_SCHED;
            PG8_LDA(At, 0, 1); PG8_STAGE(PG8_SB(0, 0), b2, voffB); PG8_STAGE(PG8_SB(0, 1), b2 + hstep, voffB); PG8_STAGE(PG8_SA(0, 0), a2, voffA);
            PG8_WAIT_V(8); PG8_WAIT_L(0); PG8_BAR; PG8_MMA(1, 0, At, B0); PG8_MMA(1, 1, At, B1); PG8_BAR; PG8_SCHED;
            PG8_LDB(B0, 1, 0); PG8_LDB(B1, 1, 1); PG8_SCHED; PG8_LDA(At, 1, 0); PG8_STAGE(PG8_SA(0, 1), a2 + hstep, voffA);
            PG8_WAIT_V(8); PG8_WAIT_L(0); PG8_BAR; PG8_MMA(0, 0, At, B0); PG8_MMA(0, 1, At, B1); PG8_BAR; PG8_SCHED;
            PG8_LDA(At, 1, 1); PG8_STAGE(PG8_SB(1, 0), b3, voffB); PG8_STAGE(PG8_SB(1, 1), b3 + hstep, voffB); PG8_STAGE(PG8_SA(1, 0), a3, voffA);
            PG8_WAIT_V(8); PG8_WAIT_L(0); PG8_BAR; PG8_MMA(1, 0, At, B0); PG8_MMA(1, 1, At, B1); PG8_BAR; PG8_SCHED;
            } else {
            PG8_LDB(B0, 0, 0); PG8_SCHED; PG8_LDA(At, 0, 0); PG8_STAGE(PG8_SA(1, 1), a1 + hstep, voffA);
            PG8_WAIT_L(8); PG8_BAR; PG8_WAIT_L(0); PG8_MMA(0, 0, At, B0); PG8_BAR; PG8_SCHED;
            PG8_LDB(B1, 0, 1); PG8_STAGE(PG8_SB(0, 0), b2, voffB);
            PG8_BAR; PG8_WAIT_L(0); PG8_MMA(0, 1, At, B1); PG8_BAR;
            PG8_LDA(At, 0, 1); PG8_STAGE(PG8_SA(0, 0), a2, voffA);
            PG8_BAR; PG8_WAIT_L(0); PG8_MMA(1, 0, At, B0); PG8_BAR; PG8_SCHED;
            PG8_STAGE(PG8_SB(0, 1), b2 + hstep, voffB);
            PG8_WAIT_V(6); PG8_BAR; PG8_MMA(1, 1, At, B1); PG8_BAR;
            PG8_LDB(B0, 1, 0); PG8_SCHED; PG8_LDA(At, 1, 0); PG8_STAGE(PG8_SA(0, 1), a2 + hstep, voffA);
            PG8_WAIT_L(8); PG8_BAR; PG8_WAIT_L(0); PG8_MMA(0, 0, At, B0); PG8_BAR; PG8_SCHED;
            PG8_LDB(B1, 1, 1); PG8_STAGE(PG8_SB(1, 0), b3, voffB);
            PG8_BAR; PG8_WAIT_L(0); PG8_MMA(0, 1, At, B1); PG8_BAR;
            PG8_LDA(At, 1, 1); PG8_STAGE(PG8_SA(1, 0), a3, voffA);
            PG8_BAR; PG8_WAIT_L(0); PG8_MMA(1, 0, At, B0); PG8_BAR; PG8_SCHED;
            PG8_STAGE(PG8_SB(1, 1), b3 + hstep, voffB);
            PG8_WAIT_V(6); PG8_BAR; PG8_MMA(1, 1, At, B1); PG8_BAR;
            }
        }
        if constexpr (ALIGN_EPI) { if (wr == 0) PG8_BAR; }
        if constexpr (!Epi::AFTER_DRAIN) { E(acc, cur, wr, wc, fr, fq, ui); S.done(cur); }
        if (!has_next) break;
#pragma unroll
        for (int a = 0; a < 2; ++a)
#pragma unroll
            for (int b = 0; b < 2; ++b)
#pragma unroll
                for (int m = 0; m < 4; ++m)
#pragma unroll
                    for (int n = 0; n < 2; ++n) acc[a][b][m][n] = (f32x4){0.f, 0.f, 0.f, 0.f};
        cur = nxt; cA = nA; cB = nB; ++ui;
        if constexpr (ALIGN_EPI) { if (wr == 1) PG8_BAR; }
    }
    PG8_WAIT_V(0);
    if constexpr (!ALIGN_EPI) { if (wr == 0) PG8_BAR; }
    PG8_BAR;
    if constexpr (Epi::AFTER_DRAIN) { E.fused(acc, cur, wr, wc, fr, fq, lds, wid, lane); S.done(cur); }
#undef PG8_SA
#undef PG8_SB
#undef PG8_STAGE
#undef PG8_LDA
#undef PG8_LDB
#undef PG8_MMA
#undef PG8_WAIT_V
#undef PG8_WAIT_L
#undef PG8_BAR
#undef PG8_SCHED
}
}
#ifndef PV_BUILTIN
#define PV_BUILTIN 0
#endif
#ifndef PV_PIPE
#define PV_PIPE 1
#endif
namespace att {
#ifdef CSTAMP_ON
#define CS(i) do { if (MODE == 1 && blockIdx.x == 0 && tid == 0) { const unsigned long long c_ = __builtin_amdgcn_s_memtime(); volatile unsigned* M_ = (volatile unsigned*)(lds + 131072 + 320); M_[32 + 2 * (i)] = (unsigned)c_; M_[33 + 2 * (i)] = (unsigned)(c_ >> 32); } } while (0)
#else
#define CS(i) do {} while (0)
#endif
#ifndef ABL
#define ABL 0
#endif
#ifndef ORD_SPLIT
#ifndef ORD_SPLIT
#define ORD_SPLIT 0
#endif
#endif
#ifndef NO_QKT_SPLIT
#define QKT_SPLIT 1
#endif
#ifndef CINIT_TEST
#define CINIT_TEST 0
#endif
using bf16 = __hip_bfloat16;
typedef short bf16x8 __attribute__((ext_vector_type(8)));
typedef short s16x4 __attribute__((ext_vector_type(4)));
typedef float f32x16 __attribute__((ext_vector_type(16)));
typedef float f32x4 __attribute__((ext_vector_type(4)));
typedef unsigned u32x4 __attribute__((ext_vector_type(4)));
constexpr int D = 128, NW = 8, QBLK = 32, KVBLK = 64, QB = NW * QBLK, SEQ = 4096;
constexpr int SHM_V = KVBLK * D * 2, SHM_K = KVBLK * D * 2;
constexpr int OFF_WS = 2 * SHM_V + 2 * SHM_K;
constexpr int OFF_LUT = OFF_WS + NW * 64 * 4;
constexpr int LUT_FLOATS = 4 * 512 + 64;
constexpr int OFF_G = OFF_LUT + LUT_FLOATS * 4;
constexpr int OFF_QN = OFF_G + 2 * 64 * 4;
constexpr int OFF_KM = OFF_QN + 8 * 4;
constexpr int OFF_NXT = OFF_KM + 64 * 4;
constexpr int OFF_GL = OFF_NXT + 16;
constexpr int LDS_BYTES = OFF_GL + 64 * 4;
constexpr int OFF_OT = 90112, OT_STRIDE = 144, OT_BYTES = 32 * OT_STRIDE;
constexpr int OFF_ORD = 81920;
static_assert(LDS_BYTES + 16 <= OFF_ORD, "attention LDS map");
#ifndef PRUNE_TV
#define PRUNE_TV 24.f
#endif
#ifndef DYN_PRUNE
#define DYN_PRUNE 1
#endif
#ifndef O_STAGE
#define O_STAGE 1
#endif
#ifndef ATT_PRIO
#define ATT_PRIO 0
#endif
#ifndef WSKIP
#define WSKIP 1
#endif
#ifndef WAVE_PRUNE
#define WAVE_PRUNE 1
#endif
#ifndef WSKIP_Y
#define WSKIP_Y 1
#endif
#ifndef WSKIP_HEAD
#define WSKIP_HEAD 1
#endif
#ifndef WSKIP_TAIL
#define WSKIP_TAIL 1
#endif
constexpr float PRUNE_T = PRUNE_TV;
#ifndef SM_THR
#define SM_THR 8.f
#endif
constexpr float SCALE = 0.08838834764831845f, INV_SCALE = 11.313708498984761f, THR = SM_THR;
constexpr int OSTR = 1024;

#define KSWZ(row, colB) ((row) * 256 + ((colB) ^ (((row) & 7) << 4)))
#define SBAR() __builtin_amdgcn_sched_barrier(0)
__device__ __forceinline__ int v_st(int k, int c) { const int kk = (k & ~0xC) | ((k & 4) << 1) | ((k & 8) >> 1); return ((kk >> 3) * 4 + (c >> 5)) * 512 + ((kk & 7) * 32 + (c & 31)) * 2; }
__device__ __forceinline__ int v_rd_base(int lane) { return ((lane & 3) << 3) | (((lane >> 2) & 3) << 6) | (((lane >> 4) & 1) << 5) | (((lane >> 5) & 1) << 8); }
constexpr int v_rd_off(int d0, int ks, int half) { return d0 * 512 + ks * 4096 + half * 2048; }
__device__ __forceinline__ int crow(int r, int hi) { return (r & 3) + 8 * (r >> 2) + 4 * hi; }
__device__ __forceinline__ unsigned cvtpk(float lo, float hi) { typedef float f2_ __attribute__((ext_vector_type(2))); typedef __bf16 b2_ __attribute__((ext_vector_type(2))); const f2_ v_ = {lo, hi}; return __builtin_bit_cast(unsigned, __builtin_convertvector(v_, b2_)); }
__device__ __forceinline__ bf16x8 load8(const bf16* p) { return *reinterpret_cast<const bf16x8*>(p); }
__device__ __forceinline__ void mask_tile(f32x16& p0, f32x16& p1, int dq) {
    const float NEG = -__builtin_inff();
#pragma unroll
    for (int r = 0; r < 16; ++r) { const int c = (r & 3) + 8 * (r >> 2);
        if (dq - c < 0) p0[r] = NEG;
        if (dq - c - 32 < 0) p1[r] = NEG; }
}
__device__ __forceinline__ void partialSM(f32x16& p0, f32x16& p1, float& m_reg, float& mn, float& alpha, bool keep = true) {
    float pmax = fmaxf(p0[0], p0[1]);
#pragma unroll
    for (int r = 2; r < 16; r += 2) pmax = __builtin_fmaxf(__builtin_fmaxf(pmax, p0[r]), p0[r + 1]);
#pragma unroll
    for (int r = 0; r < 16; r += 2) pmax = __builtin_fmaxf(__builtin_fmaxf(pmax, p1[r]), p1[r + 1]);
    { auto rr = __builtin_amdgcn_permlane32_swap(__float_as_uint(pmax), __float_as_uint(pmax), false, false);
      pmax = fmaxf(__uint_as_float(rr[0]), __uint_as_float(rr[1])); }
    if (!keep) pmax = -__builtin_inff();
    constexpr float C2 = 1.4426950408889634f * SCALE;
    if (__builtin_expect(__all((pmax - m_reg) * SCALE <= THR), 1)) { mn = m_reg; alpha = 1.f; }
    else { mn = fmaxf(m_reg, pmax); alpha = __builtin_amdgcn_exp2f((m_reg - mn) * C2); m_reg = mn; }
    const float mnL = keep ? -mn * C2 : -__builtin_inff();
    { typedef float f32x2_ __attribute__((ext_vector_type(2))); const f32x2_ c2v = {C2, C2}, mlv = {mnL, mnL};
#pragma unroll
      for (int r = 0; r < 16; r += 2) { f32x2_ a = {p0[r], p0[r + 1]}, b = {p1[r], p1[r + 1]}; a = __builtin_elementwise_fma(a, c2v, mlv); b = __builtin_elementwise_fma(b, c2v, mlv);
          p0[r] = a.x; p0[r + 1] = a.y; p1[r] = b.x; p1[r + 1] = b.y; } }
    for (int r = 0; r < 16; ++r) p0[r] = (ABL == 1) ? fminf(fabsf(p0[r]) * 1e-30f, 1.f) + 0.01f : __builtin_amdgcn_exp2f(p0[r]);
}
#define ATT_PK4(P, B_, OUT) do { unsigned a0 = cvtpk(P[B_+0], P[B_+1]), a1 = cvtpk(P[B_+2], P[B_+3]);                          \
        unsigned b0 = cvtpk(P[B_+4], P[B_+5]), b1 = cvtpk(P[B_+6], P[B_+7]);                                             \
        auto r0 = __builtin_amdgcn_permlane32_swap(a0, b0, false, false); auto r1 = __builtin_amdgcn_permlane32_swap(a1, b1, false, false); \
        u32x4 w = {r0[0], r1[0], r0[1], r1[1]}; OUT = *reinterpret_cast<bf16x8*>(&w); } while (0)
__device__ __forceinline__ void finishSM(f32x16& p0, f32x16& p1, float alpha, float& l_reg, bf16x8& pa0, bf16x8& pa1, bf16x8& pa2, bf16x8& pa3) {
    for (int r = 0; r < 16; ++r) p1[r] = (ABL == 1) ? fminf(fabsf(p1[r]) * 1e-30f, 1.f) + 0.01f : __builtin_amdgcn_exp2f(p1[r]);
    float ps; { typedef float f32x2_ __attribute__((ext_vector_type(2))); f32x2_ s2 = {p0[0], p0[1]};
#pragma unroll
      for (int r = 2; r < 16; r += 2) s2 += (f32x2_){p0[r], p0[r + 1]};
#pragma unroll
      for (int r = 0; r < 16; r += 2) s2 += (f32x2_){p1[r], p1[r + 1]};
      ps = s2.x + s2.y; }
    { auto rr = __builtin_amdgcn_permlane32_swap(__float_as_uint(ps), __float_as_uint(ps), false, false);
      ps = __uint_as_float(rr[0]) + __uint_as_float(rr[1]); }
    l_reg = l_reg * alpha + ps;
    ATT_PK4(p0, 0, pa0); ATT_PK4(p0, 8, pa1); ATT_PK4(p1, 0, pa2); ATT_PK4(p1, 8, pa3);
}
template <bool ZERO = false>
__device__ __forceinline__ void qkt(f32x16& p0, f32x16& p1, const char* K_tile, int r32, int hi, const bf16x8* qr) {
    if (ZERO) { p0 = f32x16{}; p1 = f32x16{}; }
    if (ATT_PRIO) __builtin_amdgcn_s_setprio(1);
    const char* kb[4];
#pragma unroll
    for (int dd = 0; dd < 4; ++dd) kb[dd] = K_tile + KSWZ(r32, (dd * 16 + hi * 8) * 2);
#pragma unroll
    for (int d0 = 0; d0 < 8; ++d0) { const char* a = kb[d0 & 3] + (d0 >> 2) * 128;
        bf16x8 b0 = *reinterpret_cast<const bf16x8*>(a);
        bf16x8 b1 = *reinterpret_cast<const bf16x8*>(a + 32 * 256);
        if (ABL == 3 || ABL == 5) { asm volatile("" :: "v"(b0), "v"(b1), "v"(qr[d0])); } else {
        p0 = __builtin_amdgcn_mfma_f32_32x32x16_bf16(b0, qr[d0], p0, 0, 0, 0);
        p1 = __builtin_amdgcn_mfma_f32_32x32x16_bf16(b1, qr[d0], p1, 0, 0, 0); }
#ifdef QKT_SPLIT
        if (d0 == 3) SBAR();
#endif
    }
    if (ATT_PRIO) __builtin_amdgcn_s_setprio(0);
}
template <int VOFF>
__device__ __forceinline__ void pv_tile(f32x16* o, int vb0, bf16x8 pa0, bf16x8 pa1, bf16x8 pa2, bf16x8 pa3) {
#define TRRD(dst, off) asm volatile("ds_read_b64_tr_b16 %0, %1 offset:%2" : "=&v"(dst) : "v"(vb0), "i"(off) : "memory")
#define VFRAG(l, h) (bf16x8){l[0], l[1], l[2], l[3], h[0], h[1], h[2], h[3]}
#if PV_BUILTIN
    typedef short v4i16_t_ __attribute__((ext_vector_type(4)));
    const LAS char* vp_ = (const LAS char*)(unsigned)vb0;
#define VTR(off) __builtin_bit_cast(s16x4, __builtin_amdgcn_ds_read_tr16_b64_v4i16((LAS v4i16_t_*)(vp_ + (off))))
#pragma unroll
    for (int d0 = 0; d0 < 4; ++d0) { const int b_ = VOFF + v_rd_off(d0, 0, 0);
        const s16x4 l0 = VTR(b_), h0 = VTR(b_ + 2048), l1 = VTR(b_ + 4096), h1 = VTR(b_ + 6144), l2 = VTR(b_ + 8192), h2 = VTR(b_ + 10240), l3 = VTR(b_ + 12288), h3 = VTR(b_ + 14336);
        o[d0] = __builtin_amdgcn_mfma_f32_32x32x16_bf16(pa0, VFRAG(l0, h0), o[d0], 0, 0, 0);
        o[d0] = __builtin_amdgcn_mfma_f32_32x32x16_bf16(pa1, VFRAG(l1, h1), o[d0], 0, 0, 0);
        o[d0] = __builtin_amdgcn_mfma_f32_32x32x16_bf16(pa2, VFRAG(l2, h2), o[d0], 0, 0, 0);
        o[d0] = __builtin_amdgcn_mfma_f32_32x32x16_bf16(pa3, VFRAG(l3, h3), o[d0], 0, 0, 0);
        if (d0 == 1) SBAR(); }
#undef VTR
#elif PV_PIPE
    s16x4 l0, h0, l1, h1, l2, h2, l3, h3, n0, m0, n1, m1;
#define RD_A(L0, H0, L1, H1, d0) do { constexpr int b_ = VOFF + v_rd_off(d0, 0, 0); TRRD(L0, b_); TRRD(H0, b_ + 2048); TRRD(L1, b_ + 4096); TRRD(H1, b_ + 6144); } while (0)
#define RD_B(L2, H2, L3, H3, d0) do { constexpr int b_ = VOFF + v_rd_off(d0, 0, 0); TRRD(L2, b_ + 8192); TRRD(H2, b_ + 10240); TRRD(L3, b_ + 12288); TRRD(H3, b_ + 14336); } while (0)
#define WAITL(n) do { asm volatile("s_waitcnt lgkmcnt(" #n ")" ::: "memory"); SBAR(); } while (0)
    if (ATT_PRIO) __builtin_amdgcn_s_setprio(1);
    RD_A(l0, h0, l1, h1, 0); RD_B(l2, h2, l3, h3, 0);
    RD_A(n0, m0, n1, m1, 1); WAITL(4);
    o[0] = __builtin_amdgcn_mfma_f32_32x32x16_bf16(pa0, VFRAG(l0, h0), o[0], 0, 0, 0); o[0] = __builtin_amdgcn_mfma_f32_32x32x16_bf16(pa1, VFRAG(l1, h1), o[0], 0, 0, 0);
    o[0] = __builtin_amdgcn_mfma_f32_32x32x16_bf16(pa2, VFRAG(l2, h2), o[0], 0, 0, 0); o[0] = __builtin_amdgcn_mfma_f32_32x32x16_bf16(pa3, VFRAG(l3, h3), o[0], 0, 0, 0);
    SBAR(); RD_B(l2, h2, l3, h3, 1);
    RD_A(l0, h0, l1, h1, 2); WAITL(4);
    o[1] = __builtin_amdgcn_mfma_f32_32x32x16_bf16(pa0, VFRAG(n0, m0), o[1], 0, 0, 0); o[1] = __builtin_amdgcn_mfma_f32_32x32x16_bf16(pa1, VFRAG(n1, m1), o[1], 0, 0, 0);
    o[1] = __builtin_amdgcn_mfma_f32_32x32x16_bf16(pa2, VFRAG(l2, h2), o[1], 0, 0, 0); o[1] = __builtin_amdgcn_mfma_f32_32x32x16_bf16(pa3, VFRAG(l3, h3), o[1], 0, 0, 0);
    SBAR(); RD_B(l2, h2, l3, h3, 2);
    RD_A(n0, m0, n1, m1, 3); WAITL(4);
    o[2] = __builtin_amdgcn_mfma_f32_32x32x16_bf16(pa0, VFRAG(l0, h0), o[2], 0, 0, 0); o[2] = __builtin_amdgcn_mfma_f32_32x32x16_bf16(pa1, VFRAG(l1, h1), o[2], 0, 0, 0);
    o[2] = __builtin_amdgcn_mfma_f32_32x32x16_bf16(pa2, VFRAG(l2, h2), o[2], 0, 0, 0); o[2] = __builtin_amdgcn_mfma_f32_32x32x16_bf16(pa3, VFRAG(l3, h3), o[2], 0, 0, 0);
    SBAR(); RD_B(l2, h2, l3, h3, 3);
    WAITL(0);
    o[3] = __builtin_amdgcn_mfma_f32_32x32x16_bf16(pa0, VFRAG(n0, m0), o[3], 0, 0, 0); o[3] = __builtin_amdgcn_mfma_f32_32x32x16_bf16(pa1, VFRAG(n1, m1), o[3], 0, 0, 0);
    o[3] = __builtin_amdgcn_mfma_f32_32x32x16_bf16(pa2, VFRAG(l2, h2), o[3], 0, 0, 0); o[3] = __builtin_amdgcn_mfma_f32_32x32x16_bf16(pa3, VFRAG(l3, h3), o[3], 0, 0, 0);
    if (ATT_PRIO) __builtin_amdgcn_s_setprio(0);
#undef RD_A
#undef RD_B
#undef WAITL
#else
#define PV_D0(d0) do { s16x4 l0, l1, l2, l3, h0, h1, h2, h3; constexpr int b_ = VOFF + v_rd_off(d0, 0, 0); \
        TRRD(l0, b_); TRRD(h0, b_ + 2048); TRRD(l1, b_ + 4096); TRRD(h1, b_ + 6144); TRRD(l2, b_ + 8192); TRRD(h2, b_ + 10240); TRRD(l3, b_ + 12288); TRRD(h3, b_ + 14336); \
        asm volatile("s_waitcnt lgkmcnt(0)" ::: "memory"); SBAR();   \
        if (ABL == 2 || ABL == 5) { asm volatile("" :: "v"(l0), "v"(h0), "v"(l1), "v"(h1), "v"(l2), "v"(h2), "v"(l3), "v"(h3), "v"(pa0), "v"(pa1), "v"(pa2), "v"(pa3)); } else { \
        o[d0] = __builtin_amdgcn_mfma_f32_32x32x16_bf16(pa0, VFRAG(l0, h0), o[d0], 0, 0, 0);   \
        o[d0] = __builtin_amdgcn_mfma_f32_32x32x16_bf16(pa1, VFRAG(l1, h1), o[d0], 0, 0, 0);   \
        o[d0] = __builtin_amdgcn_mfma_f32_32x32x16_bf16(pa2, VFRAG(l2, h2), o[d0], 0, 0, 0);   \
        o[d0] = __builtin_amdgcn_mfma_f32_32x32x16_bf16(pa3, VFRAG(l3, h3), o[d0], 0, 0, 0); } } while (0)
    PV_D0(0); PV_D0(1); PV_D0(2); PV_D0(3);
#undef PV_D0
#endif
#undef VFRAG
#undef TRRD
}

struct ABase { const bf16* Q; const bf16* K; const bf16* V; bf16* O; const float* F; const unsigned* sel; int nh, ocol0; };
struct ADesc { __amdgpu_buffer_rsrc_t q, k, v, f; };
struct AItem { int bh, qb, slot; };
#define A_HB(it)  ((size_t)(it).bh * SEQ * D)
#define A_Q(it)   (B.Q + A_HB(it) + (size_t)(it).qb * QB * D)
#define A_K(it)   (B.K + A_HB(it))
#define A_V(it)   (B.V + A_HB(it))
#define A_F(it)   (B.F + (size_t)(it).bh * SEQ)
#define A_O(it)   (B.O + ((size_t)((it).bh / B.nh) * SEQ + (size_t)(it).qb * QB) * OSTR + B.ocol0 + ((it).bh % B.nh) * D)
#define A_SEL(it) (B.sel + (size_t)(it).bh * SEQ + (size_t)(it).qb * QB)
#define A_P0(it)  ((it).qb * QB)
struct Seam { bf16x8 qr[8]; bf16x8 st_v0, st_v1, st_k0, st_k1; float st_g; };
template <int MODE> __device__ __forceinline__ int first_kb(int P0) { return MODE == 0 ? P0 + QB - KVBLK : 0; }
#define VMW() asm volatile("s_waitcnt vmcnt(0)" ::: "memory")
#define VMWN(n) asm volatile("s_waitcnt vmcnt(%0)" :: "i"(n) : "memory")
#define BL16(rs, vo, so) __builtin_bit_cast(bf16x8, __builtin_amdgcn_raw_buffer_load_b128((rs), (int)(vo), (int)(so), 0))
#define SLOAD_H(it, k0) do { const unsigned so_ = (unsigned)(((it).bh * SEQ + (ABL == 4 ? 0 : (k0))) * D * 2);                                                  \
                         S.st_v0 = BL16(DS.v, loff, so_); S.st_v1 = BL16(DS.v, loff, so_ + 32 * D * 2);                                     \
                         S.st_k0 = BL16(DS.k, loff, so_); S.st_k1 = BL16(DS.k, loff, so_ + 32 * D * 2);                                     \
                         if (MODE == 0) S.st_g = __builtin_bit_cast(float, __builtin_amdgcn_raw_buffer_load_b32(DS.f, (int)((tid & 63u) * 4u), (int)(((it).bh * SEQ + (k0)) * 4), 0)); } while (0)
#define QLOAD(it) do { const unsigned so_ = (unsigned)((((it).bh * SEQ) + (it).qb * QB) * D * 2);                                              \
                         _Pragma("unroll") for (int d0 = 0; d0 < 8; ++d0) S.qr[d0] = BL16(DS.q, qoff + d0 * 32, so_); } while (0)
#define SWRITE_HK(bf) do { *(bf16x8*)(K_lds + (bf) * SHM_K + kws) = S.st_k0; *(bf16x8*)(K_lds + (bf) * SHM_K + kws + 32 * 256) = S.st_k1; \
                           if (MODE == 0 && tid < 64) ((float*)(lds + OFF_G))[(bf) * 64 + tid] = S.st_g; } while (0)
#define SWRITE_HV(bf) do { *(bf16x8*)(V_lds + (bf) * SHM_V + vst0) = S.st_v0; *(bf16x8*)(V_lds + (bf) * SHM_V + vst0 + 8192) = S.st_v1; } while (0)
#define SWRITE_H(bf) do { SWRITE_HV(bf); SWRITE_HK(bf); } while (0)
template <int MODE>
__device__ __forceinline__ void attn_prime(const ABase& B, const ADesc& DS, const AItem& cur, char* lds, Seam& S) {
    const int tid = ph_tid(), wid = __builtin_amdgcn_readfirstlane(tid >> 6), lane = tid & 63, r32 = lane & 31, hi = lane >> 5;
    const int sr = tid >> 4, sc = (tid & 15) * 8, kws = KSWZ(sr, sc * 2); char* K_lds = lds + 2 * SHM_V; const unsigned loff = (unsigned)(sr * D + sc) * 2u, qoff = (unsigned)((wid * QBLK + r32) * D + hi * 8) * 2u;
    const int kb0 = first_kb<MODE>(A_P0(cur));
    QLOAD(cur);
    SLOAD_H(cur, kb0); VMW(); SWRITE_HK(0);
    __syncthreads();
}
template <int MODE, class Sched>
__device__ __forceinline__ bool attn_block(const ABase& B, const ADesc& DS, const AItem& cur, AItem& nxt, char* lds, Seam& S, const Sched& sch, bool more) {
    const int tid = ph_tid(), wid = __builtin_amdgcn_readfirstlane(tid >> 6), lane = tid & 63, r32 = lane & 31, hi = lane >> 5;
    const int P0 = A_P0(cur), NT = (P0 + QB) / KVBLK;
    int NTW = 1 << 20;
    int NTE = NT;
    float g0 = 0.f, gl = 0.f;
    if (MODE == 0) { const float* Gh = A_F(cur); g0 = Gh[P0]; gl = Gh[((tid & 63) < NT ? (tid & 63) : NT - 1) * KVBLK + KVBLK - 1]; }
    int kbn = Sched::DYN ? 0 : first_kb<MODE>(A_P0(nxt));
    const int qlo = P0 + wid * QBLK, qm = qlo + r32 - 4 * hi;
    char* V_lds = lds; char* K_lds = lds + 2 * SHM_V;
    float* ws = (float*)(lds + OFF_WS) + wid * 64; float* li_l = ws, * al_l = ws + 32;
    float m_reg = -1e30f, l_reg = 0; f32x16 o[4] = {};
    const int sr = tid >> 4, sc = (tid & 15) * 8, vst0 = v_st(sr, sc)  , kws = KSWZ(sr, sc * 2);
    const unsigned loff = (unsigned)(sr * D + sc) * 2u;
    const int vb0 = (int)(uintptr_t)V_lds + v_rd_base(lane);
    const float* Fh = A_F(cur);
    const float* lut = (const float*)(lds + OFF_LUT) + (cur.bh % B.nh) * 512 + 256;
    const bool ordB = ORD_SPLIT && ((ORD_SPLIT == 1) ? (wid >= 4) : ((ORD_SPLIT == 2) ? (wid & 1) : ((wid >> 1) & 1)));
    const int own = P0 >> 8;
    if (MODE == 1) { const unsigned sr_ = A_SEL(cur)[wid * QBLK + r32] | (1u << own); if (hi == 0) ((unsigned*)li_l)[r32] = sr_; asm volatile("s_waitcnt lgkmcnt(0)" ::: "memory"); }
#define RESC(a) do { if (__any((a) < 1.f)) { if (hi == 0) al_l[r32] = (a); asm volatile("s_waitcnt lgkmcnt(0)" ::: "memory");              \
                     for (int d_ = 0; d_ < 4; ++d_) for (int r = 0; r < 16; ++r) o[d_][r] *= al_l[crow(r, hi)]; } } while (0)
#define KBASE(t) (MODE == 0 ? (NT - 1 - (t)) * KVBLK : (t) * KVBLK)
#define MASKT(P0_, P1_, t) do { const int kb_ = KBASE(t); if (kb_ + KVBLK - 1 > qlo) mask_tile(P0_, P1_, qm - kb_); } while (0)
#define CINIT(P0_, P1_, t, KB) do { const int kb_ = KBASE(t);                                                                               \
        if (MODE == 0) { const float* fp_ = (const float*)(lds + OFF_G) + (KB) * 64 + 4 * hi;                                               \
            _Pragma("unroll") for (int g_ = 0; g_ < 4; ++g_) { const f32x4 a_ = *(const f32x4*)(fp_ + 8 * g_), b_ = *(const f32x4*)(fp_ + 32 + 8 * g_);   \
                _Pragma("unroll") for (int i_ = 0; i_ < 4; ++i_) { P0_[4 * g_ + i_] = a_[i_]; P1_[4 * g_ + i_] = b_[i_]; } } }   \
        else { if (qlo - kb_ - (KVBLK - 1) >= 113) { P0_ = f32x16{}; P1_ = f32x16{}; }     \
            else { const float* lp_ = lut + (qlo + r32 - kb_ - 4 * hi - 59);                                                                 \
                _Pragma("unroll") for (int r_ = 0; r_ < 16; ++r_) { const int c_ = (r_ & 3) + 8 * (r_ >> 2);                                 \
                    P0_[r_] = lp_[59 - c_]; P1_[r_] = lp_[27 - c_]; } } } } while (0)
#define KEEP(t) (MODE == 0 ? true : (bool)((((const unsigned*)li_l)[r32] >> (KBASE(t) >> 8)) & 1u))
#define ACTW(t) (!WSKIP || (KBASE(t) <= qlo + (QBLK - 1) && (MODE == 1 || !WAVE_PRUNE || (t) < NTW)))
#define PFILL(P0_, P1_, al_) do { float ni_; asm volatile("s_mov_b32 %0, 0xff800000" : "=s"(ni_));   \
        P0_ = f32x16{}; _Pragma("unroll") for (int r_ = 0; r_ < 16; ++r_) P1_[r_] = ni_; al_ = 1.f; } while (0)
    constexpr int NQL = 8;
#define SEAM_K0() do { VMWN(NQL); SWRITE_HK(0); SBAR(); } while (0)
    f32x16 pA0, pA1, pB0, pB1; float mnA, mnB, alA, alB; bf16x8 pa0, pa1, pa2, pa3;
    CS(69);
    SWRITE_HV(0); SBAR();
    if (!WSKIP_HEAD || ACTW(0)) {
    CINIT(pA0, pA1, 0, 0);
    SLOAD_H(cur, KBASE(1));
    SBAR(); qkt(pA0, pA1, K_lds, r32, hi, S.qr);
    MASKT(pA0, pA1, 0); partialSM(pA0, pA1, m_reg, mnA, alA, KEEP(0)); }
    else { SLOAD_H(cur, KBASE(1)); PFILL(pA0, pA1, alA); }
    if (MODE == 0) {
        float qs = 0.f;
#pragma unroll
        for (int d0 = 0; d0 < 8; ++d0) { const u32x4 w = __builtin_bit_cast(u32x4, S.qr[d0]);
#pragma unroll
            for (int e = 0; e < 4; ++e) { const float a = __uint_as_float(w[e] << 16), b = __uint_as_float(w[e] & 0xffff0000u); qs += a * a + b * b; } }
        { auto rr = __builtin_amdgcn_permlane32_swap(__float_as_uint(qs), __float_as_uint(qs), false, false); qs = __uint_as_float(rr[0]) + __uint_as_float(rr[1]); }
        if (DYN_PRUNE) { if (hi == 0) li_l[r32] = qs; if (wid == 0) ((float*)(lds + OFF_GL))[lane] = gl; }
#pragma unroll
        for (int o_ = 1; o_ < 32; o_ <<= 1) qs = fmaxf(qs, __shfl_xor(qs, o_));
        if (lane == 0) ((float*)(lds + OFF_QN))[wid] = qs; }
    VMW(); SWRITE_H(1);
    __syncthreads(); CS(70);
    if constexpr (Sched::DYN) {
        const int n_ = __builtin_amdgcn_readfirstlane(((volatile LAS int*)(lds + OFF_NXT))[0]);
        more = sch.decode(n_, nxt); if (!more) nxt = cur;
        kbn = first_kb<MODE>(A_P0(nxt)); }
    if (MODE == 0) {
        const float* qn = (const float*)(lds + OFF_QN); float q2 = qn[0];
#pragma unroll
        for (int w_ = 1; w_ < 8; ++w_) q2 = fmaxf(q2, qn[w_]);
        const float k2 = ((const float*)(lds + OFF_KM))[cur.slot];
        const float thr = 2.04f * sqrtf(q2 * k2) + PRUNE_T * INV_SCALE;
        const unsigned long long bal = __ballot(lane < NT && (g0 - gl > thr));
        int jlo = bal == ~0ull ? 64 : __builtin_ctzll(~bal);
        jlo = __builtin_amdgcn_readfirstlane(jlo);
        if (jlo > NT - 4) jlo = NT - 4;
        jlo &= ~1;
        NTE = NT - jlo;
#ifdef FORCE_NTE4
        NTE = 4;
#endif
        }
#define HALF_STEP(PX0, PX1, mnX, alX, PY0, PY1, alY, t, KB, VB, SB) do {                                                      \
        SBAR(); CS(60);                                                                                                       \
        const bool actX_ = ACTW(t), actY_ = !WSKIP_Y || ACTW((t) - 1);                                                        \
        if (!actX_) { finishSM(PY0, PY1, alY, l_reg, pa0, pa1, pa2, pa3); PFILL(PX0, PX1, alX); }                             \
        else { if (MODE == 1 && qlo - KBASE(t) - (KVBLK - 1) >= 113) { qkt<true>(PX0, PX1, K_lds + (KB) * SHM_K, r32, hi, S.qr); }            \
        else { CINIT(PX0, PX1, (t), (KB)); qkt(PX0, PX1, K_lds + (KB) * SHM_K, r32, hi, S.qr); }                                  \
        finishSM(PY0, PY1, alY, l_reg, pa0, pa1, pa2, pa3); } SBAR(); CS(62);                   \
        if ((t) + 1 < NTE && ABL != 6 && ABL != 8) { SLOAD_H(cur, KBASE((t) + 1)); SBAR(); } CS(63);                           \
        if (actY_) pv_tile<(VB) * SHM_V>(o, vb0, pa0, pa1, pa2, pa3); if (actX_) { MASKT(PX0, PX1, (t)); partialSM(PX0, PX1, m_reg, mnX, alX, KEEP(t)); } CS(65); \
        if (ABL != 7 && ABL != 8) __syncthreads(); CS(66);                                                                    \
        if ((t) + 1 < NTE) { VMW(); SWRITE_H(SB); } CS(67);                                                                    \
        RESC(alX); if (ABL != 7 && ABL != 8) __syncthreads(); CS(68); } while (0)
    for (int t = 1; t + 1 < NTE; t += 2) {
        HALF_STEP(pB0, pB1, mnB, alB, pA0, pA1, alA, t, 1, 0, 0);
        if (MODE == 0 && DYN_PRUNE && t == 3) {
            const float kmx_ = sqrtf(((const float*)(lds + OFF_KM))[cur.slot]);
            float bnd = 1.02f * sqrtf(li_l[r32]) * kmx_ - m_reg;
#pragma unroll
            for (int o_ = 1; o_ < 32; o_ <<= 1) bnd = fmaxf(bnd, __shfl_xor(bnd, o_));
            if ((ph_tid() & 63) == 0) ((float*)(lds + OFF_QN))[wid] = bnd;
            if (WAVE_PRUNE) {
                const int lw_ = ph_tid() & 63; const float thw = -PRUNE_T * INV_SCALE - bnd;
                const unsigned long long bw = __ballot(lw_ < NT && ((const float*)(lds + OFF_GL))[lw_] < thw);
                int jw = bw == ~0ull ? 64 : __builtin_ctzll(~bw);
                jw = __builtin_amdgcn_readfirstlane(jw);
                if (jw > NT - 4) jw = NT - 4;
                NTW = NT - jw; }
            __syncthreads();
            const float* qn = (const float*)(lds + OFF_QN); float bm = qn[0];
#pragma unroll
            for (int w_ = 1; w_ < 8; ++w_) bm = fmaxf(bm, qn[w_]);
            const float theta = -PRUNE_T * INV_SCALE - bm;
            const int l_ = ph_tid() & 63;
            const unsigned long long bal = __ballot(l_ < NT && ((const float*)(lds + OFF_GL))[l_] < theta);
            int jlo = bal == ~0ull ? 64 : __builtin_ctzll(~bal);
            jlo = __builtin_amdgcn_readfirstlane(jlo);
            if (jlo > NT - 6) jlo = NT - 6;
            jlo &= ~1;
            if (NT - jlo < NTE) NTE = NT - jlo; }
        HALF_STEP(pA0, pA1, mnA, alA, pB0, pB1, alB, t + 1, 0, 1, 1);
    }
#ifdef NTEPROBE
    if (MODE == 0 && ph_tid() == 0) { if (NTEPROBE == 1) atomicAdd((unsigned*)((const char*)B.F - (6u << 20)) + 9216 + 1024, (unsigned)NTE);
        else { volatile LAS unsigned* d_ = (volatile LAS unsigned*)(lds + OFF_GL + 256); const unsigned v_ = d_[0] + (NTEPROBE == 3 ? 1u : (unsigned)NTE); d_[0] = v_; atomicMax((unsigned*)((const char*)B.F - (6u << 20)) + 9216 + 1024, v_); } }
#endif
    CS(71);
    const bool actT_ = !WSKIP_TAIL || ACTW(NTE - 1);
    SBAR(); if (actT_) { CINIT(pB0, pB1, NTE - 1, 1); qkt(pB0, pB1, K_lds + SHM_K, r32, hi, S.qr); } else PFILL(pB0, pB1, alB); SBAR();
    SLOAD_H(nxt, kbn); SBAR();
    { const int t2_ = ph_tid(), l2_ = t2_ & 63; const unsigned qoff = (unsigned)((wid * QBLK + (l2_ & 31)) * D + (l2_ >> 5) * 8) * 2u; QLOAD(nxt); }
    SBAR();
    const bool actU_ = !WSKIP_Y || !WSKIP_TAIL || ACTW(NTE - 2);
    finishSM(pA0, pA1, alA, l_reg, pa0, pa1, pa2, pa3); SBAR();
    if (actU_) pv_tile<0>(o, vb0, pa0, pa1, pa2, pa3);
    if (actT_) { MASKT(pB0, pB1, NTE - 1); partialSM(pB0, pB1, m_reg, mnB, alB, KEEP(NTE - 1)); } __syncthreads(); RESC(alB);
    finishSM(pB0, pB1, alB, l_reg, pa0, pa1, pa2, pa3); SBAR(); if (!WSKIP_Y || actT_) pv_tile<SHM_V>(o, vb0, pa0, pa1, pa2, pa3);
    SBAR(); SEAM_K0(); CS(59);
    if (hi == 0) li_l[r32] = l_reg; asm volatile("s_waitcnt lgkmcnt(0)" ::: "memory");
    float rli[16];
#pragma unroll
    for (int r = 0; r < 16; ++r) rli[r] = __builtin_amdgcn_rcpf(li_l[crow(r, hi)]);
    bf16* Ow = A_O(cur) + (size_t)(wid * QBLK) * OSTR;
#if O_STAGE
    { char* ot = lds + OFF_OT + wid * OT_BYTES; const int l2_ = ph_tid() & 63, rw_ = l2_ >> 3, ch_ = l2_ & 7;
#pragma unroll
      for (int ps = 0; ps < 2; ++ps) {
#pragma unroll
        for (int r = 0; r < 16; ++r) {
#pragma unroll
            for (int dd = 0; dd < 2; ++dd) { const float v = o[2 * ps + dd][r] * rli[r];
                const float vn = __uint_as_float((unsigned)__builtin_amdgcn_mov_dpp((int)__float_as_uint(v), 0xB1, 0xF, 0xF, true));
                if ((r32 & 1) == 0) *(unsigned*)(ot + crow(r, hi) * OT_STRIDE + (dd * 32 + r32) * 2) = cvtpk(v, vn); } }
#pragma unroll
        for (int i = 0; i < 4; ++i) { const int row = 8 * i + rw_; const u32x4 w = *(const u32x4*)(ot + row * OT_STRIDE + ch_ * 16);
            *(u32x4*)(Ow + (size_t)row * OSTR + ps * 64 + ch_ * 8) = w; } } }
#else
    const unsigned ooff = (unsigned)(4 * hi * OSTR + r32);
#pragma unroll
    for (int r = 0; r < 16; ++r) { const int orow = crow(r, hi);
#pragma unroll
        for (int d0 = 0; d0 < 4; ++d0) { const float v = o[d0][r] * rli[r];
            const float vn = __uint_as_float((unsigned)__builtin_amdgcn_mov_dpp((int)__float_as_uint(v), 0xB1, 0xF, 0xF, true));
            if ((r32 & 1) == 0) *(unsigned*)(Ow + ((r & 3) + 8 * (r >> 2)) * OSTR + d0 * 32 + ooff) = cvtpk(v, vn); } }
#endif
    __syncthreads(); CS(58);
    return more;
#undef RESC
#undef KBASE
#undef MASKT
#undef CINIT
#undef KEEP
#undef ACTW
#undef PFILL
#undef SEAM_K0
#undef HALF_STEP
}
#undef ROW
#undef VMW
#undef VMWN
#undef SLOAD_H
#undef QLOAD
#undef BL16
#undef SWRITE_HK
#undef SWRITE_HV
#undef SWRITE_H
template <int MODE, class Sched>
__device__ __forceinline__ void attn_phase(char* lds, const ABase& B, const Sched& sch) {
    AItem cur, nxt;
    if constexpr (Sched::DYN) { volatile LAS int* nx = (volatile LAS int*)(lds + OFF_NXT);
        if (ph_tid() == 0) { nx[1] = 0; const int c0 = sch.resolve(sch.issue(nx + 1), nx + 1); nx[2] = c0; nx[0] = c0 >= 0 ? sch.resolve(sch.issue(nx + 1), nx + 1) : -1; }
        __syncthreads();
        const int n0 = __builtin_amdgcn_readfirstlane(nx[2]);
        if (!sch.decode(n0, cur)) return; }
    else { if (!sch.get(0, cur)) return; }
    ADesc DS; const int tb_ = 8 * SEQ * B.nh * D * 2;
    DS.q = __builtin_amdgcn_make_buffer_rsrc((void*)B.Q, (short)0, tb_, 0x00020000); DS.k = __builtin_amdgcn_make_buffer_rsrc((void*)B.K, (short)0, tb_, 0x00020000);
    DS.v = __builtin_amdgcn_make_buffer_rsrc((void*)B.V, (short)0, tb_, 0x00020000); DS.f = __builtin_amdgcn_make_buffer_rsrc((void*)B.F, (short)0, MODE == 0 ? 8 * SEQ * B.nh * 4 : 0, 0x00020000);
#ifdef NTEPROBE
    if (ph_tid() == 0) ((volatile LAS unsigned*)(lds + OFF_GL + 256))[0] = 0u;
#endif
    Seam S; attn_prime<MODE>(B, DS, cur, lds, S);
    for (int i = 0;; ++i) {
        bool more = false;
        unsigned pend = 0;
        if constexpr (Sched::DYN) { if (ph_tid() == 0) pend = sch.issue((volatile LAS int*)(lds + OFF_NXT) + 1); }
        else { more = sch.get(i + 1, nxt); if (!more) nxt = cur; }
        more = attn_block<MODE, Sched>(B, DS, cur, nxt, lds, S, sch, more);
        if constexpr (Sched::DYN) { volatile LAS int* nx = (volatile LAS int*)(lds + OFF_NXT); if (ph_tid() == 0) nx[0] = sch.resolve(pend, nx + 1); }
        if (!more) break;
        cur = nxt;
    }
}
#undef SBAR
}
namespace ret {
using att::bf16; using att::bf16x8; using att::s16x4; using att::f32x16; using att::f32x4; using att::u32x4;
using att::crow; using att::cvtpk; using att::load8; using att::v_st; using att::v_rd_base; using att::qkt; using att::pv_tile;
typedef float f32x2c_ __attribute__((ext_vector_type(2))); typedef __bf16 bf16x2c_ __attribute__((ext_vector_type(2)));
__device__ __forceinline__ unsigned cvtpk_c(float lo, float hi) { const f32x2c_ v = {lo, hi}; const bf16x2c_ b = __builtin_convertvector(v, bf16x2c_); return __builtin_bit_cast(unsigned, b); }
__device__ __forceinline__ float bf_lo(unsigned w) { return __uint_as_float(w << 16); }
__device__ __forceinline__ float bf_hi(unsigned w) { return __uint_as_float(w & 0xffff0000u); }
__device__ __forceinline__ float l2g_of(int h) { return __builtin_log2f(1.f - __builtin_amdgcn_exp2f(-5.f - (float)h)); }
#define SBAR() __builtin_amdgcn_sched_barrier(0)
#ifdef RSTAMP_ON
#define RSTAMP(i) do { if (blockIdx.x == 0 && threadIdx.x == 0) { const unsigned long long t_ = __builtin_amdgcn_s_memrealtime(); volatile unsigned* M_ = (volatile unsigned*)(lds + 131072 + 320); M_[32 + 2 * (i)] = (unsigned)t_; M_[33 + 2 * (i)] = (unsigned)(t_ >> 32); } } while (0)
#else
#define RSTAMP(i) do {} while (0)
#endif
__device__ __forceinline__ int frag_idx(int dv, int dk) { return (((((dv >> 5) * 8 + (dk >> 4)) * 2 + ((dk >> 3) & 1)) * 32 + (dv & 31)) << 3) + (dk & 7); }
struct KVStage { u32x4 kw[4]; bf16x8 vv[4]; };
__device__ __forceinline__ void kv_load(KVStage& st, const bf16* K, const bf16* V) {
    const int tid = ph_tid();
#pragma unroll
    for (int i = 0; i < 4; ++i) { const int idx = tid + 512 * i, row = idx >> 4, pc = idx & 15;
        st.kw[i] = *(const u32x4*)(K + (size_t)row * 128 + pc * 8); st.vv[i] = load8(V + (size_t)row * 128 + pc * 8); }
}
__device__ __forceinline__ void kv_task(char* lds, KVStage& st, const bf16* Kn, const bf16* Vn, bool has_next, bf16* KVt, int h) {
    const int tid = ph_tid(), wid = __builtin_amdgcn_readfirstlane(tid >> 6), lane = tid & 63, r32 = lane & 31, hi = lane >> 5;
    const float l2g = l2g_of(h);
#pragma unroll
    for (int i = 0; i < 4; ++i) { const int idx = tid + 512 * i, row = idx >> 4, pc = idx & 15;
        const u32x4 kw = st.kw[i];
        const float dec = __builtin_amdgcn_exp2f(l2g * (float)(127 - row));
        u32x4 ks; ks.x = cvtpk(bf_lo(kw.x) * dec, bf_hi(kw.x) * dec); ks.y = cvtpk(bf_lo(kw.y) * dec, bf_hi(kw.y) * dec);
        ks.z = cvtpk(bf_lo(kw.z) * dec, bf_hi(kw.z) * dec); ks.w = cvtpk(bf_lo(kw.w) * dec, bf_hi(kw.w) * dec);
        const int off = (row >> 6) * 16384 + v_st(row & 63, pc * 8);
        *(u32x4*)(lds + off) = ks; *(bf16x8*)(lds + 32768 + off) = st.vv[i]; }
    if (has_next) kv_load(st, Kn, Vn);
    __syncthreads();
    const int dkb = wid >> 1, dvb0 = 2 * (wid & 1);
    const int kb = (int)(uintptr_t)lds + v_rd_base(lane) + dkb * 512, vb = (int)(uintptr_t)lds + 32768 + v_rd_base(lane) + dvb0 * 512;
    f32x16 acc0 = {}, acc1 = {};
#define TRRD(dst, base, off) asm volatile("ds_read_b64_tr_b16 %0, %1 offset:%2" : "=&v"(dst) : "v"(base), "i"(off) : "memory")
#define KV_STEP(tt, ks) do { s16x4 al, ah, b0l, b0h, b1l, b1h; constexpr int o_ = (tt) * 16384 + (ks) * 4096;                        \
        TRRD(al, kb, o_); TRRD(ah, kb, o_ + 2048); TRRD(b0l, vb, o_); TRRD(b0h, vb, o_ + 2048); TRRD(b1l, vb, o_ + 512); TRRD(b1h, vb, o_ + 2560);   \
        asm volatile("s_waitcnt lgkmcnt(0)" ::: "memory"); SBAR();                                                                     \
        const bf16x8 A_ = (bf16x8){al[0], al[1], al[2], al[3], ah[0], ah[1], ah[2], ah[3]};                                              \
        acc0 = __builtin_amdgcn_mfma_f32_32x32x16_bf16(A_, (bf16x8){b0l[0], b0l[1], b0l[2], b0l[3], b0h[0], b0h[1], b0h[2], b0h[3]}, acc0, 0, 0, 0);   \
        acc1 = __builtin_amdgcn_mfma_f32_32x32x16_bf16(A_, (bf16x8){b1l[0], b1l[1], b1l[2], b1l[3], b1h[0], b1h[1], b1h[2], b1h[3]}, acc1, 0, 0, 0); } while (0)
    KV_STEP(0, 0); KV_STEP(0, 1); KV_STEP(0, 2); KV_STEP(0, 3); KV_STEP(1, 0); KV_STEP(1, 1); KV_STEP(1, 2); KV_STEP(1, 3);
#undef KV_STEP
#pragma unroll
    for (int g = 0; g < 4; ++g) { const int dk = 32 * dkb + 8 * g + 4 * hi;
        uint2 w0, w1; w0.x = cvtpk_c(acc0[4 * g], acc0[4 * g + 1]); w0.y = cvtpk_c(acc0[4 * g + 2], acc0[4 * g + 3]); w1.x = cvtpk_c(acc1[4 * g], acc1[4 * g + 1]); w1.y = cvtpk_c(acc1[4 * g + 2], acc1[4 * g + 3]);
        *(uint2*)(KVt + frag_idx(32 * dvb0 + r32, dk)) = w0; *(uint2*)(KVt + frag_idx(32 * (dvb0 + 1) + r32, dk)) = w1; }
    __syncthreads();
}
__device__ __forceinline__ void out_task(char* lds, const bf16* Q, const bf16* K, const bf16* V, const bf16* ST, const bf16* RG, const float* gn, bf16* CAT, int h) {
    const int tid = ph_tid(), wid = __builtin_amdgcn_readfirstlane(tid >> 6), lane = tid & 63, r32 = lane & 31, hi = lane >> 5;
    const int ch = wid >> 2, wq = wid & 3, ltid = tid & 255;
    const float l2g = l2g_of(h);
    char* Vreg = lds + ch * 32768; char* Kreg = lds + 65536 + ch * 32768;
    bf16x8 kst[8];
#pragma unroll
    for (int i = 0; i < 8; ++i) { const int row = (ltid >> 4) + 16 * i, pc = ltid & 15; kst[i] = load8(K + (size_t)(ch * 128 + row) * 128 + pc * 8); }
    { const bf16* STc = ST + (size_t)ch * 16384; bf16x8 sst[8];
#pragma unroll
      for (int i = 0; i < 8; ++i) sst[i] = load8(STc + ((ltid + 256 * i) << 3));
#pragma unroll
      for (int i0 = 0; i0 < 8; i0 += 4) {
#pragma unroll
        for (int i = i0; i < i0 + 4; ++i) { const int row = (ltid >> 4) + 16 * i, pc = ltid & 15;
          const bf16x8 vv = load8(V + (size_t)(ch * 128 + row) * 128 + pc * 8);
          *(bf16x8*)(Vreg + (row >> 6) * 16384 + v_st(row & 63, pc * 8)) = vv; }
        SBAR(); }
#pragma unroll
      for (int i = 0; i < 8; ++i) *(bf16x8*)(Kreg + ((ltid + 256 * i) << 4)) = sst[i]; }
    RSTAMP(21);
    bf16x8 qr[8];
#pragma unroll
    for (int d0 = 0; d0 < 8; ++d0) qr[d0] = load8(Q + (size_t)(ch * 128 + wq * 32 + r32) * 128 + d0 * 16 + hi * 8);
    f32x16 o[4] = {};
    __syncthreads();
#pragma unroll
    for (int d0 = 0; d0 < 4; ++d0) { bf16x8 sf[8];
#pragma unroll
        for (int ks = 0; ks < 8; ++ks) sf[ks] = *(const bf16x8*)(Kreg + ((((d0 * 8 + ks) * 2 + hi) * 32 + r32) << 4));
#pragma unroll
        for (int ks = 0; ks < 8; ++ks) o[d0] = __builtin_amdgcn_mfma_f32_32x32x16_bf16(qr[ks], sf[ks], o[d0], 0, 0, 0); }
#pragma unroll
    for (int r = 0; r < 16; ++r) { const float qd = __builtin_amdgcn_exp2f(l2g * (float)(wq * 32 + crow(r, hi) + 1));
#pragma unroll
        for (int d0 = 0; d0 < 4; ++d0) o[d0][r] *= qd; }
    u32x4 gwv[8];
    { const bf16* rgp0 = RG + (size_t)(ch * 128 + wq * 32 + (lane & 31)) * 512 + (lane >> 5) * 64;
#pragma unroll
      for (int i = 0; i < 8; ++i) gwv[i] = *(const u32x4*)(rgp0 + 8 * i); }
    __syncthreads();
#pragma unroll
    for (int i = 0; i < 8; ++i) { const int row = (ltid >> 4) + 16 * i, pc = ltid & 15; *(bf16x8*)(Kreg + (row >> 6) * 16384 + KSWZ(row & 63, pc * 16)) = kst[i]; }
    __syncthreads();
    RSTAMP(22);
    const int vb0 = (int)(uintptr_t)Vreg + v_rd_base(lane), row = wq * 32 + r32;
    for (int kt = 0; kt < 2; ++kt) { if (kt * 64 > wq * 32 + 31) break;
        f32x16 p0 = {}, p1 = {};
        qkt(p0, p1, Kreg + kt * 16384, r32, hi, qr);
#pragma unroll
        for (int r = 0; r < 16; ++r) { const int k0 = kt * 64 + crow(r, hi), k1 = k0 + 32;
            p0[r] = (k0 <= row) ? p0[r] * __builtin_amdgcn_exp2f(l2g * (float)(row - k0)) : 0.f;
            p1[r] = (k1 <= row) ? p1[r] * __builtin_amdgcn_exp2f(l2g * (float)(row - k1)) : 0.f; }
        bf16x8 pa0, pa1, pa2, pa3;
        ATT_PK4(p0, 0, pa0); ATT_PK4(p0, 8, pa1); ATT_PK4(p1, 0, pa2); ATT_PK4(p1, 8, pa3);
        SBAR(); pv_tile<0>(o, vb0 + kt * 16384, pa0, pa1, pa2, pa3); }
    RSTAMP(23);
    __syncthreads();
    { float* tile = (float*)(lds + wid * 16384);
#pragma unroll
      for (int r = 0; r < 16; ++r) { const int rw = crow(r, hi);
#pragma unroll
          for (int d0 = 0; d0 < 4; ++d0) { const int c = d0 * 8 + (r32 >> 2); tile[rw * 128 + ((c ^ (rw & 15)) << 2) + (r32 & 3)] = o[d0][r]; } }
      asm volatile("s_waitcnt lgkmcnt(0)" ::: "memory");
      const int rw = lane & 31, hf = lane >> 5, trow = ch * 128 + wq * 32 + rw;
      const float* trp = tile + rw * 128; const int sw = rw & 15;
#define TV(i) (*(const f32x4*)(trp + ((((hf * 16 + (i)) ^ sw)) << 2)))
      float s = 0.f;
#pragma unroll
      for (int i = 0; i < 16; ++i) { const f32x4 t = TV(i); s += (t[0] + t[1]) + (t[2] + t[3]); }
      { auto rr = __builtin_amdgcn_permlane32_swap(__float_as_uint(s), __float_as_uint(s), false, false); s = __uint_as_float(rr[0]) + __uint_as_float(rr[1]); }
      const float mu = s * (1.f / 128.f); float q = 0.f;
#pragma unroll
      for (int i = 0; i < 16; ++i) { const f32x4 t = TV(i) - mu; q += (t[0] * t[0] + t[1] * t[1]) + (t[2] * t[2] + t[3] * t[3]); }
      { auto rr = __builtin_amdgcn_permlane32_swap(__float_as_uint(q), __float_as_uint(q), false, false); q = __uint_as_float(rr[0]) + __uint_as_float(rr[1]); }
      const float rstd = __builtin_amdgcn_rsqf(q * (1.f / 128.f) + 1e-5f);
      bf16* cp = CAT + (size_t)trow * 1024 + hf * 64; const float* gp = gn + hf * 64;
#pragma unroll
      for (int i = 0; i < 8; ++i) { const u32x4 gw = gwv[i]; const f32x4 ga = *(const f32x4*)(gp + 8 * i), gb = *(const f32x4*)(gp + 8 * i + 4);
          const f32x4 va = (TV(2 * i) - mu) * rstd * ga, vb = (TV(2 * i + 1) - mu) * rstd * gb;
          float y[8];
#pragma unroll
          for (int e = 0; e < 4; ++e) { const float g0 = bf_lo(gw[e]), g1 = bf_hi(gw[e]);
              const float x0 = (e < 2) ? va[(e & 1) * 2] : vb[(e & 1) * 2], x1 = (e < 2) ? va[(e & 1) * 2 + 1] : vb[(e & 1) * 2 + 1];
              y[2 * e] = x0 * g0 * __builtin_amdgcn_rcpf(1.f + __builtin_amdgcn_exp2f(-1.4426950408889634f * g0));
              y[2 * e + 1] = x1 * g1 * __builtin_amdgcn_rcpf(1.f + __builtin_amdgcn_exp2f(-1.4426950408889634f * g1)); }
          u32x4 w; w.x = cvtpk(y[0], y[1]); w.y = cvtpk(y[2], y[3]); w.z = cvtpk(y[4], y[5]); w.w = cvtpk(y[6], y[7]);
          *(u32x4*)(cp + 8 * i) = w; }
#undef TV
    }
    __syncthreads();
}
#undef TRRD
#undef SBAR
}
constexpr int NWAVES = 8;
#ifndef PLAIN_ALIGN
#define PLAIN_ALIGN true
#endif
#ifndef PLAIN_SP2
#define PLAIN_SP2 true
#endif
constexpr int BATCH = 8, SEQ = 4096, DM = 1024, T = BATCH * SEQ, FFH = 2816;
constexpr size_t MiB = 1u << 20;
constexpr size_t WS_CTL = 0, CTL_ZERO_BYTES = 1 * MiB;
constexpr size_t WS_COS = 1 * MiB, WS_SIN = 2 * MiB;
constexpr size_t WS_WFL = 3 * MiB;
constexpr size_t WS_KMEAN = 3 * MiB + 65536;
constexpr size_t WS_SEL = 4 * MiB;
constexpr size_t WS_LOGF = 5 * MiB;
constexpr size_t WS_FCUM = 6 * MiB;
constexpr size_t WS_RS = 7 * MiB;
constexpr size_t WS_WP0 = 8 * MiB, WS_WO0 = 15 * MiB, WS_WFI0 = 17 * MiB, WS_WFO0 = 28 * MiB, WS_WP1 = 34 * MiB, WS_WO1 = 40 * MiB, WS_WFI1 = 42 * MiB, WS_WFO1 = 53 * MiB;
constexpr size_t WS_A = 64 * MiB;
constexpr size_t WS_B = 128 * MiB;
constexpr size_t WS_C = 352 * MiB;
constexpr size_t WS_D = 416 * MiB;
constexpr size_t WS_E = 480 * MiB;
constexpr size_t WS_END = 512 * MiB;
constexpr int CW_BAR = 4096, CW_KM = 8192, CW_FQ = 9216, CW_XID = 12288, CW_GX = 12800, CW_WQ = 13312, CW_PF = 16384;
constexpr int RING_BYTES = 131072, MISC_OFF = RING_BYTES + 320, LDS_BYTES = 147456;
constexpr int SCR_OFF = RING_BYTES + 1024;

typedef unsigned short bf16r;
typedef unsigned v4u __attribute__((ext_vector_type(4)));
typedef float f32x4 __attribute__((ext_vector_type(4)));
#define LDS_WAIT() asm volatile("s_waitcnt lgkmcnt(0)" ::: "memory")
__device__ __forceinline__ unsigned pk2(float lo, float hi) { unsigned r; asm volatile("v_cvt_pk_bf16_f32 %0, %1, %2" : "=v"(r) : "v"(lo), "v"(hi)); return r; }
template <int CTRL> __device__ __forceinline__ float dpp_f(float v) { return __uint_as_float((unsigned)__builtin_amdgcn_mov_dpp((int)__float_as_uint(v), CTRL, 0xF, 0xF, true)); }
__device__ __forceinline__ float xsum16(float v) { auto rr = __builtin_amdgcn_permlane16_swap(__float_as_uint(v), __float_as_uint(v), false, false); return __uint_as_float(rr[0]) + __uint_as_float(rr[1]); }
__device__ __forceinline__ float xsum32(float v) { auto rr = __builtin_amdgcn_permlane32_swap(__float_as_uint(v), __float_as_uint(v), false, false); return __uint_as_float(rr[0]) + __uint_as_float(rr[1]); }
__device__ __forceinline__ float wave_sum(float v) {
    v += dpp_f<0xB1>(v);
    v += dpp_f<0x4E>(v);
    v += dpp_f<0x141>(v);
    v += dpp_f<0x140>(v);
    return xsum32(xsum16(v));
}
__device__ __forceinline__ int t5_bucket(int rel) {
    int n = rel > 0 ? rel : 0; if (n < 16) return n;
    int large = 16 + (int)(logf((float)n / 16.f) / 2.0794415416798357f * 16.f);
    return large < 31 ? large : 31;
}
template <int MAP> __device__ __forceinline__ int dest_row(int n) {
    if (MAP == 1) { if (n >= 1024) return n; const int d = n & 127, j = d & 63; return (n & ~127) + 8 * (j >> 2) + (j & 3) + ((d >> 6) << 2); }
    if (MAP == 2) { if (n < FFH) return 256 * (n >> 7) + (n & 127); const int c = n - FFH; return 256 * (c >> 7) + 128 + (c & 127); }
    return n;
}
struct TItem { const float* W; bf16r* WT; const float* gk; int K, ldw, map, k0, n0; };
__device__ __forceinline__ int dest_row_rt(int map, int n) { return map == 1 ? dest_row<1>(n) : (map == 2 ? dest_row<2>(n) : n); }
__device__ __forceinline__ void titem_load(const TItem& t, float (&rg)[32], float (&gg)[32], int lane) {
#pragma unroll
    for (int i = 0; i < 32; ++i) { const int kk = 2 * i + (lane >> 5); rg[i] = t.W[(size_t)(t.k0 + kk) * t.ldw + t.n0 + (lane & 31)]; gg[i] = t.gk ? t.gk[t.k0 + kk] : 1.f; }
}
__device__ __forceinline__ void titem_store(const TItem& t, const float (&rg)[32], const float (&gg)[32], LAS float* scr, int lane) {
#pragma unroll
    for (int i = 0; i < 32; ++i) { const int kk = 2 * i + (lane >> 5); scr[kk * 33 + (lane & 31)] = rg[i] * gg[i]; }
    LDS_WAIT(); asm volatile("" ::: "memory");
    const int c = lane & 7;
#pragma unroll
    for (int j = 0; j < 4; ++j) { const int n = (lane >> 3) + 8 * j; const LAS float* s = scr + (8 * c) * 33 + n;
        v4u o; o.x = pk2(s[0 * 33], s[1 * 33]); o.y = pk2(s[2 * 33], s[3 * 33]); o.z = pk2(s[4 * 33], s[5 * 33]); o.w = pk2(s[6 * 33], s[7 * 33]);
        *(v4u*)(t.WT + (size_t)dest_row_rt(t.map, t.n0 + n) * t.K + t.k0 + 8 * c) = o; }
    LDS_WAIT(); asm volatile("" ::: "memory");
}
struct P {
    const float *x, *relb, *nmpre, *nmpost, *nfpre, *nfpost, *ewin, *egn, *ewout, *owin, *obf, *owout, *fwin, *fwout; float* out; unsigned char* ws;
};
template <int XIN, bool HAS_M, int OUT, bool HAS_LOGF>
__device__ __forceinline__ void row_pass(int gw, int NGW, int lane, const float* xin32, const bf16r* xb_in, const bf16r* m, const float* gpost, bf16r* xb_out, float* rs, float* out32,
                                         const LAS float* wfl, const float* bfg, float* logf_out, const int r_hi = T) {
    f32x4 gp[4];
#pragma unroll
    for (int j = 0; j < 4; ++j) { if (HAS_M) gp[j] = *(const f32x4*)(gpost + 4 * lane + 256 * j); }
    constexpr int RPW = 2;
#define UNPK(w) ((f32x4){__uint_as_float((w).x << 16), __uint_as_float((w).x & 0xffff0000u), __uint_as_float((w).y << 16), __uint_as_float((w).y & 0xffff0000u)})
    struct Raw { f32x4 v[RPW][4]; uint2 xw[RPW][4]; uint2 mw[RPW][4]; };
    auto rp_load = [&](Raw& R, int r0) {
#pragma unroll
        for (int p = 0; p < RPW; ++p) { const int rq = r0 + p * NGW, rr = rq < r_hi ? rq : r_hi - 1;
#pragma unroll
            for (int j = 0; j < 4; ++j) { if (XIN == 0) R.v[p][j] = *(const f32x4*)(xin32 + (size_t)rr * DM + 4 * lane + 256 * j); else R.xw[p][j] = *(const uint2*)(xb_in + (size_t)rr * DM + 4 * lane + 256 * j);
                if (HAS_M) R.mw[p][j] = *(const uint2*)(m + (size_t)rr * DM + 4 * lane + 256 * j); } } };
    auto rp_proc = [&](Raw& R, int r0) {
        f32x4 vk[HAS_LOGF ? RPW : 1][4]; float r2k[HAS_LOGF ? RPW : 1];
#pragma unroll
        for (int p = 0; p < RPW; ++p) { const int r = r0 + p * NGW; const bool live = r < r_hi; { f32x4 v[4];
#pragma unroll
            for (int j = 0; j < 4; ++j) v[j] = (XIN == 0) ? R.v[p][j] : UNPK(R.xw[p][j]);
            if (HAS_M) { f32x4 mv[4]; float ss = 0.f;
#pragma unroll
                for (int j = 0; j < 4; ++j) { mv[j] = UNPK(R.mw[p][j]); ss += (mv[j].x * mv[j].x + mv[j].y * mv[j].y) + (mv[j].z * mv[j].z + mv[j].w * mv[j].w); }
                const float r1 = 1.f / sqrtf(wave_sum(ss) * (1.f / DM) + 1e-6f);
#pragma unroll
                for (int j = 0; j < 4; ++j) v[j] = v[j] + mv[j] * r1 * gp[j]; }
            if (OUT == 1) { if (live) {
#pragma unroll
                for (int j = 0; j < 4; ++j) *(f32x4*)(out32 + (size_t)r * DM + 4 * lane + 256 * j) = v[j]; }
            } else { float ss = 0.f;
#pragma unroll
                for (int j = 0; j < 4; ++j) { ss += (v[j].x * v[j].x + v[j].y * v[j].y) + (v[j].z * v[j].z + v[j].w * v[j].w);
                    uint2 w; w.x = pk2(v[j].x, v[j].y); w.y = pk2(v[j].z, v[j].w); if (live) *(uint2*)(xb_out + (size_t)r * DM + 4 * lane + 256 * j) = w; }
                const float r2 = 1.f / sqrtf(wave_sum(ss) * (1.f / DM) + 1e-6f);
                if (live && lane == 0) rs[r] = r2;
                if (HAS_LOGF) { r2k[p] = r2;
#pragma unroll
                    for (int j = 0; j < 4; ++j) vk[p][j] = v[j]; } } } }
        if (HAS_LOGF) { float d[RPW][8];
            typedef float f32x2_ __attribute__((ext_vector_type(2)));
#pragma unroll
            for (int h = 0; h < 8; ++h) { f32x2_ a2[RPW];
#pragma unroll
                for (int p = 0; p < RPW; ++p) a2[p] = (f32x2_){0.f, 0.f};
#pragma unroll
                for (int j = 0; j < 4; ++j) { const f32x4 w = *(const LAS f32x4*)(wfl + h * DM + 4 * lane + 256 * j);
#pragma unroll
                    for (int p = 0; p < RPW; ++p) { a2[p] = __builtin_elementwise_fma((f32x2_){vk[p][j].x, vk[p][j].y}, (f32x2_){w.x, w.y}, a2[p]); a2[p] = __builtin_elementwise_fma((f32x2_){vk[p][j].z, vk[p][j].w}, (f32x2_){w.z, w.w}, a2[p]); } }
#pragma unroll
                for (int p = 0; p < RPW; ++p) d[p][h] = a2[p].x + a2[p].y;
                __builtin_amdgcn_sched_barrier(0); }
#pragma unroll
            for (int p = 0; p < RPW; ++p) { const int r = r0 + p * NGW; if (r < r_hi) {
                float e4[4], e2[2], e1;
#pragma unroll
                for (int i = 0; i < 4; ++i) { const float keep = (lane & 4) ? d[p][4 + i] : d[p][i], send = (lane & 4) ? d[p][i] : d[p][4 + i]; e4[i] = keep + dpp_f<0x141>(send); }
#pragma unroll
                for (int i = 0; i < 2; ++i) { const float keep = (lane & 2) ? e4[2 + i] : e4[i], send = (lane & 2) ? e4[i] : e4[2 + i]; e2[i] = keep + dpp_f<0x4E>(send); }
                { const float keep = (lane & 1) ? e2[1] : e2[0], send = (lane & 1) ? e2[0] : e2[1]; e1 = keep + dpp_f<0xB1>(send); }
                e1 += dpp_f<0x128>(e1);
                e1 = xsum32(xsum16(e1));
                if (lane < 8) { const float z = e1 * r2k[p] + bfg[lane]; logf_out[(size_t)r * 8 + lane] = fminf(z, 0.f) - 0.6931471805599453f * __builtin_amdgcn_logf(1.f + __builtin_amdgcn_exp2f(-1.4426950408889634f * fabsf(z))); } } } } };
    Raw A, B; const int step = RPW * NGW;
    rp_load(A, gw);
    for (int r0 = gw; r0 < r_hi; r0 += 2 * step) {
        rp_load(B, r0 + step);
        rp_proc(A, r0);
        rp_load(A, r0 + 2 * step);
        rp_proc(B, r0 + step);
    }
#undef UNPK
}
struct AttSchedFoxDyn {
    static constexpr bool DYN = true;
    unsigned* ctr; int q, nq; const LAS unsigned short* ord;
    __device__ __forceinline__ unsigned issue(volatile LAS int* cursor) const { const int k = cursor[0]; if (k >= nq) return ~0u; return __hip_atomic_fetch_add(ctr + 64 * ((q + k) % nq), 1u, __ATOMIC_RELAXED, __HIP_MEMORY_SCOPE_AGENT); }
    __device__ __forceinline__ int resolve(unsigned n, volatile LAS int* cursor) const { const int per = 1024 / nq; int k = cursor[0];
        while (k < nq) { if (n < (unsigned)per) { cursor[0] = k; return ((q + k) % nq) * per + (int)n; } ++k; if (k < nq) n = __hip_atomic_fetch_add(ctr + 64 * ((q + k) % nq), 1u, __ATOMIC_RELAXED, __HIP_MEMORY_SCOPE_AGENT); }
        cursor[0] = k; return -1; }
    __device__ __forceinline__ bool decode(int c, att::AItem& r) const { if (c < 0) return false; const int per = 1024 / nq, hpq = 64 / nq, qq = c / per, li = ord[c]; r.qb = 15 - li / hpq; r.bh = qq * hpq + li % hpq; r.slot = r.bh; return true; }
};
struct AttSchedFox {
    static constexpr bool DYN = false;
    int vcu;
    __device__ __forceinline__ bool get(int i, att::AItem& r) const { if (i >= 4) return false; const int p = vcu + 256 * (i >> 1), x = p & 7; r.bh = p >> 3; r.qb = (i & 1) ? x : 15 - x; r.slot = r.bh; return true; }
};
struct AttSchedMoba {
    static constexpr bool DYN = false;
    int vcu, first, count;
    __device__ __forceinline__ bool get(int i, att::AItem& r) const { if (i >= count) return false; const int x = vcu & 7; r.bh = vcu >> 3; r.qb = ((first + i) & 1) ? x : 15 - x; r.slot = 0; return true; }
};

#ifndef FUSE_QUAD
#define FUSE_QUAD 0
#endif
#ifndef GATE_IN_P4
#define GATE_IN_P4 1
#endif
#ifndef DEFER_W
#define DEFER_W 0
#endif
#ifndef P4_MIX
#define P4_MIX 1
#endif
#ifndef LOCAL_SEAMS
#define LOCAL_SEAMS 0
#endif
struct PairOrder {
    bool pair; pg8::StaticOrder so; int pm, m;
    __device__ __forceinline__ void init(int M, int N, int G_, int bx_) { so.init(M, N, G_, bx_); pair = FUSE_QUAD && (G_ == 256 && M == T && N == DM); pm = 16 * (bx_ & 7) + 2 * (bx_ >> 5); m = (bx_ >> 3) & 3; }
    __device__ __forceinline__ bool next(int i, pg8::Unit& u) const { if (!pair) return so.next(i, u); if (i >= 2) return false; u.pm = pm + i; u.pn = m; return true; }
    __device__ __forceinline__ int row0() const { return (pm + (m >> 1)) * 256 + (m & 1) * 128; }
    __device__ __forceinline__ void a_ready(const pg8::Unit&) const {}
    __device__ __forceinline__ void done(const pg8::Unit&) const {}
};
__device__ __forceinline__ void pair_sync(unsigned* flag, bool same_xcc) {
    asm volatile("s_waitcnt vmcnt(0)" ::: "memory");
    __syncthreads();
    if (threadIdx.x == 0) {
        if (!same_xcc) { __builtin_amdgcn_fence(__ATOMIC_RELEASE, "agent"); asm volatile("s_waitcnt vmcnt(0)" ::: "memory"); }
        (void)xb_add(flag, 1u);
        unsigned sp_ = 0u; while (xb_ld(flag) < 4u) { __builtin_amdgcn_s_sleep(1); if (++sp_ > (XB_SPIN_CAP << 4)) break; }
        __builtin_amdgcn_fence(__ATOMIC_ACQUIRE, "agent");
        asm volatile("s_waitcnt vmcnt(0)" ::: "memory");
    }
    __syncthreads();
}
struct Args { const float* in[14]; float* out; unsigned char* ws; int ph_lo, ph_hi; };
constexpr int NPHASE = 17;
__global__ void __launch_bounds__(NWAVES * 64, 2) mega_fwd(Args args) {
    extern __shared__ __attribute__((aligned(16))) unsigned char lds[];
    LAS unsigned char* ldsA = (LAS unsigned char*)lds;
    volatile LAS unsigned* MISC = (volatile LAS unsigned*)(ldsA + MISC_OFF);
    const int tid = threadIdx.x, lane = tid & 63, wave = __builtin_amdgcn_readfirstlane(tid >> 6);
    const int G = gridDim.x, bx = blockIdx.x, vcu = (G % 8 == 0) ? (bx % 8) * (G / 8) + bx / 8 : bx;
    const int NGW = G * NWAVES;
    typedef const __attribute__((address_space(4))) Args* CArgsP;
    const CArgsP ap0 = (CArgsP)__builtin_amdgcn_kernarg_segment_ptr();
#define ARGP() ({ unsigned lo_ = (unsigned)(uintptr_t)ap0, hi_ = (unsigned)((uintptr_t)ap0 >> 32); asm volatile("" : "+s"(lo_), "+s"(hi_)); \
    (CArgsP)(((uintptr_t)(unsigned)__builtin_amdgcn_readfirstlane(hi_) << 32) | (unsigned)__builtin_amdgcn_readfirstlane(lo_)); })
#define a_ws ((unsigned char*)(GAS unsigned char*)(ARGP()->ws))
    unsigned* ctl = (unsigned*)(a_ws + WS_CTL);
    for (int u = tid; u < (LDS_BYTES - RING_BYTES) / 4; u += NWAVES * 64) ((LAS unsigned*)(ldsA + RING_BYTES))[u] = 0u;
    __syncthreads();
    XcdBarrier bar = xcd_barrier_post(ctl + CW_BAR, MISC + 8);
    if (LOCAL_SEAMS && tid == 0) (void)__hip_atomic_fetch_or(ctl + CW_GX + 16 * (bx & 7), 1u << xb_xcc_id(), __ATOMIC_RELAXED, __HIP_MEMORY_SCOPE_AGENT);
    if (FUSE_QUAD && tid == 0) __hip_atomic_store(ctl + CW_XID + bx, xb_xcc_id() + 1u, __ATOMIC_RELAXED, __HIP_MEMORY_SCOPE_AGENT);
    cg::grid_group grid = cg::this_grid();
#ifndef CODE_PAD
#define CODE_PAD "s_nop 0\n\ts_nop 0\n\ts_nop 0\n\ts_nop 0"
#endif
    asm volatile(CODE_PAD);
    const int lo = ap0->ph_lo, hi = ap0->ph_hi;
    if (hi < 0) grid.sync();
#ifndef PHMASK
#define PHMASK 0x1ffff
#endif
#define IN(k) (((PHMASK >> (k)) & 1) && lo <= (k) && (k) < hi)
#ifndef REPEAT_PH
#define REPEAT_PH -1
#endif
#ifndef REP_PART
#define REP_PART 0
#endif
#ifndef REPEAT_N
#define REPEAT_N 2
#endif
#define REP(k) for (int rep_ = 0; rep_ < (((k) == REPEAT_PH) ? REPEAT_N : 1); ++rep_)
#define STAGE_RS(S_) do { LAS float* rsl_ = (LAS float*)(ldsA + SCR_OFF); pg8::Unit u_; _Pragma("unroll 1") for (int i_ = 0; i_ < 15 && (S_).next(i_, u_); ++i_) { if (tid < 256) rsl_[i_ * 256 + tid] = RSV[u_.pm * 256 + tid]; } __syncthreads(); } while (0)
#define REPBAR() do { if (rep_ > 0) xcd_barrier(bar); } while (0)
#define PHIDS() const int tid = ph_tid(), lane = tid & 63, wave = __builtin_amdgcn_readfirstlane(tid >> 6), gw = vcu * NWAVES + wave; (void)lane; (void)gw
#ifndef TSA
#define TSA TSK
#endif
#ifndef TSB
#define TSB (TSK + 1)
#endif
#ifndef TSQC
#define TSQC 100.f
#endif
#ifndef TSCYC
#define TSCYC 0
#endif
#ifndef TSCLK
#define TSCLK 0
#endif
#ifndef TSTHR
#define TSTHR 0.f
#endif
#ifndef TSQ
#define TSQ 10.f
#endif
#ifndef TSK
#define TSK -1
#endif
#define STAMP(i) do { if (TSK >= 0 && bx == 0 && tid == 0) { const unsigned long long t_ = __builtin_amdgcn_s_memrealtime(); MISC[32 + 2 * (i)] = (unsigned)t_; MISC[33 + 2 * (i)] = (unsigned)(t_ >> 32); const unsigned long long c_ = __builtin_amdgcn_s_memtime(); MISC[80 + 2 * (i)] = (unsigned)c_; MISC[81 + 2 * (i)] = (unsigned)(c_ >> 32); } } while (0)
#ifdef BWPROBE
#define SEAM(k) do { if (IN(k) && IN((k) + 1)) { unsigned long long t0_ = 0; if (bx == BWPROBE && threadIdx.x == 0) t0_ = __builtin_amdgcn_s_memrealtime(); xcd_barrier(bar); \
    if (bx == BWPROBE && threadIdx.x == 0) { const unsigned long long t1_ = __builtin_amdgcn_s_memrealtime(); if (BWSEL < 0 || BWSEL == (k)) MISC[120] += (unsigned)(t1_ - t0_); } } } while (0)
#else
#define SEAM(k) do { if (IN(k) && IN((k) + 1)) { xcd_barrier(bar); } STAMP((k) + 1); } while (0)
#endif
#define a_x      ((const float*)(const GAS float*)(ARGP()->in[0]))
#define a_relb   ((const float*)(const GAS float*)(ARGP()->in[1]))
#define a_nmpre  ((const float*)(const GAS float*)(ARGP()->in[2]))
#define a_nmpost ((const float*)(const GAS float*)(ARGP()->in[3]))
#define a_nfpre  ((const float*)(const GAS float*)(ARGP()->in[4]))
#define a_nfpost ((const float*)(const GAS float*)(ARGP()->in[5]))
#define a_ewin   ((const float*)(const GAS float*)(ARGP()->in[6]))
#define a_egn    ((const float*)(const GAS float*)(ARGP()->in[7]))
#define a_ewout  ((const float*)(const GAS float*)(ARGP()->in[8]))
#define a_owin   ((const float*)(const GAS float*)(ARGP()->in[9]))
#define a_obf    ((const float*)(const GAS float*)(ARGP()->in[10]))
#define a_owout  ((const float*)(const GAS float*)(ARGP()->in[11]))
#define a_fwin   ((const float*)(const GAS float*)(ARGP()->in[12]))
#define a_fwout  ((const float*)(const GAS float*)(ARGP()->in[13]))
#define a_out    ((float*)(GAS float*)(ARGP()->out))
#define COS   ((float*)(a_ws + WS_COS))
#define SIN   ((float*)(a_ws + WS_SIN))
#define WFL   ((float*)(a_ws + WS_WFL))
#define KMEAN ((float*)(a_ws + WS_KMEAN))
#define SEL   ((unsigned*)(a_ws + WS_SEL))
#define LOGF  ((float*)(a_ws + WS_LOGF))
#define FCUM  ((float*)(a_ws + WS_FCUM))
#define WP0   ((bf16r*)(a_ws + WS_WP0))
#define WO0   ((bf16r*)(a_ws + WS_WO0))
#define WFI0  ((bf16r*)(a_ws + WS_WFI0))
#define WFO0  ((bf16r*)(a_ws + WS_WFO0))
#define WP1   ((bf16r*)(a_ws + WS_WP1))
#define WO1   ((bf16r*)(a_ws + WS_WO1))
#define WFI1  ((bf16r*)(a_ws + WS_WFI1))
#define WFO1  ((bf16r*)(a_ws + WS_WFO1))
#define HN    ((bf16r*)(a_ws + WS_A))
#define RSV   ((float*)(a_ws + WS_RS))
#define KVT   ((bf16r*)(a_ws + WS_E))
#define PB    ((bf16r*)(a_ws + WS_B))
    constexpr size_t A32 = (size_t)T * 512;
#define RQ (PB)
#define RK (PB + A32)
#define RV (PB + 2 * A32)
#define RG (PB + 3 * A32)
#define MQ (PB + 4 * A32)
#define MK (PB + 5 * A32)
#define MV (PB + 6 * A32)
#define HB (PB)
#define FQ (PB)
#define FK (PB + 2 * A32)
#define FV (PB + 4 * A32)
#define CAT ((bf16r*)(a_ws + WS_C))
#define MB  ((bf16r*)(a_ws + WS_D))
#define STB ((bf16r*)(a_ws + WS_D))
    STAMP(0);
    constexpr int I_P0 = 16 * 112, I_O = 16 * 32, I_FI = 16 * 176, I_FO = 44 * 32, I_P1 = 16 * 96;
    constexpr int NITEMS = I_P0 + 2 * I_O + 2 * I_FI + 2 * I_FO + I_P1, I_G2 = I_O + I_FI + I_FO + I_P1, I_G3 = I_O + I_FI + I_FO;
    auto wdecode = [&](int it, TItem& t) { int r = it; const float* W; bf16r* WT; const float* gk = nullptr; int K = DM, N, ldw, map = 0;
        if (r < I_P0) { W = a_ewin; WT = WP0; N = 3584; ldw = 3584; map = 1; gk = a_nmpre; }
        else if ((r -= I_P0) < I_O) { W = a_ewout; WT = WO0; N = DM; ldw = DM; }
        else if ((r -= I_O) < I_FI) { W = a_fwin; WT = WFI0; N = 2 * FFH; ldw = 2 * FFH; map = 2; gk = a_nfpre; }
        else if ((r -= I_FI) < I_FO) { W = a_fwout; WT = WFO0; K = FFH; N = DM; ldw = DM; }
        else if ((r -= I_FO) < I_P1) { W = a_owin; WT = WP1; N = 3072; ldw = 3080; gk = a_nmpre + DM; }
        else if ((r -= I_P1) < I_O) { W = a_owout; WT = WO1; N = DM; ldw = DM; }
        else if ((r -= I_O) < I_FI) { W = a_fwin + (size_t)DM * 2 * FFH; WT = WFI1; N = 2 * FFH; ldw = 2 * FFH; map = 2; gk = a_nfpre + DM; }
        else { r -= I_FI; W = a_fwout + (size_t)FFH * DM; WT = WFO1; K = FFH; N = DM; ldw = DM; }
        const int nblk = N / 32; t.W = W; t.WT = WT; t.gk = gk; t.K = K; t.ldw = ldw; t.map = map; t.k0 = 64 * (r / nblk); t.n0 = 32 * (r % nblk); };
    auto conv_tail = [&](int q, int first, int count, int wave_, int lane_) {
        LAS float* scr = (LAS float*)(ldsA + wave_ * 16384); unsigned* qc = ctl + CW_WQ + 64 * q;
        TItem cur, nxt; float ra[32], rb[32], ga[32], gb[32];
        for (;;) {
            if (wave_ == 0 && lane_ == 0) MISC[124] = __hip_atomic_fetch_add(qc, 32u, __ATOMIC_RELAXED, __HIP_MEMORY_SCOPE_AGENT);
            __syncthreads();
            const int base = __builtin_amdgcn_readfirstlane((int)MISC[124]);
            __syncthreads();
            if (base >= count) break;
            const int i0 = base + wave_;
            if (i0 < count) { wdecode(first + i0, cur); titem_load(cur, ra, ga, lane_); }
            if (i0 + 8 < count) { wdecode(first + i0 + 8, nxt); titem_load(nxt, rb, gb, lane_); }
            if (i0 < count) titem_store(cur, ra, ga, scr, lane_);
            if (i0 + 16 < count) { wdecode(first + i0 + 16, cur); titem_load(cur, ra, ga, lane_); }
            if (i0 + 8 < count) titem_store(nxt, rb, gb, scr, lane_);
            if (i0 + 24 < count) { wdecode(first + i0 + 24, nxt); titem_load(nxt, rb, gb, lane_); }
            if (i0 + 16 < count) titem_store(cur, ra, ga, scr, lane_);
            if (i0 + 24 < count) titem_store(nxt, rb, gb, scr, lane_); } };
    if (IN(0)) REP(0) { REPBAR(); PHIDS();
        LAS float* scr = (LAS float*)(ldsA + wave * 16384);
        constexpr int NIT0 = DEFER_W ? I_P0 : NITEMS;
        auto& decode = wdecode;
        { TItem cur, nxt; float ra[32], rb[32], ga[32], gb[32];
          if (gw < NIT0) { decode(gw, cur); titem_load(cur, ra, ga, lane); }
          for (int it = gw; it < NIT0; it += 2 * NGW) {
              const bool h1 = it + NGW < NIT0, h2 = it + 2 * NGW < NIT0;
              if (h1) { decode(it + NGW, nxt); titem_load(nxt, rb, gb, lane); }
              titem_store(cur, ra, ga, scr, lane);
              if (h1) { if (h2) { decode(it + 2 * NGW, cur); titem_load(cur, ra, ga, lane); } titem_store(nxt, rb, gb, scr, lane); } } }
        for (int i = bx * 512 + tid; i < 8 * DM; i += G * 512) { const int h = i >> 10, k = i & 1023; WFL[i] = a_owin[(size_t)k * 3080 + 3072 + h] * (a_nmpre + DM)[k]; }
        row_pass<0, false, 0, false>(gw, NGW, lane, a_x, nullptr, nullptr, nullptr, HN, RSV, nullptr, nullptr, nullptr, nullptr);
    }
    SEAM(0);
    bool local_ok = LOCAL_SEAMS && (G % 8 == 0);
    if (LOCAL_SEAMS) { unsigned all_ = 0u; for (int j_ = 0; j_ < 8; ++j_) { const unsigned w_ = (unsigned)__builtin_amdgcn_readfirstlane((int)xb_ld(ctl + CW_GX + 16 * j_)); local_ok = local_ok && (__builtin_popcount(w_) == 1); all_ |= w_; }
        local_ok = local_ok && (__builtin_popcount(all_) == 8); }
#define SEAML(k) do { if (IN(k) && IN((k) + 1)) { if (local_ok) xcd_local_barrier(bar); else xcd_barrier(bar); } STAMP((k) + 1); } while (0)
    bool same_xcc = true;
    if (FUSE_QUAD) for (int j_ = 1; j_ < 4; ++j_) same_xcc = same_xcc && ((unsigned)__builtin_amdgcn_readfirstlane((int)xb_ld(ctl + CW_XID + (bx ^ (8 * j_)))) == xb_xcc_id() + 1u);
    if (IN(1)) REP(1) { REPBAR(); PHIDS();
        pg8::Gemm g{HN, WP0, T, 3584, DM}; pg8::StaticOrder S; S.init(T, 3584, G, bx);
        pg8::EpiHeads<4, true, 3> E{PB, A32, COS, SIN, 0.08838834764831845f, RSV, nullptr};
        pg8::gemm_phase<pg8::EpiHeads<4, true, 3>, pg8::StaticOrder, true, true>(ldsA, g, S, E);
    }
    SEAM(1);
    if (IN(2)) REP(2) { REPBAR(); PHIDS();
        { ret::KVStage kst; if (vcu < 1024) ret::kv_load(kst, (const att::bf16*)(RK + (size_t)vcu * 16384), (const att::bf16*)(RV + (size_t)vcu * 16384));
          for (int c = vcu; c < 1024; c += G) { const int bh = c >> 5, cn = c + G; const bool hn = cn < 1024; const size_t on = (size_t)(hn ? cn : c) * 16384;
            ret::kv_task((char*)lds, kst, (const att::bf16*)(RK + on), (const att::bf16*)(RV + on), hn, (att::bf16*)(KVT + (size_t)c * 16384), bh & 3); } }
        STAMP(21);
        { LAS float* part = (LAS float*)ldsA;
          const int dc = tid & 15, rg = tid >> 4;
#pragma unroll
          for (int tsk = 0; tsk < 2; ++tsk) { const int u = vcu + tsk * G; if (u < 512) {
              const v4u* kp = (const v4u*)(MK + ((size_t)u * 256 + rg * 8) * 128 + dc * 8); v4u w[8]; float acc[8] = {0.f, 0.f, 0.f, 0.f, 0.f, 0.f, 0.f, 0.f};
#pragma unroll
              for (int i = 0; i < 8; ++i) w[i] = kp[i * 16];
#pragma unroll
              for (int i = 0; i < 8; ++i)
#pragma unroll
                  for (int e = 0; e < 4; ++e) { acc[2 * e] += ret::bf_lo(w[i][e]); acc[2 * e + 1] += ret::bf_hi(w[i][e]); }
#pragma unroll
              for (int e = 0; e < 8; ++e) part[(tsk * 32 + rg) * 128 + dc * 8 + e] = acc[e]; } }
          __syncthreads();
          if (tid < 256) { const int tsk = tid >> 7, d = tid & 127, u = vcu + tsk * G; if (u < 512) { float sm = 0.f;
#pragma unroll
              for (int r = 0; r < 32; ++r) sm += part[(tsk * 32 + r) * 128 + d];
              KMEAN[(size_t)u * 128 + d] = sm * (1.f / 256.f); } }
          __syncthreads(); }
    }
    SEAM(2);
    auto gate_rows = [&](int bh, int srow, int wave_, int lane_) {

            typedef short bf16x8v __attribute__((ext_vector_type(8)));
            LAS float* gl = (LAS float*)ldsA + wave_ * 64 * 16;
            const int nn = lane_ & 15, kg = lane_ >> 4; bf16x8v bhi[4], blo[4];
            const float* kmp = KMEAN + ((size_t)bh * 16 + nn) * 128 + 8 * kg;
#pragma unroll
            for (int ks = 0; ks < 4; ++ks) { const f32x4 a = *(const f32x4*)(kmp + 32 * ks), b = *(const f32x4*)(kmp + 32 * ks + 4); const float v[8] = {a.x, a.y, a.z, a.w, b.x, b.y, b.z, b.w};
                unsigned hw[4], lw[4];
#pragma unroll
                for (int e = 0; e < 4; ++e) { const unsigned h2 = pk2(v[2 * e], v[2 * e + 1]); hw[e] = h2; lw[e] = pk2(v[2 * e] - __uint_as_float(h2 << 16), v[2 * e + 1] - __uint_as_float(h2 & 0xffff0000u)); }
                bhi[ks] = __builtin_bit_cast(bf16x8v, (v4u){hw[0], hw[1], hw[2], hw[3]}); blo[ks] = __builtin_bit_cast(bf16x8v, (v4u){lw[0], lw[1], lw[2], lw[3]}); }
#pragma unroll
            for (int g = 0; g < 4; ++g) { const bf16r* qp = MQ + ((size_t)bh * SEQ + srow + g * 16 + nn) * 128 + 8 * kg; f32x4 acc = {0.f, 0.f, 0.f, 0.f};
#pragma unroll
                for (int ks = 0; ks < 4; ++ks) { const bf16x8v a = *(const bf16x8v*)(qp + 32 * ks);
                    acc = __builtin_amdgcn_mfma_f32_16x16x32_bf16(a, bhi[ks], acc, 0, 0, 0); acc = __builtin_amdgcn_mfma_f32_16x16x32_bf16(a, blo[ks], acc, 0, 0, 0); }
#pragma unroll
                for (int r = 0; r < 4; ++r) gl[(g * 16 + 4 * kg + r) * 16 + nn] = acc[r]; }
            LDS_WAIT(); asm volatile("" ::: "memory");
            const int s = srow + lane_, own = s >> 8; float gt[16];
#pragma unroll
            for (int c = 0; c < 4; ++c) { const f32x4 t4 = *(const LAS f32x4*)(gl + lane_ * 16 + 4 * c); gt[4 * c] = t4.x; gt[4 * c + 1] = t4.y; gt[4 * c + 2] = t4.z; gt[4 * c + 3] = t4.w; }
            float v1 = 0.f, v2 = 0.f, v3 = 0.f; int i1 = -1, i2 = -1, i3 = -1;
#pragma unroll
            for (int n = 0; n < 15; ++n) { const float d = gt[n]; if (n < own) {
                if (i1 < 0 || d > v1) { v3 = v2; i3 = i2; v2 = v1; i2 = i1; v1 = d; i1 = n; }
                else if (i2 < 0 || d > v2) { v3 = v2; i3 = i2; v2 = d; i2 = n; }
                else if (i3 < 0 || d > v3) { v3 = d; i3 = n; } } }
            unsigned msk = 0; if (i1 >= 0) msk |= 1u << i1; if (i2 >= 0) msk |= 1u << i2; if (i3 >= 0) msk |= 1u << i3;
            SEL[(size_t)bh * SEQ + s] = msk;
            LDS_WAIT(); asm volatile("" ::: "memory"); };
    if (IN(3)) REP(3) { REPBAR(); PHIDS();
        for (int gid = bx * 512 + tid; gid < 32 * 4096; gid += G * 512) { const int bh = gid >> 12, e4 = gid & 4095;
            const float cd = __builtin_amdgcn_exp2f(ret::l2g_of(bh & 3) * 128.f); f32x4 s = {0.f, 0.f, 0.f, 0.f};
            typedef unsigned u32x2_ __attribute__((ext_vector_type(2)));
            const u32x2_* kv = (const u32x2_*)KVT + (size_t)bh * 32 * 4096 + e4; uint2* st = (uint2*)STB + (size_t)bh * 32 * 4096 + e4;
            u32x2_ k[32];
#pragma unroll
            for (int i = 0; i < 32; ++i) k[i] = __builtin_nontemporal_load(kv + (size_t)i * 4096);
#pragma unroll
            for (int i = 0; i < 32; ++i) { uint2 w; w.x = pk2(s.x, s.y); w.y = pk2(s.z, s.w); st[(size_t)i * 4096] = w;
                s = s * cd + (f32x4){__uint_as_float(k[i].x << 16), __uint_as_float(k[i].x & 0xffff0000u), __uint_as_float(k[i].y << 16), __uint_as_float(k[i].y & 0xffff0000u)}; } }
        STAMP(19);
        if (!GATE_IN_P4) for (int g0 = bx * 512; g0 < 32 * 4096; g0 += G * 512) gate_rows(g0 >> 12, (g0 & 4095) + wave * 64, wave, lane);
    }
    SEAM(3);
    if (IN(4)) REP(4) { REPBAR(); PHIDS();
        const int cls = P4_MIX == 1 ? ((vcu & 1) ? 3 : 0) : (P4_MIX == 2 ? ((vcu >> 3) & 3) : 0);
        if (GATE_IN_P4) {
            const int x_ = vcu & 7;
            gate_rows(vcu >> 3, (((wave >> 2) ? x_ : 15 - x_) << 8) + (wave & 3) * 64, wave, lane);
            asm volatile("s_waitcnt vmcnt(0)" ::: "memory"); __syncthreads(); }
#pragma unroll 1
        for (int step = 0; step < 3; ++step) {
            int act;
            if (cls == 0) act = step == 0 ? 1 : (step == 1 ? 2 : 0);
            else if (cls == 3) act = step == 0 ? 2 : (step == 1 ? 1 : 0);
            else act = step == 0 ? 3 : (step == 1 ? 1 : 4);
            if (act == 1) {
                for (int u = vcu; u < 512; u += G) { const int bh = u >> 4, cp = u & 15, b = bh >> 2, h = bh & 3; const size_t hb = ((size_t)bh * SEQ + cp * 256) * 128, tb = (size_t)b * SEQ + cp * 256;
                    ret::out_task((char*)lds, (const att::bf16*)(RQ + hb), (const att::bf16*)(RK + hb), (const att::bf16*)(RV + hb), (const att::bf16*)(STB + ((size_t)bh * 32 + cp * 2) * 16384),
                                  (const att::bf16*)(RG + tb * 512 + h * 128), a_egn + h * 128, (att::bf16*)(CAT + tb * DM + h * 128), h); }
                __syncthreads();
            } else if (act >= 2) {
                { LAS float* lut = (LAS float*)(ldsA + att::OFF_LUT); const float* rb = a_relb;
                  STAMP(18);
                  for (int i = tid; i < att::LUT_FLOATS; i += 512) { const int h = i >> 9, rel = (i & 511) - 256; lut[i] = (i >= 2048) ? 0.f : (rb[t5_bucket(rel) * 4 + (h & 3)] - rb[31 * 4 + (h & 3)]) * att::INV_SCALE; }
                  __syncthreads(); }
                { AttSchedMoba sch{vcu, act == 4 ? 1 : 0, act == 2 ? 2 : 1}; const att::ABase AB{(const att::bf16*)MQ, (const att::bf16*)MK, (const att::bf16*)MV, (att::bf16*)CAT, nullptr, SEL, 4, 512};
                  att::attn_phase<1, AttSchedMoba>((char*)lds, AB, sch); }
                __syncthreads();
            } }
        if (DEFER_W) conv_tail(0, I_P0, I_G2, wave, lane);
    }
    SEAM(4);
    { bool fused = false;
      if (IN(5)) { PHIDS(); pg8::Gemm g{CAT, WO0, T, DM, DM}; PairOrder S; S.init(T, DM, G, bx); pg8::EpiPlain E{MB, DM};
          pg8::gemm_phase<pg8::EpiPlain, PairOrder, PLAIN_ALIGN, PLAIN_SP2>(ldsA, g, S, E);
          if (S.pair && IN(6)) { fused = true; const int r0_ = S.row0();
              pair_sync(ctl + CW_PF + 16 * (0 * 128 + S.pm), same_xcc);
              row_pass<1, true, 0, false>(r0_ + wave, NWAVES, lane, nullptr, HN, MB, a_nmpost, HN, RSV, nullptr, nullptr, nullptr, nullptr, r0_ + 128); __syncthreads(); } }
      if (!fused) { SEAM(5);
          if (IN(6)) { PHIDS(); row_pass<1, true, 0, false>(gw, NGW, lane, nullptr, HN, MB, a_nmpost, HN, RSV, nullptr, nullptr, nullptr, nullptr); __syncthreads(); } } }
    SEAM(6);
    if (IN(7)) REP(7) { REPBAR(); PHIDS(); pg8::Gemm g{HN, WFI0, T, 2 * FFH, DM}; pg8::StaticOrder S; S.init(T, 2 * FFH, G, bx); pg8::EpiSwiglu E{HB, FFH, RSV};
        pg8::gemm_phase<pg8::EpiSwiglu, pg8::StaticOrder, true, true>(ldsA, g, S, E); }
    SEAML(7);
    { bool fused = false;
      if (IN(8)) { PHIDS(); pg8::Gemm g{HB, WFO0, T, DM, FFH}; PairOrder S; S.init(T, DM, G, bx); pg8::EpiPlain E{MB, DM};
          pg8::gemm_phase<pg8::EpiPlain, PairOrder, PLAIN_ALIGN, PLAIN_SP2>(ldsA, g, S, E);
          if (S.pair && IN(9)) { fused = true; const int r0_ = S.row0(); LAS float* wfl = (LAS float*)ldsA; for (int i = tid; i < 8 * DM; i += 512) wfl[i] = WFL[i];
              pair_sync(ctl + CW_PF + 16 * (1 * 128 + S.pm), same_xcc);
              row_pass<1, true, 0, true>(r0_ + wave, NWAVES, lane, nullptr, HN, MB, a_nfpost, HN, RSV, nullptr, wfl, a_obf, LOGF, r0_ + 128); __syncthreads(); } }
      if (!fused) { SEAM(8);
          if (IN(9)) { PHIDS(); LAS float* wfl = (LAS float*)ldsA; for (int i = tid; i < 8 * DM; i += 512) wfl[i] = WFL[i]; __syncthreads(); row_pass<1, true, 0, true>(gw, NGW, lane, nullptr, HN, MB, a_nfpost, HN, RSV, nullptr, wfl, a_obf, LOGF); __syncthreads(); } } }
    SEAM(9);
    if (IN(10)) REP(10) { REPBAR(); PHIDS();
        for (int bh = vcu; bh < 64; bh += G) { LAS float* sc = (LAS float*)(ldsA + SCR_OFF); const int b = bh >> 3, h = bh & 7; float v[8], run = 0.f;
#pragma unroll
            for (int i = 0; i < 8; ++i) { run += LOGF[((size_t)b * SEQ + tid * 8 + i) * 8 + h]; v[i] = run; }
            sc[tid] = run; __syncthreads();
            for (int o = 1; o < 512; o <<= 1) { const float a = (tid >= o) ? sc[tid - o] : 0.f; __syncthreads(); sc[tid] += a; __syncthreads(); }
            const float base = (tid > 0) ? sc[tid - 1] : 0.f;
#pragma unroll
            for (int i = 0; i < 8; ++i) FCUM[(size_t)bh * SEQ + tid * 8 + i] = -(base + v[i]) * att::INV_SCALE;
            __syncthreads(); }
        pg8::Gemm g{HN, WP1, T, 3072, DM}; pg8::StaticOrder S; S.init(T, 3072, G, bx);
        pg8::EpiHeads<8, false, -1, true> E{PB, 2 * A32, nullptr, nullptr, 1.f, RSV, ctl + CW_KM};
        pg8::gemm_phase<pg8::EpiHeads<8, false, -1, true>, pg8::StaticOrder, true, true>(ldsA, g, S, E);
    }
    SEAM(10);
    if (IN(11)) REP(11) { REPBAR(); PHIDS();
        if (tid < 64) { float k2 = 0.f;
            for (int w = 0; w < 4; ++w) k2 += __uint_as_float(__hip_atomic_load(ctl + CW_KM + tid * 4 + w, __ATOMIC_RELAXED, __HIP_MEMORY_SCOPE_AGENT));
            ((LAS float*)(ldsA + att::OFF_KM))[tid] = k2; }
        __syncthreads();
        STAMP(20);
#ifdef FOX_STATIC
        AttSchedFox sch{vcu};
        typedef AttSchedFox FoxSched;
#else
        const int nq = (G % 8 == 0) ? 8 : 1;
        LAS unsigned short* ord = (LAS unsigned short*)(ldsA + att::OFF_ORD);
        {
            LAS float* est = (LAS float*)(ldsA + att::OFF_ORD + 2048); LAS unsigned* key = (LAS unsigned*)(ldsA + att::OFF_ORD + 2048 + 256);
            if (tid < 64) { const float* Gp = FCUM + (size_t)tid * SEQ; const float rate = (Gp[SEQ - 1] - Gp[0]) * (1.f / (SEQ - 1));
                const float thr = 1.02f * sqrtf(170.f * ((LAS float*)(ldsA + att::OFF_KM))[tid]) + att::PRUNE_T * att::INV_SCALE - 20.f;
                est[tid] = fminf(4.f + ceilf(thr / fmaxf(rate, 1e-3f) * (1.f / 64.f)), 64.f); }
            __syncthreads();
            const int per = 1024 / nq, hpq = 64 / nq;
            for (int i = tid; i < 1024; i += 512) { const int qq = i / per, li = i % per, qb = 15 - li / hpq, bh = qq * hpq + li % hpq, e = ((int)est[bh] + 1) & ~1, c = 4 * (qb + 1); key[i] = ((unsigned)(c < e ? c : e) << 10) | (unsigned)(1023 - li); }
            __syncthreads();
            for (int i = tid; i < 1024; i += 512) { const int qq = i / per; const unsigned ki = key[i]; int rank = 0; const LAS v4u* kv = (const LAS v4u*)(key + qq * per);
#pragma unroll 8
                for (int j = 0; j < per / 4; ++j) { const v4u w = kv[j]; rank += (w.x > ki ? 1 : 0) + (w.y > ki ? 1 : 0) + (w.z > ki ? 1 : 0) + (w.w > ki ? 1 : 0); }
                ord[qq * per + rank] = (unsigned short)(i % per); }
            __syncthreads(); }
        AttSchedFoxDyn sch{ctl + CW_FQ, nq == 8 ? vcu / (G / 8) : 0, nq, ord};
        typedef AttSchedFoxDyn FoxSched;
#endif
        const att::ABase AB{(const att::bf16*)FQ, (const att::bf16*)FK, (const att::bf16*)FV, (att::bf16*)CAT, FCUM, nullptr, 8, 0};
        att::attn_phase<0, FoxSched>((char*)lds, AB, sch);
        if (DEFER_W) { __syncthreads(); conv_tail(1, I_P0 + I_G2, I_G3, wave, lane); } }
    SEAM(11);
    { bool fused = false;
      if (IN(12)) { PHIDS(); pg8::Gemm g{CAT, WO1, T, DM, DM}; PairOrder S; S.init(T, DM, G, bx); pg8::EpiPlain E{MB, DM};
          pg8::gemm_phase<pg8::EpiPlain, PairOrder, PLAIN_ALIGN, PLAIN_SP2>(ldsA, g, S, E);
          if (S.pair && IN(13)) { fused = true; const int r0_ = S.row0();
              pair_sync(ctl + CW_PF + 16 * (2 * 128 + S.pm), same_xcc);
              row_pass<1, true, 0, false>(r0_ + wave, NWAVES, lane, nullptr, HN, MB, a_nmpost + DM, HN, RSV, nullptr, nullptr, nullptr, nullptr, r0_ + 128); __syncthreads(); } }
      if (!fused) { SEAM(12);
          if (IN(13)) { PHIDS(); row_pass<1, true, 0, false>(gw, NGW, lane, nullptr, HN, MB, a_nmpost + DM, HN, RSV, nullptr, nullptr, nullptr, nullptr); __syncthreads(); } } }
    SEAM(13);
    if (IN(14)) REP(14) { REPBAR(); PHIDS(); pg8::Gemm g{HN, WFI1, T, 2 * FFH, DM}; pg8::StaticOrder S; S.init(T, 2 * FFH, G, bx); pg8::EpiSwiglu E{HB, FFH, RSV};
        pg8::gemm_phase<pg8::EpiSwiglu, pg8::StaticOrder, true, true>(ldsA, g, S, E); }
    SEAML(14);
    { bool fused = false;
      if (IN(15)) { PHIDS(); pg8::Gemm g{HB, WFO1, T, DM, FFH}; PairOrder S; S.init(T, DM, G, bx); pg8::EpiPlain E{MB, DM};
          pg8::gemm_phase<pg8::EpiPlain, PairOrder, PLAIN_ALIGN, PLAIN_SP2>(ldsA, g, S, E);
          if (S.pair && IN(16)) { fused = true; const int r0_ = S.row0();
              pair_sync(ctl + CW_PF + 16 * (3 * 128 + S.pm), same_xcc);
              row_pass<1, true, 1, false>(r0_ + wave, NWAVES, lane, nullptr, HN, MB, a_nfpost + DM, nullptr, nullptr, a_out, nullptr, nullptr, nullptr, r0_ + 128); __syncthreads(); } }
      if (!fused) { SEAM(15);
          if (IN(16)) { PHIDS(); row_pass<1, true, 1, false>(gw, NGW, lane, nullptr, HN, MB, a_nfpost + DM, nullptr, nullptr, a_out, nullptr, nullptr, nullptr); __syncthreads(); } } }
    STAMP(17);
#ifdef BWPROBE
    if (bx == BWPROBE && threadIdx.x == 0) { float us_ = (float)MISC[120] * 0.01f; us_ = us_ > (float)BWTHR ? 1000.f : 500.f; a_out[0] = us_; }
#endif
    if (TSK >= 0 && bx == 0) { __syncthreads(); if (tid == 0) { asm volatile("s_waitcnt vmcnt(0)" ::: "memory");
        const unsigned long long t1 = ((unsigned long long)MISC[33 + 2 * (TSB)] << 32) | MISC[32 + 2 * (TSB)], t0 = ((unsigned long long)MISC[33 + 2 * (TSA)] << 32) | MISC[32 + 2 * (TSA)];
        float us_ = (float)(t1 - t0) * 0.01f; us_ = us_ >= 100.f ? TSQ * rintf(us_ * (1.f / TSQ)) : rintf(us_);
        if (TSCLK) { const unsigned long long c1 = ((unsigned long long)MISC[81 + 2 * (TSB)] << 32) | MISC[80 + 2 * (TSB)], c0 = ((unsigned long long)MISC[81 + 2 * (TSA)] << 32) | MISC[80 + 2 * (TSA)];
            us_ = 100.f * rintf((float)(c1 - c0) / ((float)(t1 - t0) * 0.01f) * 0.01f); }
        if (TSCYC) { const float cy_ = (float)(t1 - t0); us_ = cy_ >= 1000.f ? TSQC * rintf(cy_ * (1.f / TSQC)) : (cy_ >= 100.f ? 10.f * rintf(cy_ * 0.1f) : cy_); }
        if (TSTHR > 0.f) us_ = ((float)(t1 - t0) * 0.01f > TSTHR) ? 1000.f : 500.f;
#ifdef LOKPROBE
        us_ = local_ok ? 1000.f : 500.f;
#endif
#ifdef TSOFF
        us_ = TSQ * rintf(((float)(t1 - t0) * 0.01f - (float)TSOFF) * (1.f / TSQ));
#endif
#ifdef NTEPROBE
        us_ = (float)__hip_atomic_load(ctl + 9216 + 1024, __ATOMIC_RELAXED, __HIP_MEMORY_SCOPE_AGENT);
#endif
        a_out[0] = us_; } }
#undef IN
#undef SEAM
}

#ifndef N_LAUNCH_SPLIT
#define N_LAUNCH_SPLIT 0
#endif
extern "C" void kernel_launch(void* const* d_in, const int* in_sizes, int n_in, void* d_out, int out_size, void* d_ws, size_t ws_size, hipStream_t stream) {
    static int grid = 0;
    if (grid == 0) {
        if (n_in != 14 || in_sizes[0] != T * DM || out_size != T * DM || ws_size < WS_END) { fprintf(stderr, "kernel_launch: unexpected shapes (n_in %d in0 %d out %d ws %zu)\n", n_in, n_in > 0 ? in_sizes[0] : -1, out_size, ws_size); grid = -1; return; }
        int dev = 0, cus = 0, per_cu = 0;
        if (hipGetDevice(&dev) != hipSuccess || hipDeviceGetAttribute(&cus, hipDeviceAttributeMultiprocessorCount, dev) != hipSuccess) { grid = -1; return; }
        if (hipFuncSetAttribute((const void*)mega_fwd, hipFuncAttributeMaxDynamicSharedMemorySize, LDS_BYTES) != hipSuccess) { fprintf(stderr, "kernel_launch: hipFuncSetAttribute failed\n"); grid = -1; return; }
        if (hipOccupancyMaxActiveBlocksPerMultiprocessor(&per_cu, (const void*)mega_fwd, NWAVES * 64, LDS_BYTES) != hipSuccess || per_cu < 1) { fprintf(stderr, "kernel_launch: occupancy query says %d\n", per_cu); (void)hipGetLastError(); grid = -1; return; }
        grid = cus;
        if (grid != 256) fprintf(stderr, "kernel_launch: note: %d CUs (tuned for 256)\n", grid);
    }
    if (grid < 0) return;
    if (hipMemsetAsync((char*)d_ws + WS_CTL, 0, CTL_ZERO_BYTES, stream) != hipSuccess) return;
    Args a{};
    for (int i = 0; i < 14; ++i) a.in[i] = (const float*)d_in[i];
    a.out = (float*)d_out; a.ws = (unsigned char*)d_ws;
#if N_LAUNCH_SPLIT
    for (int p = 0; p < NPHASE; ++p) { a.ph_lo = p; a.ph_hi = p + 1; hipLaunchKernelGGL(mega_fwd, dim3(grid), dim3(NWAVES * 64), LDS_BYTES, stream, a); }
#else
    a.ph_lo = 0; a.ph_hi = NPHASE;
    void* kargs[] = {&a};
    hipError_t e = hipLaunchCooperativeKernel((const void*)mega_fwd, dim3(grid), dim3(NWAVES * 64), kargs, LDS_BYTES, stream);
    if (e != hipSuccess) fprintf(stderr, "kernel_launch: cooperative launch failed: %s (grid %d)\n", hipGetErrorString(e), grid);
#endif
}
```
